# Optimizing an MI355X kernel written in HIP

```python
import math
import jax, jax.numpy as jnp
from jax import lax
import numpy as np

D_MODEL = 1024
BATCH = 4
SEQ = 8192
DEPTH = 1

D_FOURIER = D_MODEL // 2
FOURIER_GROUPS = 4
D_SSM = D_MODEL // 2
SSM_GROUP = 16
SSM_GROUPS = D_SSM // SSM_GROUP
SSM_STATE = 64
N_DIRECTIONS = 2
DT_MIN = 1e-3
DT_MAX = 1e-1
N_BRANCHES = 2
D_IN = D_FOURIER + D_SSM + N_BRANCHES * D_MODEL
N_EXPERTS = 16
D_EXPERT = 2816
EC_CAPACITY = 2
PLE_DIM = 256
RMS_EPS = 1e-6

kernel_name = 'hybrid_fourier_s5_expert_choice_block'


def rmsnorm(x, g):
    xf = x.astype(jnp.float32)
    y = xf * lax.rsqrt(jnp.mean(xf * xf, axis=-1, keepdims=True) + RMS_EPS)
    return (y * g.astype(jnp.float32)).astype(x.dtype)


def fourier_mix(u):
    b, s, _ = u.shape
    ug = u.astype(jnp.float32).reshape(b, s, FOURIER_GROUPS, D_FOURIER // FOURIER_GROUPS)
    ug = jnp.transpose(ug, (0, 2, 1, 3))
    f = jnp.fft.fft2(ug, axes=(-2, -1), norm='ortho').real
    f = jnp.transpose(f, (0, 2, 1, 3)).reshape(b, s, D_FOURIER)
    return f.astype(u.dtype)


def _linear_recurrence(c1, c2):
    a1, b1 = c1
    a2, b2 = c2
    return a1 * a2, a2 * b1 + b2


def ssm_direction(ug, a_re, a_im, log_dt, b_re, b_im, c_re, c_im, reverse):
    f32 = jnp.float32
    lam = lax.complex(a_re.astype(f32), a_im.astype(f32))
    dt = jnp.exp(log_dt.astype(f32))[:, None]
    lam_bar = jnp.exp(lam * dt)
    b_bar = ((lam_bar - 1.0) / lam)[..., None] * lax.complex(b_re.astype(f32), b_im.astype(f32))
    bu = jnp.einsum('bsgi,gni->bsgn', ug.astype(jnp.complex64), b_bar)
    a = jnp.broadcast_to(lam_bar, (1, ug.shape[1]) + lam_bar.shape)
    _, states = lax.associative_scan(_linear_recurrence, (a, bu), reverse=reverse, axis=1)
    c = lax.complex(c_re.astype(f32), c_im.astype(f32))
    return jnp.einsum('bsgn,gon->bsgo', states, c).real


def ssm_branch(u, a_re, a_im, log_dt, b_re, b_im, c_re, c_im, d, w_glu):
    bsz, s, _ = u.shape
    uf = u.astype(jnp.float32)
    ug = uf.reshape(bsz, s, SSM_GROUPS, SSM_GROUP)
    y = d.astype(jnp.float32) * uf
    for direction, rev in enumerate((False, True)):
        y = y + ssm_direction(ug, a_re[direction], a_im[direction], log_dt[direction],
                              b_re[direction], b_im[direction], c_re[direction], c_im[direction],
                              rev).reshape(bsz, s, D_SSM)
    y = jax.nn.gelu(y).astype(u.dtype)
    val, gate = jnp.split(y @ w_glu, 2, axis=-1)
    return val * jax.nn.sigmoid(gate)


def expert_choice_ffn(h, w_router, w_gate, w_up, w_down):
    bsz, s, d = h.shape
    cap = EC_CAPACITY * s // N_EXPERTS
    affinity = jax.nn.softmax((h @ w_router).astype(jnp.float32), axis=-1)
    vals, idx = lax.top_k(jnp.swapaxes(affinity, 1, 2), cap)
    bidx = jnp.arange(bsz)[:, None, None]
    xg = h[bidx, idx]
    hid = jax.nn.silu(jnp.einsum('becd,edf->becf', xg, w_gate)) * jnp.einsum('becd,edf->becf', xg, w_up)
    y = jnp.einsum('becf,efd->becd', hid, w_down) * vals[..., None].astype(h.dtype)
    flat = (bidx * s + idx).reshape(-1)
    out = jnp.zeros((bsz * s, d), h.dtype).at[flat].add(y.reshape(-1, d))
    return out.reshape(bsz, s, d)


def setup_inputs(seed: int = 0) -> dict:
    key = jax.random.key(seed)
    ks = jax.random.split(key, 24)

    def nrm(k, shape, scale):
        return jax.random.normal(k, shape, jnp.float32) * scale

    L = DEPTH
    G, N = SSM_GROUPS, SSM_STATE
    return {
        'x': nrm(ks[0], (BATCH, SEQ, D_MODEL), 1.0),
        'p': nrm(ks[1], (DEPTH, BATCH, SEQ, PLE_DIM), 1.0),
        'g_mix': 1.0 + nrm(ks[2], (L, D_MODEL), 0.01),
        'w_in': nrm(ks[3], (L, D_MODEL, D_IN), D_MODEL ** -0.5),
        'w_fourier': nrm(ks[4], (L, D_FOURIER, D_MODEL), D_FOURIER ** -0.5),
        'ssm_a_re': -0.5 + nrm(ks[5], (L, N_DIRECTIONS, G, N), 0.01),
        'ssm_a_im': math.pi * jnp.arange(N, dtype=jnp.float32) + nrm(ks[6], (L, N_DIRECTIONS, G, N), 0.01),
        'ssm_log_dt': jax.random.uniform(ks[7], (L, N_DIRECTIONS, G), jnp.float32,
                                         math.log(DT_MIN), math.log(DT_MAX)),
        'ssm_b_re': nrm(ks[8], (L, N_DIRECTIONS, G, N, SSM_GROUP), (2 * SSM_GROUP) ** -0.5),
        'ssm_b_im': nrm(ks[9], (L, N_DIRECTIONS, G, N, SSM_GROUP), (2 * SSM_GROUP) ** -0.5),
        'ssm_c_re': nrm(ks[10], (L, N_DIRECTIONS, G, SSM_GROUP, N), SSM_STATE ** -0.5),
        'ssm_c_im': nrm(ks[11], (L, N_DIRECTIONS, G, SSM_GROUP, N), SSM_STATE ** -0.5),
        'ssm_d': nrm(ks[12], (L, D_SSM), 1.0),
        'w_glu': nrm(ks[13], (L, D_SSM, 2 * D_MODEL), D_SSM ** -0.5),
        'w_out': nrm(ks[14], (L, D_MODEL, D_MODEL), D_MODEL ** -0.5),
        'g_ffn': 1.0 + nrm(ks[15], (L, D_MODEL), 0.01),
        'w_router': nrm(ks[16], (L, D_MODEL, N_EXPERTS), D_MODEL ** -0.5),
        'w_exp_gate': nrm(ks[17], (L, N_EXPERTS, D_MODEL, D_EXPERT), D_MODEL ** -0.5),
        'w_exp_up': nrm(ks[18], (L, N_EXPERTS, D_MODEL, D_EXPERT), D_MODEL ** -0.5),
        'w_exp_down': nrm(ks[19], (L, N_EXPERTS, D_EXPERT, D_MODEL), D_EXPERT ** -0.5),
        'g_ple': 1.0 + nrm(ks[20], (L, D_MODEL), 0.01),
        'w_ple_gate': nrm(ks[21], (L, D_MODEL, D_MODEL), D_MODEL ** -0.5),
        'w_ple_proj': nrm(ks[22], (L, PLE_DIM, D_MODEL), PLE_DIM ** -0.5),
        'g_final': 1.0 + nrm(ks[23], (D_MODEL,), 0.01),
    }


def reference(x, p, g_mix, w_in, w_fourier, ssm_a_re, ssm_a_im, ssm_log_dt, ssm_b_re, ssm_b_im,
              ssm_c_re, ssm_c_im, ssm_d, w_glu, w_out, g_ffn, w_router, w_exp_gate, w_exp_up,
              w_exp_down, g_ple, w_ple_gate, w_ple_proj, g_final):
    for i in range(DEPTH):
        h = rmsnorm(x, g_mix[i])
        z = h @ w_in[i]
        u_f, u_s, gates = jnp.split(z, [D_FOURIER, D_FOURIER + D_SSM], axis=-1)
        y_f = fourier_mix(u_f) @ w_fourier[i]
        y_s = ssm_branch(u_s, ssm_a_re[i], ssm_a_im[i], ssm_log_dt[i], ssm_b_re[i], ssm_b_im[i],
                         ssm_c_re[i], ssm_c_im[i], ssm_d[i], w_glu[i])
        g_f, g_s = jnp.split(jax.nn.sigmoid(gates), N_BRANCHES, axis=-1)
        x = x + (g_f * y_f + g_s * y_s) @ w_out[i]
        x = x + expert_choice_ffn(rmsnorm(x, g_ffn[i]), w_router[i], w_exp_gate[i],
                                  w_exp_up[i], w_exp_down[i])
        e = p[i] @ w_ple_proj[i]
        x = x + jax.nn.sigmoid(rmsnorm(x, g_ple[i]) @ w_ple_gate[i]) * e
    return rmsnorm(x, g_final)
```

```cpp
#include <hip/hip_runtime.h>
#include <cstdint>
#include <cstdio>

#ifndef MK_N_LAUNCHES
#define MK_N_LAUNCHES 1
#endif

#define LAS __attribute__((address_space(3)))
#define GAS __attribute__((address_space(1)))
typedef unsigned short bf16;
typedef short bf16x8 __attribute__((ext_vector_type(8)));
typedef float f32x4 __attribute__((ext_vector_type(4)));
typedef float f32x2 __attribute__((ext_vector_type(2)));
typedef unsigned u32x2 __attribute__((ext_vector_type(2)));
typedef unsigned u32x4 __attribute__((ext_vector_type(4)));
typedef GAS unsigned gu32;

constexpr int NB = 4, SEQ = 8192, T = NB * SEQ, DM = 1024, DIN = 3072, NE = 16, DE = 2816, CAP = 1024, PLE = 256;
constexpr int NG = 32, NS = 64, LCH = 64, NCH = SEQ / LCH, NROWC = NB * NCH, KCAT = 1280;
constexpr float RMS_EPS = 1e-6f;
constexpr int NPH = 15;
constexpr int NTHR = 512;

constexpr size_t MiB = 1u << 20;
constexpr size_t WS_CTL = 0, CTL_BYTES = 1 * MiB;
constexpr size_t OFF_WFT = 1 * MiB;
constexpr size_t OFF_DFT1 = OFF_WFT + 1 * MiB;
constexpr size_t OFF_DFT2 = OFF_DFT1 + 64 * 1024;
constexpr size_t OFF_TW = OFF_DFT2 + 64 * 1024;
constexpr size_t OFF_L64 = OFF_TW + 64 * 1024;
constexpr size_t OFF_WGT = OFF_L64 + 64 * 1024;
constexpr size_t OFF_AFF = OFF_WGT + 64 * 1024;
constexpr size_t OFF_IDX = OFF_AFF + 2 * MiB;
constexpr size_t OFF_VAL = OFF_IDX + 256 * 1024;
constexpr size_t OFF_SLOT = OFF_VAL + 256 * 1024;
constexpr size_t OFF_RST = OFF_SLOT + 2 * MiB;
constexpr size_t OFF_RSD = OFF_RST + 128 * 1024;
constexpr size_t OFF_RSS = OFF_RSD + 128 * 1024;
static_assert(OFF_RSS + 256 * 1024 <= 16 * MiB, "small region");
constexpr size_t OFF_WB = 16 * MiB;
constexpr size_t OFF_WGLU = OFF_WB + 5 * MiB;
constexpr size_t OFF_WF = OFF_WGLU + 2 * MiB;
constexpr size_t OFF_WOUT = OFF_WF + 1 * MiB;
constexpr size_t OFF_WPG = OFF_WOUT + 2 * MiB;
constexpr size_t OFF_WPP = OFF_WPG + 2 * MiB;
constexpr size_t WS_H = 32 * MiB;
constexpr size_t WS_R = 96 * MiB;
constexpr size_t WS_GF = WS_R, WS_MIXF = WS_R, WS_MIX = WS_R;
constexpr size_t WS_GS = WS_R + 64 * MiB, WS_XT = WS_R + 128 * MiB, WS_Y = WS_R + 160 * MiB, WS_FMIX = WS_R + 224 * MiB,
                 WS_ACAT = WS_R + 256 * MiB, WS_YS = WS_R + 296 * MiB, WS_EE = WS_R + 328 * MiB;
constexpr size_t WS_KC = WS_R + 352 * MiB;
constexpr size_t WS_CT = WS_R + 356 * MiB;
constexpr size_t WS_WEND = WS_R + 432 * MiB;
constexpr size_t WS_HID = WS_R;
constexpr size_t WS_WGU = WS_R + 352 * MiB;
constexpr size_t WS_WD = WS_R + 528 * MiB;
constexpr size_t WS_YB = WS_WGU;
constexpr size_t WS_PB = WS_R + 496 * MiB;
constexpr size_t WS_X2B = WS_R + 64 * MiB;
constexpr size_t WS_X3B = WS_R + 128 * MiB;
constexpr size_t WS_EB = WS_R + 192 * MiB;
constexpr size_t WS_END = WS_R + 616 * MiB;
static_assert(OFF_SLOT + 2 * MiB <= OFF_WB && OFF_WPP + 1 * MiB <= WS_H && WS_EE + 16 * MiB <= WS_WGU && WS_PB >= WS_YB + 128 * MiB && WS_PB + 16 * MiB <= WS_WD && WS_EB >= WS_HID + 176 * MiB && WS_EB + 64 * MiB <= WS_WGU, "ws map");

typedef __bf16 bf16v2_t __attribute__((ext_vector_type(2)));
__device__ __forceinline__ unsigned cvt_pk_bf16(float lo, float hi) { const bf16v2_t v = __builtin_convertvector((f32x2){lo, hi}, bf16v2_t); return __builtin_bit_cast(unsigned, v); }
__device__ __forceinline__ float clamp8(float v) { return fminf(fmaxf(v, -440.0f), 440.0f); }
__device__ __forceinline__ float bf2f(unsigned short h) { return __uint_as_float(((unsigned)h) << 16); }
__device__ __forceinline__ float sigmoidf_(float x) { return __builtin_amdgcn_rcpf(1.0f + __expf(-x)); }
__device__ __forceinline__ float gelu_tanh(float x) { const float u = 0.7978845608028654f * (x + 0.044715f * x * x * x); return x * __builtin_amdgcn_rcpf(1.0f + __expf(-2.0f * u)); }
__device__ __forceinline__ float wave_sum(float v) {
#pragma unroll
    for (int o = 1; o < 64; o <<= 1) v += __shfl_xor(v, o);
    return v;
}
__device__ __forceinline__ bf16x8 pack8(const f32x4 a, const f32x4 b) {
    u32x4 w; w.x = cvt_pk_bf16(a.x, a.y); w.y = cvt_pk_bf16(a.z, a.w); w.z = cvt_pk_bf16(b.x, b.y); w.w = cvt_pk_bf16(b.z, b.w);
    return __builtin_bit_cast(bf16x8, w);
}
__device__ __forceinline__ void store_bf16x4(bf16* p, const f32x4 v) { u32x2 w; w.x = cvt_pk_bf16(v.x, v.y); w.y = cvt_pk_bf16(v.z, v.w); *(u32x2*)p = w; }
__device__ __forceinline__ f32x4 load_bf16x4(const bf16* p) { const u32x2 w = *(const u32x2*)p; f32x4 r; r.x = __uint_as_float(w.x << 16); r.y = __uint_as_float(w.x & 0xffff0000u); r.z = __uint_as_float(w.y << 16); r.w = __uint_as_float(w.y & 0xffff0000u); return r; }

__device__ __forceinline__ int lane_id_here() { unsigned z = 0u; asm volatile("" : "+v"(z)); return (int)__builtin_amdgcn_mbcnt_hi(~0u, __builtin_amdgcn_mbcnt_lo(~0u, z)); }
#define XB_TMO      128
#define XB_XCNT(j)  (256  + 64 * (j))
#define XB_XSUB(j)  (1280 + 64 * (j))
#define XB_XGEN(j)  (2304 + 64 * (j))
#define XB_TOP      3328
#define XB_TOPGEN   3392
#define XCD_BAR_WORDS 3456
#define XB_SPIN_CAP (1u << 22)
__device__ __forceinline__ unsigned xb_ld(unsigned* p)              { return __hip_atomic_load(p, __ATOMIC_RELAXED, __HIP_MEMORY_SCOPE_AGENT); }
__device__ __forceinline__ unsigned xb_add(unsigned* p, unsigned v) { return __hip_atomic_fetch_add(p, v, __ATOMIC_RELAXED, __HIP_MEMORY_SCOPE_AGENT); }
__device__ __forceinline__ unsigned xb_xcc_id() { return (unsigned)__builtin_amdgcn_s_getreg((3 << 11) | 20) & 0xFu; }
#define XB_SPIN(cond, bar) do { unsigned _sp = 0; while (cond) { __builtin_amdgcn_s_sleep(1); \
    if ((++_sp & 255u) == 0u) { if (xb_ld(&(bar)[XB_TMO])) break; if (_sp > XB_SPIN_CAP) { atomicAdd(&(bar)[XB_TMO], 1u); break; } } } } while (0)
struct XcdBarrier { unsigned* bar; unsigned x; volatile LAS unsigned* st; int wave; };
__device__ __forceinline__ XcdBarrier xcd_barrier_post(unsigned* bar, volatile LAS unsigned* st, int wave) {
    XcdBarrier b; b.bar = bar; b.x = xb_xcc_id(); b.st = st; b.wave = wave;
    if (wave == 0 && lane_id_here() == 0) (void)xb_add(&bar[XB_XCNT(b.x)], 1u);
    return b;
}
__device__ __forceinline__ void xcd_barrier_complete(unsigned* bar, unsigned x, unsigned& nloc, unsigned& nx) {
    const unsigned G = gridDim.x * gridDim.y * gridDim.z;
    unsigned sum, cnt, mine, sp = 0u;
    for (;;) {
        sum = 0u; cnt = 0u; mine = 0u;
#pragma unroll
        for (unsigned j = 0; j < 16; ++j) { const unsigned c = xb_ld(&bar[XB_XCNT(j)]); sum += c; cnt += (c > 0u) ? 1u : 0u; mine = (j == x) ? c : mine; }
        if (sum == G) break;
        __builtin_amdgcn_s_sleep(1);
        if ((++sp & 255u) == 0u) { if (xb_ld(&bar[XB_TMO])) break; if (sp > XB_SPIN_CAP) { atomicAdd(&bar[XB_TMO], 1u); break; } }
    }
    nloc = mine > 0u ? mine : 1u; nx = cnt > 0u ? cnt : 1u;
}
__device__ __forceinline__ void xcd_barrier(const XcdBarrier& b) {
    asm volatile("s_waitcnt vmcnt(0)" ::: "memory");
    __syncthreads();
    if (b.wave == 0 && lane_id_here() == 0) {
        unsigned* bar = b.bar;
        __builtin_amdgcn_s_waitcnt(0);
        unsigned nloc = b.st[0], nx = b.st[1];
        if (nloc == 0u) { xcd_barrier_complete(bar, b.x, nloc, nx); b.st[0] = nloc; b.st[1] = nx; }
        const unsigned old = xb_add(&bar[XB_XSUB(b.x)], 1u);
        const unsigned gen = old / nloc;
        if (old + 1u == (gen + 1u) * nloc) {
            __builtin_amdgcn_fence(__ATOMIC_RELEASE, "agent");
            asm volatile("s_waitcnt vmcnt(0)" ::: "memory");
            const unsigned og = xb_add(&bar[XB_TOP], 1u);
            const unsigned tg = og / nx;
            if (og + 1u == (tg + 1u) * nx) xb_add(&bar[XB_TOPGEN], 1u);
            else XB_SPIN(xb_ld(&bar[XB_TOPGEN]) == tg, bar);
            __builtin_amdgcn_fence(__ATOMIC_ACQUIRE, "agent");
            xb_add(&bar[XB_XGEN(b.x)], 1u);
            asm volatile("s_waitcnt vmcnt(0)" ::: "memory");
        } else {
            XB_SPIN(xb_ld(&bar[XB_XGEN(b.x)]) == gen, bar);
            __builtin_amdgcn_fence(__ATOMIC_ACQUIRE, "agent");
            asm volatile("s_waitcnt vmcnt(0)" ::: "memory");
        }
    }
    __syncthreads();
}

constexpr int GG_LDS_ROW = 144;
constexpr int GG_LDS_B = 128 * GG_LDS_ROW;
template <class AF, class BF, class EF>
__device__ __forceinline__ void gg_tile(LAS unsigned char* lds, const AF& af, const BF& bfn, const EF& ef, int m0, int n0, int K, int wid) {
    const int lane = lane_id_here(), tid = wid * 64 + lane, wr = wid >> 2, wc = wid & 3, fr = lane & 15, fq = lane >> 4;
    const int a_row = AF::ROWFAST ? (tid & 127) : (tid >> 2), a_kc = AF::ROWFAST ? (tid >> 7) : (tid & 3);
    const int b_row = BF::ROWFAST ? (tid & 127) : (tid >> 2), b_kc = BF::ROWFAST ? (tid >> 7) : (tid & 3);
    f32x4 acc[4][2];
#pragma unroll
    for (int m = 0; m < 4; ++m)
#pragma unroll
        for (int n = 0; n < 2; ++n) acc[m][n] = (f32x4){0.f, 0.f, 0.f, 0.f};
    bf16x8 av[2][2], bv[2][2];
#pragma unroll
    for (int d = 0; d < 2; ++d)
#pragma unroll
        for (int h = 0; h < 2; ++h) { av[d][h] = af.load8(m0 + a_row, 64 * d + 32 * h + a_kc * 8); bv[d][h] = bfn.load8(n0 + b_row, 64 * d + 32 * h + b_kc * 8); }
    for (int k0 = 0; k0 < K; k0 += 128) {
#pragma unroll
        for (int d = 0; d < 2; ++d) {
            __syncthreads();
#pragma unroll
            for (int h = 0; h < 2; ++h) { *(LAS bf16x8*)(lds + a_row * GG_LDS_ROW + h * 64 + a_kc * 16) = av[d][h]; *(LAS bf16x8*)(lds + GG_LDS_B + b_row * GG_LDS_ROW + h * 64 + b_kc * 16) = bv[d][h]; }
            __syncthreads();
            if (k0 + 128 < K) {
#pragma unroll
                for (int h = 0; h < 2; ++h) { av[d][h] = af.load8(m0 + a_row, k0 + 128 + 64 * d + 32 * h + a_kc * 8); bv[d][h] = bfn.load8(n0 + b_row, k0 + 128 + 64 * d + 32 * h + b_kc * 8); } }
#pragma unroll
            for (int h = 0; h < 2; ++h) { bf16x8 Af[4], Bf[2];
#pragma unroll
                for (int m = 0; m < 4; ++m) Af[m] = *(const LAS bf16x8*)(lds + (wr * 64 + m * 16 + fr) * GG_LDS_ROW + h * 64 + fq * 16);
#pragma unroll
                for (int n = 0; n < 2; ++n) Bf[n] = *(const LAS bf16x8*)(lds + GG_LDS_B + (wc * 32 + n * 16 + fr) * GG_LDS_ROW + h * 64 + fq * 16);
#pragma unroll
                for (int m = 0; m < 4; ++m)
#pragma unroll
                    for (int n = 0; n < 2; ++n) acc[m][n] = __builtin_amdgcn_mfma_f32_16x16x32_bf16(Bf[n], Af[m], acc[m][n], 0, 0, 0); }
        }
    }
    ef.tile(m0 + wr * 64 + fr, n0 + wc * 32 + fq * 4, acc);
}

struct OpTrivA { static constexpr bool ROWFAST = false;
    __device__ __forceinline__ bf16x8 load8(int row, int k0) const { float v[8];
#pragma unroll
        for (int q = 0; q < 8; ++q) v[q] = (float)(((row * 5 + k0 + q) & 15) - 8);
        return pack8((f32x4){v[0], v[1], v[2], v[3]}, (f32x4){v[4], v[5], v[6], v[7]}); } };
struct OpBf16Rows {
    static constexpr bool ROWFAST = false; const bf16* p; int ld;
    __device__ __forceinline__ bf16x8 load8(int row, int k0) const { return *(const bf16x8*)(p + (size_t)row * ld + k0); }
};
struct OpF32Rows {
    static constexpr bool ROWFAST = false; const float* p; int ld;
    __device__ __forceinline__ bf16x8 load8(int row, int k0) const { const f32x4* q = (const f32x4*)(p + (size_t)row * ld + k0); return pack8(q[0], q[1]); }
};
struct OpF32KN {
    static constexpr bool ROWFAST = true; const float* p; int ld; int c0;
    __device__ __forceinline__ bf16x8 load8(int n, int k0) const {
        const float* q = p + (size_t)k0 * ld + c0 + n; float v[8];
#pragma unroll
        for (int j = 0; j < 8; ++j) v[j] = q[(size_t)j * ld];
        return pack8((f32x4){v[0], v[1], v[2], v[3]}, (f32x4){v[4], v[5], v[6], v[7]});
    }
};
struct OpF32KNPair {
    static constexpr bool ROWFAST = true; const float* w0; long delta; int ld;
    __device__ __forceinline__ bf16x8 load8(int n, int k0) const {
        const int f = ((n >> 5) << 4) | (n & 15); const float* q = w0 + (long)((n >> 4) & 1) * delta + (size_t)k0 * ld + f; float v[8];
#pragma unroll
        for (int j = 0; j < 8; ++j) v[j] = q[(size_t)j * ld];
        return pack8((f32x4){v[0], v[1], v[2], v[3]}, (f32x4){v[4], v[5], v[6], v[7]});
    }
};


struct Args { const float* in[24]; float* out; unsigned char* ws; int ph_lo, ph_hi; };
typedef const __attribute__((address_space(4))) Args* KArgs;
struct Frame {
    LAS unsigned char* lds; int wave, G, bid;
    unsigned char* ws; float* xo;
    __device__ __forceinline__ int lane() const { return lane_id_here(); }
    __device__ __forceinline__ int tid() const { return wave * 64 + lane_id_here(); }
};

namespace pg8 {
constexpr int BM = 256, BK = 64, HALF = 128, HTB = HALF * BK * 2, STAGE_BYTES = 8 * HTB, NXCD = 8, WGM = 8;
__device__ __forceinline__ int lds_byte(int r, int c) { const int st = (r >> 4) * 2 + (c >> 5), rr = r & 15, cc = c & 31, ob = rr * 64 + cc * 2; return st * 1024 + (ob ^ (((ob >> 9) & 1) << 5)); }
__device__ __forceinline__ void stage_rc(int b, int& R, int& C) { const int st = b / 1024, sb = b % 1024, swz = sb ^ (((sb >> 9) & 1) << 5); R = (st >> 1) * 16 + swz / 64; C = (st & 1) * 32 + (swz % 64) / 2; }
__device__ __forceinline__ int perm32(int rho) { const int n = rho >> 4, i = rho & 15; return 8 * (i >> 2) + 4 * n + (i & 3); }
struct Unit { int pm, pn; };
typedef int v8i_t __attribute__((ext_vector_type(8)));
__device__ __forceinline__ v8i_t cat8(const bf16x8 lo, const bf16x8 hi) { typedef int v4i_t __attribute__((ext_vector_type(4))); const v4i_t a = __builtin_bit_cast(v4i_t, lo), b = __builtin_bit_cast(v4i_t, hi); return (v8i_t){a.x, a.y, a.z, a.w, b.x, b.y, b.z, b.w}; }
struct StaticOrder {
    int nM, nN, nwg, G, c;
    __device__ void init(int M, int N, int G_, int c_) { nM = M / BM; nN = N / BM; nwg = nM * nN; G = G_; c = c_; }
    __device__ bool next(int i, Unit& u) const {
        const long L = (long)i * G + c; if (L >= nwg) return false;
        int wgid = (int)L; { const int q = nwg / NXCD, r = nwg % NXCD, xcd = wgid % NXCD, off = wgid / NXCD; wgid = (xcd < r ? xcd * (q + 1) : r * (q + 1) + (xcd - r) * q) + off; }
        const int nig = WGM * nN, gid = wgid / nig, fm = gid * WGM, gsz = (nM - fm) < WGM ? (nM - fm) : WGM;
        u.pm = fm + ((wgid % nig) % gsz); u.pn = (wgid % nig) / gsz; return true;
    }
};
struct ExpertOrder {
    int nN, nwg, G, c;
    __device__ void init(int nN_, int G_, int c_) { nN = nN_; nwg = NE * 16 * nN_; G = G_; c = c_; }
    __device__ bool next(int i, Unit& u) const { const long L = (long)i * G + c; if (L >= nwg) return false;
        int combo = (int)(L >> 4), pml = (int)(L & 15);
        if (G == 256) { const int x = c & 7, j = c >> 3; combo = 16 * i + 4 * (x >> 1) + (j >> 3); pml = 8 * (x & 1) + (j & 7); }
        const int e = combo / nN; u.pn = combo - e * nN; u.pm = e * 16 + pml; return true; }
};
struct PolPlain {
    static constexpr bool DYN = false, FP8 = false, BSWITCH = false; const bf16* A; const bf16* Bt; int lda, ldb, K;
    __device__ __forceinline__ const char* a_base(const Unit& u) const { return (const char*)(A + (size_t)u.pm * BM * lda); }
    __device__ __forceinline__ const char* b_base(const Unit& u) const { return (const char*)(Bt + (size_t)u.pn * BM * ldb); }
    __device__ __forceinline__ unsigned a_off(int h, int R, int C, const Unit&) const { return (unsigned)((h * HALF + R) * lda + C) * 2u; }
    __device__ __forceinline__ unsigned b_off(int h, int R, int C) const { return (unsigned)((h * HALF + R) * ldb + C) * 2u; }
};
struct PolG1a {
    static constexpr bool DYN = false, FP8 = false, BSWITCH = false; const bf16* A; const bf16* H; int K;
    __device__ __forceinline__ const char* a_base(const Unit& u) const { return (const char*)(A + (size_t)u.pm * BM * DM); }
    __device__ __forceinline__ const char* b_base(const Unit& u) const { return (const char*)(H + ((size_t)(u.pn >> 5) * SEQ + 2 * (u.pn & 31)) * DM); }
    __device__ __forceinline__ unsigned a_off(int h, int R, int C, const Unit&) const { return (unsigned)((h * HALF + R) * DM + C) * 2u; }
    __device__ __forceinline__ unsigned b_off(int h, int R, int C) const { return (unsigned)((64 * R + h) * DM + C) * 2u; }
};
struct PolExpUp {
    static constexpr bool DYN = true, FP8 = false, BSWITCH = false; const bf16* H2; const int* idx; const bf16* W; int K;
    __device__ __forceinline__ const char* a_base(const Unit&) const { return (const char*)H2; }
    __device__ __forceinline__ const char* b_base(const Unit& u) const { return (const char*)(W + ((size_t)(u.pm >> 4) * (2 * DE) + (size_t)u.pn * BM) * DM); }
    __device__ __forceinline__ unsigned a_off(int h, int R, int C, const Unit& u) const { return (unsigned)idx[u.pm * BM + h * HALF + R] * (unsigned)(DM * 2) + (unsigned)C * 2u; }
    __device__ __forceinline__ unsigned b_off(int h, int R, int C) const { return (unsigned)((h * HALF + R) * DM + C) * 2u; }
};
struct PolExpUp8 {
    static constexpr bool DYN = true, FP8 = true, BSWITCH = false; const unsigned char* H2; const int* idx; const unsigned char* W; int K;
    __device__ __forceinline__ const char* a_base(const Unit&) const { return (const char*)H2; }
    __device__ __forceinline__ const char* b_base(const Unit& u) const { return (const char*)(W + ((size_t)(u.pm >> 4) * (2 * DE) + (size_t)u.pn * BM) * DM); }
    __device__ __forceinline__ unsigned a_off(int h, int R, int C, const Unit& u) const { return (unsigned)idx[u.pm * BM + h * HALF + R] * (unsigned)DM + (unsigned)C * 2u; }
    __device__ __forceinline__ unsigned b_off(int h, int R, int C) const { return (unsigned)((h * HALF + R) * DM) + (unsigned)C * 2u; }
};
struct PolExpDown8 {
    static constexpr bool DYN = false, FP8 = true, BSWITCH = false; const unsigned char* A; const unsigned char* W; int K;
    __device__ __forceinline__ const char* a_base(const Unit& u) const { return (const char*)(A + (size_t)u.pm * BM * DE); }
    __device__ __forceinline__ const char* b_base(const Unit& u) const { return (const char*)(W + ((size_t)(u.pm >> 4) * DM + (size_t)u.pn * BM) * DE); }
    __device__ __forceinline__ unsigned a_off(int h, int R, int C, const Unit&) const { return (unsigned)((h * HALF + R) * DE) + (unsigned)C * 2u; }
    __device__ __forceinline__ unsigned b_off(int h, int R, int C) const { return (unsigned)((h * HALF + R) * DE) + (unsigned)C * 2u; }
};
struct PolExpDown {
    static constexpr bool DYN = false, FP8 = false, BSWITCH = false; const bf16* A; const bf16* W; int K;
    __device__ __forceinline__ const char* a_base(const Unit& u) const { return (const char*)(A + (size_t)u.pm * BM * DE); }
    __device__ __forceinline__ const char* b_base(const Unit& u) const { return (const char*)(W + ((size_t)(u.pm >> 4) * DM + (size_t)u.pn * BM) * DE); }
    __device__ __forceinline__ unsigned a_off(int h, int R, int C, const Unit&) const { return (unsigned)((h * HALF + R) * DE + C) * 2u; }
    __device__ __forceinline__ unsigned b_off(int h, int R, int C) const { return (unsigned)((h * HALF + R) * DE + C) * 2u; }
};

struct PolPassB {
    static constexpr bool DYN = false, FP8 = false, BSWITCH = false; const bf16* A; const bf16* W; int K;
    __device__ __forceinline__ const char* a_base(const Unit& u) const { return (const char*)(A + (size_t)u.pm * BM * KCAT); }
    __device__ __forceinline__ const char* b_base(const Unit& u) const { return (const char*)(W + ((size_t)(u.pm >> 1) * 1024 + (size_t)u.pn * BM) * KCAT); }
    __device__ __forceinline__ unsigned a_off(int h, int R, int C, const Unit&) const { return (unsigned)((h * HALF + R) * KCAT + C) * 2u; }
    __device__ __forceinline__ unsigned b_off(int h, int R, int C) const { return (unsigned)((h * HALF + R) * KCAT + C) * 2u; }
};
struct PolStageC {
    static constexpr bool DYN = false, FP8 = false, BSWITCH = false; const bf16* A; const bf16* Y; int K;
    __device__ __forceinline__ const char* a_base(const Unit&) const { return (const char*)A; }
    __device__ __forceinline__ const char* b_base(const Unit& u) const { return (const char*)(Y + (size_t)u.pn * 2 * 128 * 128); }
    __device__ __forceinline__ unsigned a_off(int h, int R, int C, const Unit&) const { return (unsigned)((h * HALF + R) * 128 + C) * 2u; }
    __device__ __forceinline__ unsigned b_off(int h, int R, int C) const { return (unsigned)((((R >> 6) * 128 + h * 64 + (R & 63)) * 128) + C) * 2u; }
};
struct PolPassB2 {
    static constexpr bool DYN = false, FP8 = false, BSWITCH = true; static constexpr int KSW = 16;
    const bf16* A; const bf16* KC; const bf16* CT; int K;
    __device__ __forceinline__ const char* a_base(const Unit& u) const { return (const char*)(A + (size_t)u.pm * BM * KCAT); }
    __device__ __forceinline__ unsigned a_off(int h, int R, int C, const Unit&) const { return (unsigned)((h * HALF + R) * KCAT + C) * 2u; }
    __device__ __forceinline__ const char* b_base(const Unit& u) const { return (const char*)(KC + (size_t)(u.pm >> 1) * (128 * 256)) + (size_t)u.pn * 8192; }
    __device__ __forceinline__ unsigned b_off(int h, int R, int C) const { const int row = h * HALF + R; return (unsigned)((((row >> 4) - (C >> 4) + 63) * 256 + (row & 15) * 16 + (C & 15)) * 2); }
    __device__ __forceinline__ long kstepB1() const { return -2048; }
    __device__ __forceinline__ const char* b_base2(const Unit& u) const { return (const char*)(CT + ((size_t)(u.pm >> 1) * 1024 + (size_t)u.pn * BM) * 256); }
    __device__ __forceinline__ unsigned b_off2(int h, int R, int C) const { return (unsigned)((h * HALF + R) * 256 + C) * 2u; }
    __device__ __forceinline__ long kstepB2() const { return 128; }
};
struct LinearOrder {
    int nN, nwg, G, c;
    __device__ void init(int nM_, int nN_, int G_, int c_) { nN = nN_; nwg = nM_ * nN_; G = G_; c = c_; }
    __device__ bool next(int i, Unit& u) const { const long L = (long)i * G + c; if (L >= nwg) return false; u.pm = (int)(L / nN); u.pn = (int)(L % nN); return true; }
};
template <class E, class = void> struct epi_side { static constexpr bool v = false; };
template <class E> struct epi_side<E, decltype((void)E::SIDE)> { static constexpr bool v = E::SIDE; };
constexpr int LDS_SIDE = 132 * 1024;
template <class Pol> __device__ __forceinline__ constexpr int ksw_of() { if constexpr (Pol::BSWITCH) return Pol::KSW; else return 0; }
template <class Pol, class Epi, class Sched>
__device__ __forceinline__ void gemm_phase(LAS unsigned char* lds, const Pol& P, const Sched& S, const Epi& E, int wid) {
    const int lane = lane_id_here(), tid = wid * 64 + lane, wr = wid >> 2, wc = wid & 3, fr = lane & 15, fq = lane >> 4;
    int nt = P.K / BK; asm volatile("" : "+s"(nt));
    Unit cur, nxt; int ui = 0;
    if (!S.next(0, cur)) return;
    int sR[2], sC[2], sRb[2];
#pragma unroll
    for (int i = 0; i < 2; ++i) { stage_rc(tid * 16 + i * 8192, sR[i], sC[i]); sRb[i] = Epi::PERM ? ((sR[i] & ~31) + perm32(sR[i] & 31)) : sR[i]; }
    unsigned vA[2][2], vB[2], vB2[2], vAn[2][2];
    const size_t hsB1 = (size_t)(P.b_off(1, 0, 0) - P.b_off(0, 0, 0)); size_t hsB2 = 0;
#pragma unroll
    for (int i = 0; i < 2; ++i) { vB[i] = P.b_off(0, sRb[i], sC[i]); vB2[i] = 0u;
#pragma unroll
        for (int h = 0; h < 2; ++h) { vA[h][i] = P.a_off(h, sR[i], sC[i], cur); vAn[h][i] = vA[h][i]; } }
    if constexpr (Pol::BSWITCH) { hsB2 = (size_t)(P.b_off2(1, 0, 0) - P.b_off2(0, 0, 0));
#pragma unroll
        for (int i = 0; i < 2; ++i) vB2[i] = P.b_off2(0, sRb[i], sC[i]); }
    if (Pol::DYN) asm volatile("s_waitcnt vmcnt(0)" ::: "memory");
    const size_t kstep = (size_t)(BK * 2);
    long ksB = (long)kstep, ksB2 = 0; if constexpr (Pol::BSWITCH) { ksB = P.kstepB1(); ksB2 = P.kstepB2(); }
    const unsigned ldsw = (unsigned)wid * 1024u;
    const int aoff = lds_byte(wr * 64 + fr, fq * 8), boff = lds_byte(wc * 32 + fr, fq * 8);
#define PG8_SA(b, h) (((b) * 2 + (h)) * HTB)
#define PG8_SB(b, h) ((4 + (b) * 2 + (h)) * HTB)
#define PG8_STG(bufoff, gbase, voff2) do { _Pragma("unroll") for (int _i = 0; _i < 2; ++_i) { unsigned _o = (voff2)[_i]; asm volatile("" : "+v"(_o));     \
        __builtin_amdgcn_global_load_lds((const unsigned*)((const char*)(gbase) + _o), (LAS unsigned*)(lds + (bufoff) + ldsw + _i * 8192), 16, 0, 0); } } while (0)
#define PG8_LDA(dst, b, h) do { if constexpr (Pol::FP8) { _Pragma("unroll") for (int m = 0; m < 4; ++m) dst##8[m] = cat8(*(const LAS bf16x8*)(lds + PG8_SA(b, h) + aoff + m * 2048), *(const LAS bf16x8*)(lds + PG8_SA(b, h) + aoff + m * 2048 + 1024)); } \
        else { _Pragma("unroll") for (int m = 0; m < 4; ++m) _Pragma("unroll") for (int k = 0; k < 2; ++k) dst[m][k] = *(const LAS bf16x8*)(lds + PG8_SA(b, h) + aoff + m * 2048 + k * 1024); } } while (0)
#define PG8_LDB(dst, b, h) do { if constexpr (Pol::FP8) { _Pragma("unroll") for (int n = 0; n < 2; ++n) dst##8[n] = cat8(*(const LAS bf16x8*)(lds + PG8_SB(b, h) + boff + n * 2048), *(const LAS bf16x8*)(lds + PG8_SB(b, h) + boff + n * 2048 + 1024)); } \
        else { _Pragma("unroll") for (int n = 0; n < 2; ++n) _Pragma("unroll") for (int k = 0; k < 2; ++k) dst[n][k] = *(const LAS bf16x8*)(lds + PG8_SB(b, h) + boff + n * 2048 + k * 1024); } } while (0)
#define PG8_MMA(ai, bj, At, Bt) do { __builtin_amdgcn_s_setprio(1); \
        if constexpr (Pol::FP8) { _Pragma("unroll") for (int m = 0; m < 4; ++m) _Pragma("unroll") for (int n = 0; n < 2; ++n) \
            acc[ai][bj][m][n] = __builtin_amdgcn_mfma_scale_f32_16x16x128_f8f6f4(Bt##8[n], At##8[m], acc[ai][bj][m][n], 0, 0, 0, 0x7f7f7f7f, 0, 0x7f7f7f7f); } \
        else { _Pragma("unroll") for (int m = 0; m < 4; ++m) _Pragma("unroll") for (int n = 0; n < 2; ++n) _Pragma("unroll") for (int k = 0; k < 2; ++k) \
            acc[ai][bj][m][n] = __builtin_amdgcn_mfma_f32_16x16x32_bf16(Bt[n][k], At[m][k], acc[ai][bj][m][n], 0, 0, 0); } \
        __builtin_amdgcn_s_setprio(0); } while (0)
#define PG8_WAIT_V(n) asm volatile("s_waitcnt vmcnt(" #n ")" ::: "memory")
#define PG8_WAIT_L(n) asm volatile("s_waitcnt lgkmcnt(" #n ")" ::: "memory")
#define PG8_BAR __builtin_amdgcn_s_barrier()
#define PG8_SCHED __builtin_amdgcn_sched_barrier(0)
    f32x4 acc[2][2][4][2];
#pragma unroll
    for (int a = 0; a < 2; ++a)
#pragma unroll
        for (int b = 0; b < 2; ++b)
#pragma unroll
            for (int m = 0; m < 4; ++m)
#pragma unroll
                for (int n = 0; n < 2; ++n) acc[a][b][m][n] = (f32x4){0.f, 0.f, 0.f, 0.f};
    bf16x8 At[4][2], B0[2][2], B1[2][2]; v8i_t At8[4], B08[2], B18[2]; (void)At; (void)B0; (void)B1; (void)At8; (void)B08; (void)B18;
    const char* cA = P.a_base(cur); const char* cB = P.b_base(cur);
    PG8_STG(PG8_SB(0, 0), cB, vB); PG8_STG(PG8_SB(0, 1), cB + hsB1, vB); PG8_STG(PG8_SA(0, 0), cA, vA[0]); PG8_STG(PG8_SA(0, 1), cA, vA[1]);
    if (wr == 1) PG8_BAR;
    PG8_WAIT_V(2); PG8_BAR;
    PG8_STG(PG8_SB(1, 0), cB + ksB, vB); PG8_STG(PG8_SA(1, 0), cA + kstep, vA[0]); PG8_STG(PG8_SB(1, 1), cB + ksB + hsB1, vB);
    PG8_WAIT_V(6); PG8_BAR;
    for (;;) {
        const bool has_next = S.next(ui + 1, nxt);
        const char* nA = has_next ? P.a_base(nxt) : cA; const char* nB = has_next ? P.b_base(nxt) : cB;
        const char* cB2 = cB; if constexpr (Pol::BSWITCH) cB2 = P.b_base2(cur);
        if constexpr (epi_side<Epi>::v) { if (wid == 0) { unsigned so = (unsigned)lane_id_here() * 16u; asm volatile("" : "+v"(so));
            __builtin_amdgcn_global_load_lds((const unsigned*)((const char*)E.side_ptr(cur) + so), (LAS unsigned*)(lds + LDS_SIDE + (ui & 1) * 1024), 16, 0, 0); } }
        if (Pol::DYN) {
            if (has_next) {
#pragma unroll
                for (int i = 0; i < 2; ++i) { int R_, C_; stage_rc(tid * 16 + i * 8192, R_, C_);
#pragma unroll
                    for (int h = 0; h < 2; ++h) vAn[h][i] = P.a_off(h, R_, C_, nxt); }
                asm volatile("s_waitcnt vmcnt(0)" ::: "memory");
            } else {
#pragma unroll
                for (int h = 0; h < 2; ++h)
#pragma unroll
                    for (int i = 0; i < 2; ++i) vAn[h][i] = vA[h][i];
            }
        }
        for (int t = 0; t < nt; t += 2) {
            const bool last = (t == nt - 2);
            const char* a1 = cA + (size_t)(t + 1) * kstep;
            const char* a2 = last ? nA : cA + (size_t)(t + 2) * kstep; const char* a3 = a2 + kstep;
            const char* b2; const char* b3; unsigned wB[2]; size_t hsB = hsB1;
            { bool r2 = false; if constexpr (Pol::BSWITCH) r2 = !last && (t + 2 >= ksw_of<Pol>());
              if (last) { b2 = nB; b3 = b2 + ksB; } else if (r2) { b2 = cB2 + (long)(t + 2 - ksw_of<Pol>()) * ksB2; b3 = b2 + ksB2; hsB = hsB2; } else { b2 = cB + (long)(t + 2) * ksB; b3 = b2 + ksB; }
#pragma unroll
              for (int i = 0; i < 2; ++i) wB[i] = r2 ? vB2[i] : vB[i]; }
            PG8_LDB(B0, 0, 0); PG8_LDB(B1, 0, 1); PG8_SCHED; PG8_LDA(At, 0, 0); PG8_STG(PG8_SA(1, 1), a1, vA[1]);
            if (Pol::DYN && last) {
#pragma unroll
                for (int h = 0; h < 2; ++h)
#pragma unroll
                    for (int i = 0; i < 2; ++i) vA[h][i] = vAn[h][i]; }
            PG8_WAIT_V(8); PG8_WAIT_L(0); PG8_BAR; PG8_MMA(0, 0, At, B0); PG8_MMA(0, 1, At, B1); PG8_BAR; PG8_SCHED;
            PG8_LDA(At, 0, 1); PG8_STG(PG8_SB(0, 0), b2, wB); PG8_STG(PG8_SB(0, 1), b2 + hsB, wB); PG8_STG(PG8_SA(0, 0), a2, vA[0]);
            PG8_WAIT_V(8); PG8_WAIT_L(0); PG8_BAR; PG8_MMA(1, 0, At, B0); PG8_MMA(1, 1, At, B1); PG8_BAR; PG8_SCHED;
            PG8_LDB(B0, 1, 0); PG8_LDB(B1, 1, 1); PG8_SCHED; PG8_LDA(At, 1, 0); PG8_STG(PG8_SA(0, 1), a2, vA[1]);
            PG8_WAIT_V(8); PG8_WAIT_L(0); PG8_BAR; PG8_MMA(0, 0, At, B0); PG8_MMA(0, 1, At, B1); PG8_BAR; PG8_SCHED;
            PG8_LDA(At, 1, 1); PG8_STG(PG8_SB(1, 0), b3, wB); PG8_STG(PG8_SB(1, 1), b3 + hsB, wB); PG8_STG(PG8_SA(1, 0), a3, vA[0]);
            PG8_WAIT_V(8); PG8_WAIT_L(0); PG8_BAR; PG8_MMA(1, 0, At, B0); PG8_MMA(1, 1, At, B1); PG8_BAR; PG8_SCHED;
        }
        if (wr == 0) PG8_BAR;
        { Unit eu = cur; int et = lane_id_here(); asm volatile("" : "+s"(eu.pm), "+s"(eu.pn), "+v"(et)); const int efr = et & 15, efq = (et >> 4) & 3;
          if constexpr (epi_side<Epi>::v) E(acc, eu, wr, wc, efr, efq, (const LAS float*)(lds + LDS_SIDE + (ui & 1) * 1024)); else E(acc, eu, wr, wc, efr, efq); }
        if (!has_next) break;
#pragma unroll
        for (int a = 0; a < 2; ++a)
#pragma unroll
            for (int b = 0; b < 2; ++b)
#pragma unroll
                for (int m = 0; m < 4; ++m)
#pragma unroll
                    for (int n = 0; n < 2; ++n) acc[a][b][m][n] = (f32x4){0.f, 0.f, 0.f, 0.f};
        cur = nxt; cA = nA; cB = nB; ++ui;
        if (Pol::DYN) {
#pragma unroll
            for (int h = 0; h < 2; ++h)
#pragma unroll
                for (int i = 0; i < 2; ++i) vA[h][i] = vAn[h][i];
        }
        if (wr == 1) PG8_BAR;
    }
    PG8_WAIT_V(0);
    PG8_BAR;
#undef PG8_SA
#undef PG8_SB
#undef PG8_STG
#undef PG8_LDA
#undef PG8_LDB
#undef PG8_MMA
#undef PG8_WAIT_V
#undef PG8_WAIT_L
#undef PG8_BAR
#undef PG8_SCHED
}

__device__ __forceinline__ u32x4 pk8(const f32x4 a, const f32x4 b) { u32x4 w; w.x = cvt_pk_bf16(a.x, a.y); w.y = cvt_pk_bf16(a.z, a.w); w.z = cvt_pk_bf16(b.x, b.y); w.w = cvt_pk_bf16(b.z, b.w); return w; }
__device__ __forceinline__ void unpk8(const u32x4 w, f32x4& a, f32x4& b) {
    a.x = __uint_as_float(w.x << 16); a.y = __uint_as_float(w.x & 0xffff0000u); a.z = __uint_as_float(w.y << 16); a.w = __uint_as_float(w.y & 0xffff0000u);
    b.x = __uint_as_float(w.z << 16); b.y = __uint_as_float(w.z & 0xffff0000u); b.z = __uint_as_float(w.w << 16); b.w = __uint_as_float(w.w & 0xffff0000u); }
__device__ __forceinline__ f32x4 sig4(const f32x4 v) { return (f32x4){sigmoidf_(v.x), sigmoidf_(v.y), sigmoidf_(v.z), sigmoidf_(v.w)}; }
#define PG8_EPI_LOOP for (int ai = 0; ai < 2; ++ai) _Pragma("unroll") for (int m = 0; m < 4; ++m) _Pragma("unroll") for (int bj = 0; bj < 2; ++bj)
struct EpiXt {
    static constexpr bool PERM = true; bf16* XT;
    __device__ __forceinline__ void operator()(const f32x4 (&acc)[2][2][4][2], const Unit& u, int wr, int wc, int fr, int fq) const {
        const int b = u.pn >> 5, n1 = wc * 32 + 8 * fq;
#pragma unroll
        PG8_EPI_LOOP { const int r = u.pm * BM + ai * HALF + wr * 64 + m * 16 + fr, g = r >> 7, pqc = r & 127, n2 = 2 * (u.pn & 31) + bj;
            *(u32x4*)(XT + ((((size_t)(b * 4 + g) * 128 + pqc) * 64 + n2) * 128 + n1)) = pk8(acc[ai][bj][m][0], acc[ai][bj][m][1]); }
    }
};
struct EpiG1b {
    static constexpr bool PERM = true; bf16* ACAT; bf16* GF; bf16* GS;
    __device__ __forceinline__ void operator()(const f32x4 (&acc)[2][2][4][2], const Unit& u, int wr, int wc, int fr, int fq) const {
#pragma unroll
        PG8_EPI_LOOP { const int r = u.pm * BM + ai * HALF + wr * 64 + m * 16 + fr, c = u.pn * BM + bj * HALF + wc * 32 + 8 * fq;
            if (c < 512) { const int g = c >> 4; *(u32x4*)(ACAT + ((size_t)(g * NROWC + (r >> 6)) * KCAT + (r & 63) * 16 + (c & 15))) = pk8(acc[ai][bj][m][0], acc[ai][bj][m][1]); }
            else { const int cc = c - 512; const u32x4 w = pk8(sig4(acc[ai][bj][m][0]), sig4(acc[ai][bj][m][1]));
                if (cc < 1024) *(u32x4*)(GF + (size_t)r * DM + cc) = w; else *(u32x4*)(GS + (size_t)r * DM + (cc - 1024)) = w; } }
    }
};
struct EpiPassB {
    static constexpr bool PERM = true; bf16* YS;
    __device__ __forceinline__ void operator()(const f32x4 (&acc)[2][2][4][2], const Unit& u, int wr, int wc, int fr, int fq) const {
#pragma unroll
        PG8_EPI_LOOP { const int r = u.pm * BM + ai * HALF + wr * 64 + m * 16 + fr, c = u.pn * BM + bj * HALF + wc * 32 + 8 * fq, g = r >> 9, s = c >> 4, o = c & 15;
            const f32x4 v0 = acc[ai][bj][m][0], v1 = acc[ai][bj][m][1];
            *(u32x4*)(YS + ((size_t)((r & 511) * 64 + s) * 512 + g * 16 + o)) = pk8((f32x4){gelu_tanh(v0.x), gelu_tanh(v0.y), gelu_tanh(v0.z), gelu_tanh(v0.w)}, (f32x4){gelu_tanh(v1.x), gelu_tanh(v1.y), gelu_tanh(v1.z), gelu_tanh(v1.w)}); }
    }
};
struct EpiStageA {
    static constexpr bool PERM = true; bf16* Y; const f32x2* TW;
    __device__ __forceinline__ void operator()(const f32x4 (&acc)[2][2][4][2], const Unit& u, int wr, int wc, int fr, int fq) const {
        const int bg = u.pn >> 5, n2 = 32 * (wc & 1) + 8 * fq;
        f32x2 tq0[4], tq1[4];
#pragma unroll
        for (int m = 0; m < 4; ++m) { const int k1 = 64 * wr + 16 * m + fr; tq0[m] = TW[n2 * k1]; tq1[m] = TW[k1]; }
        asm volatile("s_waitcnt vmcnt(0)" ::: "memory");
#pragma unroll
        for (int m = 0; m < 4; ++m) { const int k1 = 64 * wr + 16 * m + fr; const f32x2 t0 = tq0[m], t1 = tq1[m];
            float twc[8], tws[8]; twc[0] = t0.x; tws[0] = t0.y;
#pragma unroll
            for (int q = 1; q < 8; ++q) { twc[q] = twc[q - 1] * t1.x - tws[q - 1] * t1.y; tws[q] = tws[q - 1] * t1.x + twc[q - 1] * t1.y; }
#pragma unroll
            for (int bj = 0; bj < 2; ++bj) { const int pqc = 4 * (u.pn & 31) + 2 * bj + (wc >> 1); f32x4 xr[2], xi[2];
#pragma unroll
                for (int n = 0; n < 2; ++n)
#pragma unroll
                    for (int j = 0; j < 4; ++j) { const float c_ = twc[4 * n + j], s_ = tws[4 * n + j], ar = acc[0][bj][m][n][j], ai_ = acc[1][bj][m][n][j];
                        const float br = ar * c_ + ai_ * s_, bi = ai_ * c_ - ar * s_; if (pqc >= 65) { xr[n][j] = -bi; xi[n][j] = br; } else { xr[n][j] = br; xi[n][j] = bi; } }
                bf16* yp = Y + (((size_t)(bg * 128 + k1) * 128 + pqc) * 128 + n2); *(u32x4*)yp = pk8(xr[0], xr[1]); *(u32x4*)(yp + 64) = pk8(xi[0], xi[1]); }
            asm volatile("" ::: "memory"); }
    }
};
struct EpiStageC {
    static constexpr bool PERM = true; bf16* FM;
    __device__ __forceinline__ void operator()(const f32x4 (&acc)[2][2][4][2], const Unit& u, int wr, int wc, int fr, int fq) const {
        if (wr != 0) return;
        const int bgk1 = 2 * u.pn + (wc >> 1), bg = bgk1 >> 7, k1 = bgk1 & 127, b = bg >> 2, g = bg & 3, c0 = 32 * (wc & 1) + 8 * fq;
#pragma unroll
        for (int m = 0; m < 4; ++m) { const int k2 = 16 * m + fr; f32x4 dr0 = acc[0][0][m][0] - acc[0][1][m][0], dr1 = acc[0][0][m][1] - acc[0][1][m][1], mr0 = acc[0][0][m][0] + acc[0][1][m][0], mr1 = acc[0][0][m][1] + acc[0][1][m][1];
            if (c0 == 0) { dr0.x = acc[0][0][m][0].x; mr0.x = acc[0][1][m][0].x; }
            bf16* o = FM + (size_t)(b * SEQ + k1 + 128 * k2) * 512 + g * 128 + c0; *(u32x4*)o = pk8(dr0, dr1); *(u32x4*)(o + 64) = pk8(mr0, mr1); }
    }
};
struct EpiBf16 {
    static constexpr bool PERM = true; bf16* O; int ld;
    __device__ __forceinline__ void operator()(const f32x4 (&acc)[2][2][4][2], const Unit& u, int wr, int wc, int fr, int fq) const {
#pragma unroll
        PG8_EPI_LOOP { const int r = u.pm * BM + ai * HALF + wr * 64 + m * 16 + fr, c = u.pn * BM + bj * HALF + wc * 32 + 8 * fq;
            *(u32x4*)(O + (size_t)r * ld + c) = pk8(acc[ai][bj][m][0], acc[ai][bj][m][1]); }
    }
};
struct EpiMulInPlace {
    static constexpr bool PERM = true; bf16* O;
    __device__ __forceinline__ void operator()(const f32x4 (&acc)[2][2][4][2], const Unit& u, int wr, int wc, int fr, int fq) const {
#pragma unroll
        for (int ai = 0; ai < 2; ++ai) { u32x4 t[4][2];
#pragma unroll
            for (int m = 0; m < 4; ++m)
#pragma unroll
                for (int bj = 0; bj < 2; ++bj) t[m][bj] = *(const u32x4*)(O + (size_t)(u.pm * BM + ai * HALF + wr * 64 + m * 16 + fr) * DM + u.pn * BM + bj * HALF + wc * 32 + 8 * fq);
#pragma unroll
            for (int m = 0; m < 4; ++m)
#pragma unroll
                for (int bj = 0; bj < 2; ++bj) { bf16* p = O + (size_t)(u.pm * BM + ai * HALF + wr * 64 + m * 16 + fr) * DM + u.pn * BM + bj * HALF + wc * 32 + 8 * fq;
                    f32x4 g0, g1; unpk8(t[m][bj], g0, g1); *(u32x4*)p = pk8(acc[ai][bj][m][0] * g0, acc[ai][bj][m][1] * g1); } }
    }
};
struct EpiGlu {
    static constexpr bool PERM = true; bf16* MIX; const bf16* GS;
    __device__ __forceinline__ void operator()(const f32x4 (&acc)[2][2][4][2], const Unit& u, int wr, int wc, int fr, int fq) const {
#pragma unroll
        for (int ai = 0; ai < 2; ++ai) { u32x4 ts[4], tx[4];
#pragma unroll
            for (int m = 0; m < 4; ++m) { const size_t off = (size_t)(u.pm * BM + ai * HALF + wr * 64 + m * 16 + fr) * DM + u.pn * HALF + wc * 32 + 8 * fq; ts[m] = *(const u32x4*)(GS + off); tx[m] = *(const u32x4*)(MIX + off); }
#pragma unroll
            for (int m = 0; m < 4; ++m) { const size_t off = (size_t)(u.pm * BM + ai * HALF + wr * 64 + m * 16 + fr) * DM + u.pn * HALF + wc * 32 + 8 * fq;
                f32x4 s0, s1, x0, x1; unpk8(ts[m], s0, s1); unpk8(tx[m], x0, x1);
                *(u32x4*)(MIX + off) = pk8(acc[ai][0][m][0] * sig4(acc[ai][1][m][0]) * s0 + x0, acc[ai][0][m][1] * sig4(acc[ai][1][m][1]) * s1 + x1); } }
    }
};
struct EpiResidual {
    static constexpr bool PERM = false; float* O; const float* X;
    __device__ __forceinline__ void operator()(const f32x4 (&acc)[2][2][4][2], const Unit& u, int wr, int wc, int fr, int fq) const {
#pragma unroll
        for (int ai = 0; ai < 2; ++ai)
#pragma unroll
            for (int mp = 0; mp < 2; ++mp) { f32x4 t[2][2][2];
#pragma unroll
                for (int mm = 0; mm < 2; ++mm)
#pragma unroll
                    for (int bj = 0; bj < 2; ++bj)
#pragma unroll
                        for (int n = 0; n < 2; ++n) t[mm][bj][n] = *(const f32x4*)(X + (size_t)(u.pm * BM + ai * HALF + wr * 64 + (2 * mp + mm) * 16 + fr) * DM + u.pn * BM + bj * HALF + wc * 32 + 4 * fq + 16 * n);
#pragma unroll
                for (int mm = 0; mm < 2; ++mm)
#pragma unroll
                    for (int bj = 0; bj < 2; ++bj)
#pragma unroll
                        for (int n = 0; n < 2; ++n) *(f32x4*)(O + (size_t)(u.pm * BM + ai * HALF + wr * 64 + (2 * mp + mm) * 16 + fr) * DM + u.pn * BM + bj * HALF + wc * 32 + 4 * fq + 16 * n) = t[mm][bj][n] + acc[ai][bj][2 * mp + mm][n]; }
    }
};
struct EpiPle {
    static constexpr bool PERM = true, SIDE = true; const bf16* XI; bf16* XO; const bf16* EB; const float* RST;
    __device__ __forceinline__ const float* side_ptr(const Unit& u) const { return RST + (size_t)u.pm * BM; }
    __device__ __forceinline__ void operator()(const f32x4 (&acc)[2][2][4][2], const Unit& u, int wr, int wc, int fr, int fq, const LAS float* sd) const {
        float rs[2][4];
#pragma unroll
        for (int ai = 0; ai < 2; ++ai)
#pragma unroll
            for (int m = 0; m < 4; ++m) rs[ai][m] = sd[ai * HALF + wr * 64 + m * 16 + fr];
#pragma unroll
        for (int ai = 0; ai < 2; ++ai)
#pragma unroll
            for (int mp = 0; mp < 2; ++mp) { u32x4 tx[2][2], te[2][2];
#pragma unroll
                for (int mm = 0; mm < 2; ++mm)
#pragma unroll
                    for (int bj = 0; bj < 2; ++bj) { const size_t off = (size_t)(u.pm * BM + ai * HALF + wr * 64 + (2 * mp + mm) * 16 + fr) * DM + u.pn * BM + bj * HALF + wc * 32 + 8 * fq; tx[mm][bj] = *(const u32x4*)(XI + off); te[mm][bj] = *(const u32x4*)(EB + off); }
#pragma unroll
                for (int mm = 0; mm < 2; ++mm)
#pragma unroll
                    for (int bj = 0; bj < 2; ++bj) { const int m = 2 * mp + mm; const size_t off = (size_t)(u.pm * BM + ai * HALF + wr * 64 + m * 16 + fr) * DM + u.pn * BM + bj * HALF + wc * 32 + 8 * fq;
                        f32x4 x0, x1, e0, e1; unpk8(tx[mm][bj], x0, x1); unpk8(te[mm][bj], e0, e1);
                        *(u32x4*)(XO + off) = pk8(x0 + sig4(acc[ai][bj][m][0] * rs[ai][m]) * e0, x1 + sig4(acc[ai][bj][m][1] * rs[ai][m]) * e1); } }
    }
};
struct EpiSwiglu {
    static constexpr bool PERM = true, SIDE = true; unsigned char* HID; const float* rs; float sc, hs;
    __device__ __forceinline__ const float* side_ptr(const Unit& u) const { return rs + (size_t)u.pm * BM; }
    __device__ __forceinline__ void operator()(const f32x4 (&acc)[2][2][4][2], const Unit& u, int wr, int wc, int fr, int fq, const LAS float* sd) const {
#pragma unroll
        for (int ai = 0; ai < 2; ++ai)
#pragma unroll
            for (int m = 0; m < 4; ++m) { const int rl = ai * HALF + wr * 64 + m * 16 + fr, r = u.pm * BM + rl, f = u.pn * HALF + wc * 32 + 8 * fq;
                const float s1 = sd[rl] * sc, s2 = s1 * hs;
                const f32x4 g0 = acc[ai][0][m][0] * s1, g1 = acc[ai][0][m][1] * s1; const f32x4 h0 = g0 * sig4(g0) * (acc[ai][1][m][0] * s2), h1 = g1 * sig4(g1) * (acc[ai][1][m][1] * s2);
                u32x2 w; unsigned t = 0u; t = __builtin_amdgcn_cvt_pk_fp8_f32(clamp8(h0.x), clamp8(h0.y), t, false); t = __builtin_amdgcn_cvt_pk_fp8_f32(clamp8(h0.z), clamp8(h0.w), t, true); w.x = t;
                t = 0u; t = __builtin_amdgcn_cvt_pk_fp8_f32(clamp8(h1.x), clamp8(h1.y), t, false); t = __builtin_amdgcn_cvt_pk_fp8_f32(clamp8(h1.z), clamp8(h1.w), t, true); w.y = t;
                *(u32x2*)(HID + (size_t)r * DE + f) = w; }
    }
};
struct EpiScaleRows {
    static constexpr bool PERM = true, SIDE = true; bf16* O; const float* val; float sc;
    __device__ __forceinline__ const float* side_ptr(const Unit& u) const { return val + (size_t)u.pm * BM; }
    __device__ __forceinline__ void operator()(const f32x4 (&acc)[2][2][4][2], const Unit& u, int wr, int wc, int fr, int fq, const LAS float* sd) const {
#pragma unroll
        for (int ai = 0; ai < 2; ++ai)
#pragma unroll
            for (int m = 0; m < 4; ++m) { const int rl = ai * HALF + wr * 64 + m * 16 + fr, r = u.pm * BM + rl; const float s = sd[rl] * sc;
#pragma unroll
                for (int bj = 0; bj < 2; ++bj) { const int c = u.pn * BM + bj * HALF + wc * 32 + 8 * fq; *(u32x4*)(O + (size_t)r * DM + c) = pk8(acc[ai][bj][m][0] * s, acc[ai][bj][m][1] * s); } }
    }
};
}

__device__ __forceinline__ void rms_row_to_bf16(const float* xrow, const float* g, bf16* orow, int lane) {
    const f32x4* xr = (const f32x4*)xrow + lane; const f32x4* gr = (const f32x4*)g + lane;
    f32x4 v[4]; float s = 0.f;
#pragma unroll
    for (int j = 0; j < 4; ++j) { v[j] = xr[64 * j]; s += (v[j].x * v[j].x + v[j].y * v[j].y) + (v[j].z * v[j].z + v[j].w * v[j].w); }
    const float rstd = 1.0f / sqrtf(wave_sum(s) * (1.0f / DM) + RMS_EPS);
#pragma unroll
    for (int j = 0; j < 4; ++j) { const f32x4 gg = gr[64 * j]; store_bf16x4(orow + 4 * lane + 256 * j, (f32x4){v[j].x * rstd * gg.x, v[j].y * rstd * gg.y, v[j].z * rstd * gg.z, v[j].w * rstd * gg.w}); }
}

struct EpiStageA {
    bf16* Y; const f32x2* TW;
    __device__ __forceinline__ void tile(int row, int col, const f32x4 (&acc)[4][2]) const {
#pragma unroll
        for (int mp = 0; mp < 2; ++mp) { const int r = row + 32 * mp, k1 = ((r >> 5) << 4) | (r & 15);
#pragma unroll
            for (int n = 0; n < 2; ++n) { const int c = col + 16 * n, bg = c >> 13, pqc = (c >> 6) & 127, n2 = c & 63; f32x4 xr, xi;
#pragma unroll
                for (int j = 0; j < 4; ++j) { const f32x2 tw = TW[(n2 + j) * k1]; const float ar = acc[2 * mp][n][j], ai = acc[2 * mp + 1][n][j];
                    const float br = ar * tw.x + ai * tw.y, bi = ai * tw.x - ar * tw.y; if (pqc >= 65) { xr[j] = -bi; xi[j] = br; } else { xr[j] = br; xi[j] = bi; } }
                bf16* yp = Y + (((size_t)(bg * 128 + k1) * 128 + pqc) * 128 + n2); store_bf16x4(yp, xr); store_bf16x4(yp + 64, xi); } }
    }
};
struct EpiF32Plain { float* O; int ld;
    __device__ __forceinline__ void tile(int row, int col, const f32x4 (&acc)[4][2]) const {
#pragma unroll
        for (int m = 0; m < 4; ++m)
#pragma unroll
            for (int n = 0; n < 2; ++n) *(f32x4*)(O + (size_t)(row + 16 * m) * ld + col + 16 * n) = acc[m][n];
    }
};

struct OpDft2 {
    static constexpr bool ROWFAST = false; const bf16* D2;
    __device__ __forceinline__ bf16x8 load8(int row, int k0) const { if (row < 64) return *(const bf16x8*)(D2 + row * 128 + k0); return (bf16x8){0, 0, 0, 0, 0, 0, 0, 0}; }
};
struct OpYcols {
    static constexpr bool ROWFAST = false; const bf16* Y;
    __device__ __forceinline__ bf16x8 load8(int n, int k0) const { const int w = n & 127, c = ((w >> 5) << 4) | (w & 15), pq = (w >> 4) & 1; return *(const bf16x8*)(Y + ((size_t)(n >> 7) * 128 + pq * 64 + c) * 128 + k0); }
};
struct EpiStageC {
    bf16* FM;
    __device__ __forceinline__ void tile(int row, int col, const f32x4 (&acc)[4][2]) const {
        const int bgk1 = col >> 7, bg = bgk1 >> 7, k1 = bgk1 & 127, b = bg >> 2, g = bg & 3, c0 = (((col & 127) >> 5) << 4) | (col & 15);
#pragma unroll
        for (int m = 0; m < 4; ++m) { const int k2 = row + 16 * m; if (k2 < 64) { const f32x4 P = acc[m][0], Q = acc[m][1]; f32x4 dr = P - Q, mr = P + Q; if (c0 == 0) { dr.x = P.x; mr.x = Q.x; }
            bf16* o = FM + (size_t)(b * SEQ + k1 + 128 * k2) * 512 + g * 128 + c0; store_bf16x4(o, dr); store_bf16x4(o + 64, mr); } }
    }
};


__device__ __forceinline__ void phase_router(Frame& F, KArgs a) {
    unsigned char* ws = F.ws; unsigned char* H2 = ws + WS_H; float* AFF = (float*)(ws + OFF_AFF); float* RSD = (float*)(ws + OFF_RSD); (void)a;
    const int gw = F.bid * 8 + F.wave, NW = F.G * 8, lane = F.lane(), ri = lane & 15, q = lane >> 4;
    LAS f32x4* wl = (LAS f32x4*)F.lds;
    { const float* src = (const float*)(ws + OFF_WGT); for (int idx = F.tid(); idx < 64 * 64; idx += NTHR) { const int e = idx & 15, qq = (idx >> 4) & 3, j = idx >> 6; wl[idx] = *(const f32x4*)(src + e * DM + 16 * j + 4 * qq); } }
    asm volatile("s_waitcnt vmcnt(0)" ::: "memory"); __syncthreads();
    for (int tile = gw; tile < T / 16; tile += NW) { const int m0 = tile * 16;
        const f32x4* xr = (const f32x4*)(F.xo + (size_t)(m0 + ri) * DM) + q; unsigned char* hr = H2 + (size_t)(m0 + ri) * DM + 4 * q; const LAS f32x4* wrow = wl + lane;
        f32x4 ac0 = (f32x4){0.f, 0.f, 0.f, 0.f}, ac1 = ac0, ac2 = ac0, ac3 = ac0; float ss = 0.f;
#pragma unroll 1
        for (int half = 0; half < 2; ++half) { f32x4 v[32];
#pragma unroll
            for (int t = 0; t < 32; ++t) v[t] = xr[4 * (32 * half + t)];
            asm volatile("s_waitcnt vmcnt(0)" ::: "memory");
#pragma unroll
            for (int t = 0; t < 32; ++t) { const int j = 32 * half + t; const f32x4 x = v[t]; const f32x4 w = wrow[64 * j];
                ss += (x.x * x.x + x.y * x.y) + (x.z * x.z + x.w * x.w);
                unsigned w8 = 0u; w8 = __builtin_amdgcn_cvt_pk_fp8_f32(clamp8(x.x), clamp8(x.y), w8, false); w8 = __builtin_amdgcn_cvt_pk_fp8_f32(clamp8(x.z), clamp8(x.w), w8, true);
                *(unsigned*)(hr + 16 * j) = w8;
                ac0 = __builtin_amdgcn_mfma_f32_16x16x4f32(x.x, w.x, ac0, 0, 0, 0); ac1 = __builtin_amdgcn_mfma_f32_16x16x4f32(x.y, w.y, ac1, 0, 0, 0);
                ac2 = __builtin_amdgcn_mfma_f32_16x16x4f32(x.z, w.z, ac2, 0, 0, 0); ac3 = __builtin_amdgcn_mfma_f32_16x16x4f32(x.w, w.w, ac3, 0, 0, 0); }
        }
        ss += __shfl_xor(ss, 16); ss += __shfl_xor(ss, 32);
        const float rstd = 1.0f / sqrtf(ss * (1.0f / DM) + RMS_EPS);
        if (q == 0) RSD[m0 + ri] = rstd;
        const f32x4 lgv = (ac0 + ac1) + (ac2 + ac3);
#pragma unroll
        for (int r = 0; r < 4; ++r) { const float rs = __shfl(rstd, 4 * q + r); const float lg = lgv[r] * rs; float mx = lg;
#pragma unroll
            for (int o = 1; o < 16; o <<= 1) mx = fmaxf(mx, __shfl_xor(mx, o));
            const float ex = expf(lg - mx); float den = ex;
#pragma unroll
            for (int o = 1; o < 16; o <<= 1) den += __shfl_xor(den, o);
            AFF[(size_t)(m0 + 4 * q + r) * NE + ri] = ex / den; }
    }
}
__device__ __forceinline__ void phase_topk(Frame& F, KArgs a) {
    unsigned char* ws = F.ws; const float* AFF = (const float*)(ws + OFF_AFF); int* IDX = (int*)(ws + OFF_IDX); float* VAL = (float*)(ws + OFF_VAL); int* SLOT = (int*)(ws + OFF_SLOT); const float* RSD = (const float*)(ws + OFF_RSD); float* RSS = (float*)(ws + OFF_RSS);
    LAS unsigned* keys = (LAS unsigned*)F.lds; LAS unsigned* hist = keys + SEQ; LAS unsigned* ctl = hist + 256; LAS unsigned* wtot = ctl + 8;
    const int tid = F.tid(), lane = F.lane(), wave = F.wave;
    for (int be = F.bid; be < NB * NE; be += F.G) { const int b = be >> 4, e = be & 15; const float* src = AFF + (size_t)b * SEQ * NE + e;
        __syncthreads();
        for (int i = tid; i < SEQ; i += NTHR) keys[i] = __float_as_uint(src[(size_t)i * NE]);
        if (tid == 0) { ctl[0] = 0u; ctl[1] = CAP; }
        unsigned mask = 0u;
        for (int p = 3; p >= 0; --p) {
            if (tid < 256) hist[tid] = 0u;
            __syncthreads();
            const unsigned prefix = ctl[0];
            for (int i = tid; i < SEQ; i += NTHR) { const unsigned k = keys[i]; if ((k & mask) == prefix) atomicAdd((unsigned*)&hist[(k >> (8 * p)) & 255u], 1u); }
            __syncthreads();
            if (wave == 0) {
                const unsigned need = ctl[1]; const unsigned h0 = hist[4 * lane], h1 = hist[4 * lane + 1], h2 = hist[4 * lane + 2], h3 = hist[4 * lane + 3]; const unsigned loc = (h0 + h1) + (h2 + h3);
                unsigned suf = loc;
#pragma unroll
                for (int o = 1; o < 64; o <<= 1) { const unsigned t = __shfl_down(suf, o); if (lane + o < 64) suf += t; }
                const unsigned above = suf - loc;
                if (above < need && need <= suf) { unsigned cum = above; int bsel;
                    if (cum + h3 >= need) bsel = 4 * lane + 3; else { cum += h3; if (cum + h2 >= need) bsel = 4 * lane + 2; else { cum += h2; if (cum + h1 >= need) bsel = 4 * lane + 1; else { cum += h1; bsel = 4 * lane; } } }
                    ctl[0] = prefix | ((unsigned)bsel << (8 * p)); ctl[1] = need - cum; } }
            mask |= 0xFFu << (8 * p);
            __syncthreads();
        }
        const unsigned Tk = ctl[0], need_eq = ctl[1];
        unsigned cg = 0u, ce = 0u; unsigned kk[16];
#pragma unroll
        for (int q = 0; q < 16; ++q) { kk[q] = keys[tid * 16 + q]; cg += kk[q] > Tk ? 1u : 0u; ce += kk[q] == Tk ? 1u : 0u; }
        unsigned ig = cg, ie = ce;
#pragma unroll
        for (int o = 1; o < 64; o <<= 1) { const unsigned tg = __shfl_up(ig, o), te = __shfl_up(ie, o); if (lane >= o) { ig += tg; ie += te; } }
        if (lane == 63) { wtot[wave] = ig; wtot[8 + wave] = ie; }
        __syncthreads();
        unsigned bg = ig - cg, beq = ie - ce;
        for (int w = 0; w < wave; ++w) { bg += wtot[w]; beq += wtot[8 + w]; }
#pragma unroll
        for (int q = 0; q < 16; ++q) { const unsigned k = kk[q]; const bool gtv = k > Tk, eqv = k == Tk; const bool sel = gtv || (eqv && beq < need_eq);
            if (sel) { const unsigned pos = bg + (beq < need_eq ? beq : need_eq); const int i = tid * 16 + q; const int slot = b * CAP + (int)pos;
                IDX[e * 4096 + slot] = b * SEQ + i; VAL[e * 4096 + slot] = __uint_as_float(k); RSS[e * 4096 + slot] = RSD[b * SEQ + i]; SLOT[(size_t)e * T + b * SEQ + i] = slot; }
            bg += gtv ? 1u : 0u; beq += eqv ? 1u : 0u; }
    }
}

__device__ __forceinline__ void phase_final(Frame& F, KArgs a) {
    const float* g = a->in[23]; const bf16* X3B = (const bf16*)(F.ws + WS_X3B); const int gw = F.bid * 8 + F.wave, NW = F.G * 8, lane = F.lane();
    f32x4 gg[4];
#pragma unroll
    for (int j = 0; j < 4; ++j) gg[j] = ((const f32x4*)g + lane)[64 * j];
    asm volatile("s_waitcnt vmcnt(0)" ::: "memory");
    for (int m0 = gw * 4; m0 < T; m0 += NW * 4) { f32x4 v[4][4];
#pragma unroll
        for (int r = 0; r < 4; ++r)
#pragma unroll
            for (int j = 0; j < 4; ++j) { const u32x2 w = __builtin_nontemporal_load((const u32x2*)(X3B + (size_t)(m0 + r) * DM + 4 * lane + 256 * j)); v[r][j] = (f32x4){__uint_as_float(w.x << 16), __uint_as_float(w.x & 0xffff0000u), __uint_as_float(w.y << 16), __uint_as_float(w.y & 0xffff0000u)}; }
#pragma unroll
        for (int r = 0; r < 4; ++r) { float sq = 0.f; f32x4* xr = (f32x4*)(F.xo + (size_t)(m0 + r) * DM) + lane;
#pragma unroll
            for (int j = 0; j < 4; ++j) sq += (v[r][j].x * v[r][j].x + v[r][j].y * v[r][j].y) + (v[r][j].z * v[r][j].z + v[r][j].w * v[r][j].w);
            const float rstd = 1.0f / sqrtf(wave_sum(sq) * (1.0f / DM) + RMS_EPS);
#pragma unroll
            for (int j = 0; j < 4; ++j) __builtin_nontemporal_store((f32x4){v[r][j].x * rstd * gg[j].x, v[r][j].y * rstd * gg[j].y, v[r][j].z * rstd * gg[j].z, v[r][j].w * rstd * gg[j].w}, xr + 64 * j); }
    }
}


__device__ __forceinline__ void transpose_item(const float* W, int ld, int c0, int k0, bf16* dst, int ldd, LAS float* scr, int lane) {
#pragma unroll 8
    for (int i = 0; i < 32; ++i) { const int kk = 2 * i + (lane >> 5); scr[kk * 33 + (lane & 31)] = W[(size_t)(k0 + kk) * ld + c0 + (lane & 31)]; }
    asm volatile("s_waitcnt vmcnt(0) lgkmcnt(0)" ::: "memory");
    const int c = lane & 7;
#pragma unroll
    for (int j = 0; j < 4; ++j) { const int n = (lane >> 3) + 8 * j; const LAS float* s = scr + (8 * c) * 33 + n;
        u32x4 o; o.x = cvt_pk_bf16(s[0 * 33], s[1 * 33]); o.y = cvt_pk_bf16(s[2 * 33], s[3 * 33]); o.z = cvt_pk_bf16(s[4 * 33], s[5 * 33]); o.w = cvt_pk_bf16(s[6 * 33], s[7 * 33]);
        *(u32x4*)(dst + (size_t)n * ldd + k0 + 8 * c) = o; }
    asm volatile("s_waitcnt lgkmcnt(0)" ::: "memory");
}
__device__ __forceinline__ int kperm_fourier(int p) { const int g = p >> 7, q = p & 127; return g * 128 + (q <= 64 ? q : 192 - q); }
template <bool KMAP>
__device__ __forceinline__ void transpose_item_t(const float* W, int ld, int c0, int k0, bf16* dst, int ldd, LAS float* scr, int lane) {
#pragma unroll 8
    for (int i = 0; i < 32; ++i) { const int kk = 2 * i + (lane >> 5); const int ks = KMAP ? kperm_fourier(k0 + kk) : (k0 + kk); scr[kk * 33 + (lane & 31)] = W[(size_t)ks * ld + c0 + (lane & 31)]; }
    asm volatile("s_waitcnt vmcnt(0) lgkmcnt(0)" ::: "memory");
    const int c = lane & 7;
#pragma unroll
    for (int j = 0; j < 4; ++j) { const int n = (lane >> 3) + 8 * j; const LAS float* s = scr + (8 * c) * 33 + n;
        u32x4 o; o.x = cvt_pk_bf16(s[0 * 33], s[1 * 33]); o.y = cvt_pk_bf16(s[2 * 33], s[3 * 33]); o.z = cvt_pk_bf16(s[4 * 33], s[5 * 33]); o.w = cvt_pk_bf16(s[6 * 33], s[7 * 33]);
        *(u32x4*)(dst + (size_t)n * ldd + k0 + 8 * c) = o; }
    asm volatile("s_waitcnt lgkmcnt(0)" ::: "memory");
}

struct OpTcTab {
    static constexpr bool ROWFAST = false; const LAS float* ct; const LAS float* st;
    __device__ __forceinline__ bf16x8 load8(int pqc, int k0) const { float v[8];
#pragma unroll
        for (int q = 0; q < 8; ++q) { const int c = k0 + q; v[q] = pqc < 64 ? ct[(c * pqc) & 127] : (pqc == 64 ? ((c & 1) ? -1.f : 1.f) : st[(c * (pqc - 64)) & 127]); }
        return pack8((f32x4){v[0], v[1], v[2], v[3]}, (f32x4){v[4], v[5], v[6], v[7]}); }
};
struct EpiBf16Plain { bf16* O; int ld;
    __device__ __forceinline__ void tile(int row, int col, const f32x4 (&acc)[4][2]) const {
#pragma unroll
        for (int m = 0; m < 4; ++m)
#pragma unroll
            for (int n = 0; n < 2; ++n) store_bf16x4(O + (size_t)(row + 16 * m) * ld + col + 16 * n, acc[m][n]);
    }
};
__device__ __forceinline__ void ssm_tables_group(Frame& F, KArgs a, int g, int part) {
    unsigned char* ws = F.ws; const int tid = F.tid();
    LAS f32x2* LB = (LAS f32x2*)(F.lds); LAS f32x2* BBl = (LAS f32x2*)(F.lds + 33280); LAS f32x2* Cl = (LAS f32x2*)(F.lds + 41472);
    LAS bf16* KTb = (LAS bf16*)(F.lds + 49664); LAS float* K0 = (LAS float*)(F.lds + 115200);
    const float* a_re = a->in[5]; const float* a_im = a->in[6]; const float* log_dt = a->in[7]; const float* b_re = a->in[8]; const float* b_im = a->in[9];
    const float* c_re = a->in[10]; const float* c_im = a->in[11]; const float* dvec = a->in[12];
    bf16* WE = (bf16*)(ws + WS_WEND) + (size_t)g * 256 * 1024; bf16* KC = (bf16*)(ws + WS_KC) + (size_t)g * 128 * 256; bf16* CT = (bf16*)(ws + WS_CT) + (size_t)g * 1024 * 256; f32x2* L64 = (f32x2*)(ws + OFF_L64);
    for (int d = 0; d < 2; ++d) {
        const int dg = d * NG + g; const float dt = expf(log_dt[dg]);
        __syncthreads();
        for (int it = tid; it < 64 * 65; it += NTHR) { const int n = it / 65, p = it - n * 65; const float are = a_re[dg * 64 + n], aim = a_im[dg * 64 + n];
            const float mag = expf(are * dt * (float)p); const double tr = (double)aim * (double)dt * (double)p * 0.15915494309189535; const float fr_ = (float)(tr - __builtin_rint(tr));
            float s_, c_; sincospif(2.0f * fr_, &s_, &c_); const f32x2 v = (f32x2){mag * c_, mag * s_}; LB[it] = v; if (p == 64 && part == 0) L64[dg * 64 + n] = v; }
        for (int it = tid; it < 64 * 16; it += NTHR) { const int n = it >> 4; const float are = a_re[dg * 64 + n], aim = a_im[dg * 64 + n];
            const float em1 = expm1f(are * dt), th = aim * dt; float sh, ch, s_, c_; sincosf(0.5f * th, &sh, &ch); sincosf(th, &s_, &c_); (void)ch;
            const float lr = em1 * c_ - 2.0f * sh * sh, li = (1.0f + em1) * s_, den = are * are + aim * aim, qr = (lr * are + li * aim) / den, qi = (li * are - lr * aim) / den;
            const float br = b_re[(size_t)dg * 1024 + it], bi = b_im[(size_t)dg * 1024 + it]; BBl[it] = (f32x2){qr * br - qi * bi, qr * bi + qi * br};
            Cl[it] = (f32x2){c_re[(size_t)dg * 1024 + it], c_im[(size_t)dg * 1024 + it]}; }
        asm volatile("s_waitcnt vmcnt(0)" ::: "memory"); __syncthreads();
        { const int lane = F.lane(), o_a = lane & 15, nq = 4 * (lane >> 4); f32x2 creg[4][4]; bf16x8 bfr[4];
#pragma unroll
          for (int q = 0; q < 4; ++q) { float bv[8];
#pragma unroll
              for (int jj = 0; jj < 4; ++jj) { const int n = 16 * q + nq + jj; creg[q][jj] = Cl[o_a * 64 + n]; const f32x2 b = BBl[n * 16 + (lane & 15)]; bv[2 * jj] = b.x; bv[2 * jj + 1] = b.y; }
              bfr[q] = pack8((f32x4){bv[0], bv[1], bv[2], bv[3]}, (f32x4){bv[4], bv[5], bv[6], bv[7]}); }
          for (int k = F.wave; k < 64; k += 8) { f32x4 acc = (f32x4){0.f, 0.f, 0.f, 0.f};
#pragma unroll
              for (int q = 0; q < 4; ++q) { float av[8];
#pragma unroll
                  for (int jj = 0; jj < 4; ++jj) { const int n = 16 * q + nq + jj; const f32x2 l = LB[n * 65 + k], c = creg[q][jj]; av[2 * jj] = c.x * l.x - c.y * l.y; av[2 * jj + 1] = -(c.x * l.y + c.y * l.x); }
                  acc = __builtin_amdgcn_mfma_f32_16x16x32_bf16(pack8((f32x4){av[0], av[1], av[2], av[3]}, (f32x4){av[4], av[5], av[6], av[7]}), bfr[q], acc, 0, 0, 0); }
#pragma unroll
              for (int r = 0; r < 4; ++r) { const int o = (lane >> 4) * 4 + r, i = lane & 15, oi = o * 16 + i; KTb[(d * 64 + k) * 256 + oi] = (bf16)(cvt_pk_bf16(acc[r], 0.f) & 0xffffu);
                  if (k == 0) { if (d == 0) K0[oi] = acc[r] + (o == i ? dvec[g * 16 + o] : 0.f); else K0[oi] += acc[r]; } } } }
        for (int it = part * 4096 + tid; it < (part + 1) * 4096; it += NTHR) { const int kc = it & 127, rr = it >> 7, n = rr >> 1, ri = rr & 1, j = kc >> 1, i0 = (kc & 1) * 8; const f32x2 l = LB[n * 65 + (d ? j : 63 - j)]; float v[8];
#pragma unroll
            for (int q = 0; q < 8; ++q) { const f32x2 b = BBl[n * 16 + i0 + q]; v[q] = ri ? (l.x * b.y + l.y * b.x) : (l.x * b.x - l.y * b.y); }
            *(bf16x8*)(WE + ((size_t)(d * 128 + rr) * 1024 + kc * 8)) = pack8((f32x4){v[0], v[1], v[2], v[3]}, (f32x4){v[4], v[5], v[6], v[7]}); }
        for (int it = part * 4096 + tid; it < (part + 1) * 4096; it += NTHR) { const int nb = (it & 15) * 4, row = it >> 4, sI = row >> 4, o = row & 15, p = d ? 64 - sI : sI + 1; float v[8];
#pragma unroll
            for (int q = 0; q < 4; ++q) { const f32x2 c = Cl[o * 64 + nb + q], l = LB[(nb + q) * 65 + p]; v[2 * q] = c.x * l.x - c.y * l.y; v[2 * q + 1] = -(c.x * l.y + c.y * l.x); }
            *(bf16x8*)(CT + ((size_t)row * 256 + d * 128 + nb * 2)) = pack8((f32x4){v[0], v[1], v[2], v[3]}, (f32x4){v[4], v[5], v[6], v[7]}); }
    }
    __syncthreads();
    for (int it = part * 1024 + tid; it < (part + 1) * 1024; it += NTHR) { const int L = it >> 5, pc = (it & 31) * 8; bf16x8 w;
        if (L == 127) continue;
        if (L != 63) { const int d = L > 63 ? 0 : 1, lag = L > 63 ? L - 63 : 63 - L; w = *(const LAS bf16x8*)(KTb + (d * 64 + lag) * 256 + pc); }
        else { const LAS float* k0 = K0 + pc; w = pack8((f32x4){k0[0], k0[1], k0[2], k0[3]}, (f32x4){k0[4], k0[5], k0[6], k0[7]}); }
        *(bf16x8*)(KC + (size_t)L * 256 + pc) = w; }
    __syncthreads();
}

__device__ __forceinline__ void transpose_item_fp8(const float* W, const float* gs, int ld, int c0, int k0, unsigned char* dst, int ldd, float scale, LAS float* scr, int lane) {
    { const int r8 = lane >> 3, c4 = (lane & 7) * 4; f32x4 v[8];
#pragma unroll
      for (int i = 0; i < 8; ++i) v[i] = __builtin_nontemporal_load((const f32x4*)(W + (size_t)(k0 + 8 * i + r8) * ld + c0 + c4));
#pragma unroll
      for (int i = 0; i < 8; ++i) { const float gk = gs ? gs[k0 + 8 * i + r8] : 1.0f; LAS float* p = scr + (8 * i + r8) * 33 + c4; p[0] = v[i].x * gk; p[1] = v[i].y * gk; p[2] = v[i].z * gk; p[3] = v[i].w * gk; } }
    asm volatile("s_waitcnt vmcnt(0) lgkmcnt(0)" ::: "memory");
    const int c = lane & 3;
#pragma unroll
    for (int j = 0; j < 2; ++j) { const int n = (lane >> 2) + 16 * j; const LAS float* s = scr + (16 * c) * 33 + n; u32x4 o;
#pragma unroll
        for (int q = 0; q < 4; ++q) { unsigned w8 = 0u; w8 = __builtin_amdgcn_cvt_pk_fp8_f32(clamp8(s[(4 * q) * 33] * scale), clamp8(s[(4 * q + 1) * 33] * scale), w8, false); w8 = __builtin_amdgcn_cvt_pk_fp8_f32(clamp8(s[(4 * q + 2) * 33] * scale), clamp8(s[(4 * q + 3) * 33] * scale), w8, true); o[q] = w8; }
        *(u32x4*)(dst + (size_t)n * ldd + k0 + 16 * c) = o; }
    asm volatile("s_waitcnt lgkmcnt(0)" ::: "memory");
}
__device__ __forceinline__ void transpose_item_rowscale(const float* W, const float* gs, int ld, int c0, int k0, bf16* dst, int ldd, LAS float* scr, int lane) {
#pragma unroll 8
    for (int i = 0; i < 32; ++i) { const int kk = 2 * i + (lane >> 5); scr[kk * 33 + (lane & 31)] = W[(size_t)(k0 + kk) * ld + c0 + (lane & 31)] * gs[k0 + kk]; }
    asm volatile("s_waitcnt vmcnt(0) lgkmcnt(0)" ::: "memory");
    const int c = lane & 7;
#pragma unroll
    for (int j = 0; j < 4; ++j) { const int n = (lane >> 3) + 8 * j; const LAS float* s = scr + (8 * c) * 33 + n;
        u32x4 o; o.x = cvt_pk_bf16(s[0 * 33], s[1 * 33]); o.y = cvt_pk_bf16(s[2 * 33], s[3 * 33]); o.z = cvt_pk_bf16(s[4 * 33], s[5 * 33]); o.w = cvt_pk_bf16(s[6 * 33], s[7 * 33]);
        *(u32x4*)(dst + (size_t)n * ldd + k0 + 8 * c) = o; }
    asm volatile("s_waitcnt lgkmcnt(0)" ::: "memory");
}
__device__ __forceinline__ void phase0(Frame& F, KArgs a, int qword = 2048) {
    const int NBUILD = F.G >= 192 ? 4 * NG : 0; const bool builder = F.bid < NBUILD; const int rb = builder ? 0 : F.bid - NBUILD, RG = F.G - NBUILD;
    const int gt = builder ? (1 << 30) : rb * NTHR + F.tid(), NT = RG * NTHR, gw = builder ? (1 << 30) : rb * 8 + F.wave, NW = RG * 8;
    const float* x = a->in[0]; const float* g_mix = a->in[2]; const float* w_in = a->in[3];
    unsigned char* ws = F.ws;
    LAS float* ct = (LAS float*)(F.lds + 96 * 1024); LAS float* st = ct + 128;
    if (F.tid() < 128) { float s, c; sincospif((float)F.tid() / 64.0f, &s, &c); ct[F.tid()] = c; st[F.tid()] = s; }
    __syncthreads();
    if (NBUILD == 0) { for (int u = F.bid; u < 4 * NG; u += F.G) ssm_tables_group(F, a, u >> 2, u & 3); }
    if (builder) { ssm_tables_group(F, a, F.bid >> 2, F.bid & 3);
        if (F.tid() < 128) { float s, c; sincospif((float)F.tid() / 64.0f, &s, &c); ct[F.tid()] = c; st[F.tid()] = s; }
        __syncthreads(); }
    { const int nb0 = NBUILD, nbw = RG < 32 ? RG : 32;
      if (F.bid >= nb0 && F.bid < nb0 + nbw) for (int t = F.bid - nb0; t < 32; t += nbw) { const int g = t >> 3, n0 = (t & 7) * 128;
          OpTcTab A{ct, st}; OpF32Rows Bo{w_in + g * 128, DIN}; EpiBf16Plain E{(bf16*)(ws + OFF_WFT) + (size_t)g * 128 * 1024, 1024};
          gg_tile(F.lds, A, Bo, E, 0, n0, 128, F.wave); }
      __syncthreads(); }
    { bf16* D1 = (bf16*)(ws + OFF_DFT1);
      for (int it = gt; it < 256 * 128; it += NT) { const int r = it >> 7, n1 = it & 127, ri = r >> 7, k1 = r & 127; const int m = (n1 * k1) & 127;
          const float v = ri ? -st[m] : ct[m]; D1[it] = (bf16)(cvt_pk_bf16(v, 0.f) & 0xffffu); } }
    { bf16* D2 = (bf16*)(ws + OFF_DFT2);
      for (int it = gt; it < 256 * 128; it += NT) { const int k2 = it >> 7, kk = it & 127, ri = kk >> 6, n2 = kk & 63; const int m = ((n2 * k2) & 63) * 2;
          const float v = k2 < 64 ? (ri ? st[m] : ct[m]) * (1.0f / 1024.0f) : 0.f; D2[it] = (bf16)(cvt_pk_bf16(v, 0.f) & 0xffffu); } }
    { f32x2* TW = (f32x2*)(ws + OFF_TW);
      for (int it = gt; it < 8192; it += NT) { float s, c; sincospif((float)it / 4096.0f, &s, &c); TW[it] = (f32x2){c, s}; } }
    { int* SL = (int*)(ws + OFF_SLOT); for (int it = gt; it < T * NE; it += NT) SL[it] = -1; }
    { float* WG = (float*)(ws + OFF_WGT); const float* gf = a->in[15]; const float* wrt = a->in[16]; for (int it = gt; it < NE * DM; it += NT) { const int e = it >> 10, d = it & 1023; WG[it] = gf[d] * wrt[d * NE + e]; } }
    { LAS float* scr = (LAS float*)(F.lds + F.wave * 8704);
      constexpr int I_WB = (DM / 64) * (2560 / 32), I_GLU = (512 / 64) * (2048 / 32), I_WF = (512 / 64) * (DM / 32), I_SQ = (DM / 64) * (DM / 32), I_PP = (PLE / 64) * (DM / 32);
      constexpr int NITEMS = I_WB + I_GLU + I_WF + 2 * I_SQ + I_PP;
      for (int it = gw; it < NITEMS; it += NW) { int r = it;
          if (r < I_WB) { const int nb = r % 80, kb = r / 80; transpose_item(w_in, DIN, 512 + nb * 32, kb * 64, (bf16*)(ws + OFF_WB) + (size_t)nb * 32 * DM, DM, scr, F.lane()); continue; } r -= I_WB;
          if (r < I_GLU) { const int nb = r % 64, kb = r / 64;
              const int n0 = nb * 32, pn = n0 >> 8, bj = (n0 >> 7) & 1, xx = n0 & 127; transpose_item(a->in[13], 2048, bj * 1024 + pn * 128 + xx, kb * 64, (bf16*)(ws + OFF_WGLU) + (size_t)n0 * 512, 512, scr, F.lane()); continue; } r -= I_GLU;
          if (r < I_WF) { const int nb = r % 32, kb = r / 32; transpose_item_t<true>(a->in[4], DM, nb * 32, kb * 64, (bf16*)(ws + OFF_WF) + (size_t)nb * 32 * 512, 512, scr, F.lane()); continue; } r -= I_WF;
          if (r < I_SQ) { const int nb = r % 32, kb = r / 32; transpose_item(a->in[14], DM, nb * 32, kb * 64, (bf16*)(ws + OFF_WOUT) + (size_t)nb * 32 * DM, DM, scr, F.lane()); continue; } r -= I_SQ;
          if (r < I_SQ) { const int nb = r % 32, kb = r / 32; transpose_item_rowscale(a->in[21], a->in[20], DM, nb * 32, kb * 64, (bf16*)(ws + OFF_WPG) + (size_t)nb * 32 * DM, DM, scr, F.lane()); continue; } r -= I_SQ;
          { const int nb = r % 32, kb = r / 32; transpose_item(a->in[22], DM, nb * 32, kb * 64, (bf16*)(ws + OFF_WPP) + (size_t)nb * 32 * PLE, PLE, scr, F.lane()); }
      } }
    { bf16* H = (bf16*)(ws + WS_H); unsigned* q = (unsigned*)(ws + WS_CTL) + qword; const int lane = F.lane(); const float* pin = a->in[1];
      f32x4 gg[4];
#pragma unroll
      for (int j = 0; j < 4; ++j) gg[j] = ((const f32x4*)g_mix + lane)[64 * j];
      for (;;) { unsigned r0 = 0; if (lane == 0) r0 = __hip_atomic_fetch_add(q, 16u, __ATOMIC_RELAXED, __HIP_MEMORY_SCOPE_AGENT); r0 = __builtin_amdgcn_readfirstlane(r0); if (r0 >= (unsigned)T) break;
          for (int m0 = (int)r0; m0 < (int)r0 + 16; m0 += 4) { f32x4 v[4][4], pv[4];
#pragma unroll
              for (int r = 0; r < 4; ++r) {
#pragma unroll
                  for (int j = 0; j < 4; ++j) v[r][j] = __builtin_nontemporal_load((const f32x4*)(x + (size_t)(m0 + r) * DM) + lane + 64 * j);
                  pv[r] = __builtin_nontemporal_load((const f32x4*)(pin + (size_t)(m0 + r) * PLE) + lane); }
#pragma unroll
              for (int r = 0; r < 4; ++r) { float sq = 0.f;
#pragma unroll
                  for (int j = 0; j < 4; ++j) sq += (v[r][j].x * v[r][j].x + v[r][j].y * v[r][j].y) + (v[r][j].z * v[r][j].z + v[r][j].w * v[r][j].w);
                  const float rstd = 1.0f / sqrtf(wave_sum(sq) * (1.0f / DM) + RMS_EPS);
#pragma unroll
                  for (int j = 0; j < 4; ++j) store_bf16x4(H + (size_t)(m0 + r) * DM + 4 * lane + 256 * j, (f32x4){v[r][j].x * rstd * gg[j].x, v[r][j].y * rstd * gg[j].y, v[r][j].z * rstd * gg[j].z, v[r][j].w * rstd * gg[j].w});
                  store_bf16x4((bf16*)(ws + WS_PB) + (size_t)(m0 + r) * PLE + 4 * lane, pv[r]); } } } }
}

__device__ __forceinline__ void phase_gemm1(Frame& F, KArgs a) {
    unsigned char* ws = F.ws; const bf16* H = (const bf16*)(ws + WS_H);
    { pg8::PolG1a P{(const bf16*)(ws + OFF_WFT), H, DM}; pg8::StaticOrder S; S.init(512, T, F.G, F.bid); pg8::EpiXt E{(bf16*)(ws + WS_XT)};
      pg8::gemm_phase(F.lds, P, S, E, F.wave); }
    { pg8::PolPlain P{H, (const bf16*)(ws + OFF_WB), DM, DM, DM}; pg8::StaticOrder S; S.init(T, 2560, F.G, F.bid); pg8::EpiG1b E{(bf16*)(ws + WS_ACAT), (bf16*)(ws + WS_GF), (bf16*)(ws + WS_GS)};
      pg8::gemm_phase(F.lds, P, S, E, F.wave); }
}
__device__ __forceinline__ void phase_stageA(Frame& F, KArgs a) {
    unsigned char* ws = F.ws;
    { pg8::PolPlain P{(const bf16*)(ws + OFF_DFT1), (const bf16*)(ws + WS_XT), 128, 128, 128}; pg8::LinearOrder S; S.init(1, 131072 / 256, F.G, F.bid); pg8::EpiStageA E{(bf16*)(ws + WS_Y), (const f32x2*)(ws + OFF_TW)};
      pg8::gemm_phase(F.lds, P, S, E, F.wave); }
    { const int ntm = 4, ntn = 2;
      for (int t = F.bid; t < NG * ntm * ntn; t += F.G) { const int g = t / (ntm * ntn), tt = t % (ntm * ntn);
          OpBf16Rows A{(const bf16*)(ws + WS_ACAT) + (size_t)g * NROWC * KCAT, KCAT}; OpBf16Rows Bo{(const bf16*)(ws + WS_WEND) + (size_t)g * 256 * 1024, 1024};
          EpiF32Plain E{(float*)(ws + WS_EE) + (size_t)g * NROWC * 256, 256};
          gg_tile(F.lds, A, Bo, E, (tt % ntm) * 128, (tt / ntm) * 128, 1024, F.wave); } }
}
__device__ __forceinline__ void phase_stageC(Frame& F, KArgs a) {
    unsigned char* ws = F.ws;
    { pg8::PolStageC P{(const bf16*)(ws + OFF_DFT2), (const bf16*)(ws + WS_Y), 128}; pg8::LinearOrder S; S.init(1, 1024, F.G, F.bid); pg8::EpiStageC E{(bf16*)(ws + WS_FMIX)};
      pg8::gemm_phase(F.lds, P, S, E, F.wave); }
    { const float* EE = (const float*)(ws + WS_EE); bf16* ACAT = (bf16*)(ws + WS_ACAT); const f32x2* L64 = (const f32x2*)(ws + OFF_L64);
      if (F.G == 256) {
          const int b = F.bid >> 6, g = (F.bid >> 1) & 31, d = F.bid & 1, tid = F.tid(), lane = F.lane(); f32x4 v[8];
          __syncthreads();
#pragma unroll
          for (int k = 0; k < 8; ++k) { const int p = tid + NTHR * k, c = p >> 5, j = p & 31; v[k] = *(const f32x4*)(EE + ((size_t)g * NROWC + b * NCH + c) * 256 + d * 128 + j * 4); }
          asm volatile("s_waitcnt vmcnt(0)" ::: "memory");
#pragma unroll
          for (int k = 0; k < 8; ++k) *(LAS f32x4*)(F.lds + (size_t)(tid + NTHR * k) * 16) = v[k];
          __syncthreads();
          if (F.wave == 0) { const LAS f32x2* es = (const LAS f32x2*)F.lds; const f32x2 l64 = L64[(d * NG + g) * 64 + lane]; float cr = 0.f, ci = 0.f;
              for (int s0 = 0; s0 < NCH; s0 += 16) { f32x2 e[16];
#pragma unroll
                  for (int q = 0; q < 16; ++q) { const int c = d ? (NCH - 1 - s0 - q) : (s0 + q); e[q] = es[c * 64 + lane]; }
#pragma unroll
                  for (int q = 0; q < 16; ++q) { const int c = d ? (NCH - 1 - s0 - q) : (s0 + q); const size_t row = (size_t)g * NROWC + b * NCH + c;
                      *(unsigned*)(ACAT + row * KCAT + 1024 + d * 128 + lane * 2) = cvt_pk_bf16(cr, ci);
                      const float nr = l64.x * cr - l64.y * ci + e[q].x, ni = l64.x * ci + l64.y * cr + e[q].y; cr = nr; ci = ni; } } }
          __syncthreads();
      } else {
      const int gt = F.bid * NTHR + F.tid(), NT = F.G * NTHR;
      for (int it = gt; it < NB * NG * 2 * NS; it += NT) { const int n = it & 63, d = (it >> 6) & 1, g = (it >> 7) & 31, b = it >> 12;
          const f32x2 l64 = L64[(d * NG + g) * 64 + n]; float cr = 0.f, ci = 0.f;
          for (int s0 = 0; s0 < NCH; s0 += 16) { f32x2 e[16];
#pragma unroll
              for (int q = 0; q < 16; ++q) { const int c = d ? (NCH - 1 - s0 - q) : (s0 + q); e[q] = *(const f32x2*)(EE + ((size_t)g * NROWC + b * NCH + c) * 256 + d * 128 + n * 2); }
              asm volatile("s_waitcnt vmcnt(0)" ::: "memory");
#pragma unroll
              for (int q = 0; q < 16; ++q) { const int c = d ? (NCH - 1 - s0 - q) : (s0 + q); const size_t row = (size_t)g * NROWC + b * NCH + c;
                  *(unsigned*)(ACAT + row * KCAT + 1024 + d * 128 + n * 2) = cvt_pk_bf16(cr, ci);
                  const float nr = l64.x * cr - l64.y * ci + e[q].x, ni = l64.x * ci + l64.y * cr + e[q].y; cr = nr; ci = ni; } } } } }
}
__device__ __forceinline__ void phase_passB(Frame& F, KArgs a) {
    unsigned char* ws = F.ws;
    { pg8::PolPassB2 P{(const bf16*)(ws + WS_ACAT), (const bf16*)(ws + WS_KC), (const bf16*)(ws + WS_CT), KCAT}; pg8::LinearOrder S; S.init(NG * 2, 4, F.G, F.bid); pg8::EpiPassB E{(bf16*)(ws + WS_YS)};
      pg8::gemm_phase(F.lds, P, S, E, F.wave); }
    { pg8::PolPlain P{(const bf16*)(ws + WS_FMIX), (const bf16*)(ws + OFF_WF), 512, 512, 512}; pg8::StaticOrder S; S.init(T, DM, F.G, F.bid); pg8::EpiMulInPlace E{(bf16*)(ws + WS_GF)};
      pg8::gemm_phase(F.lds, P, S, E, F.wave); }
}
__device__ __forceinline__ void phase_glu(Frame& F, KArgs a) {
    unsigned char* ws = F.ws;
    pg8::PolPlain P{(const bf16*)(ws + WS_YS), (const bf16*)(ws + OFF_WGLU), 512, 512, 512}; pg8::StaticOrder S; S.init(T, 2048, F.G, F.bid); pg8::EpiGlu E{(bf16*)(ws + WS_MIX), (const bf16*)(ws + WS_GS)};
    pg8::gemm_phase(F.lds, P, S, E, F.wave);
}
__device__ __forceinline__ void phase_wout(Frame& F, KArgs a) {
    unsigned char* ws = F.ws;
    pg8::PolPlain P{(const bf16*)(ws + WS_MIX), (const bf16*)(ws + OFF_WOUT), DM, DM, DM}; pg8::StaticOrder S; S.init(T, DM, F.G, F.bid); pg8::EpiResidual E{F.xo, a->in[0]};
    pg8::gemm_phase(F.lds, P, S, E, F.wave);
}
__device__ __forceinline__ void phase_expert_weights(Frame& F, KArgs a) {
    unsigned char* ws = F.ws; LAS float* scr = (LAS float*)(F.lds + 40 * 1024 + F.wave * 8704); const int gw = F.bid * 8 + F.wave, NW = F.G * 8;
    constexpr int I_GU = NE * 2 * (DM / 64) * (DE / 32), I_D = NE * (DE / 64) * (DM / 32);
    for (int it = gw; it < I_GU + I_D; it += NW) {
        if (it < I_GU) { const int nb = it % 88, kb = (it / 88) % 16, bj = (it / (88 * 16)) & 1, e = it / (88 * 16 * 2);
            const int f0 = nb * 32, tq = f0 >> 7, xx = f0 & 127; const float* W = (bj ? a->in[18] : a->in[17]) + (size_t)e * DM * DE;
            transpose_item_fp8(W, a->in[15], DE, f0, kb * 64, ws + WS_WGU + ((size_t)e * (2 * DE) + tq * 256 + bj * 128 + xx) * DM, DM, 64.0f, scr, F.lane()); }
        else { const int r = it - I_GU, nb = r % 32, kb = (r / 32) % 44, e = r / (32 * 44);
            transpose_item_fp8(a->in[19] + (size_t)e * DE * DM, nullptr, DM, nb * 32, kb * 64, ws + WS_WD + ((size_t)e * DM + nb * 32) * DE, DE, 64.0f, scr, F.lane()); }
    }
}
__device__ __forceinline__ void phase_eproj(Frame& F, KArgs a, int G2, int c2) {
    unsigned char* ws = F.ws; (void)a;
    pg8::PolPlain P{(const bf16*)(ws + WS_PB), (const bf16*)(ws + OFF_WPP), PLE, PLE, PLE}; pg8::StaticOrder S; S.init(T, DM, G2, c2); pg8::EpiBf16 E{(bf16*)(ws + WS_EB), DM};
    pg8::gemm_phase(F.lds, P, S, E, F.wave);
}
__device__ __forceinline__ void phase_exp_up(Frame& F, KArgs a) {
    unsigned char* ws = F.ws;
    pg8::PolExpUp8 P{ws + WS_H, (const int*)(ws + OFF_IDX), ws + WS_WGU, DM / 2}; pg8::ExpertOrder S; S.init(2 * DE / 256, F.G, F.bid); pg8::EpiSwiglu E{ws + WS_HID, (const float*)(ws + OFF_RSS), 1.0f / 64.0f, 8.0f};
    pg8::gemm_phase(F.lds, P, S, E, F.wave);
}
__device__ __forceinline__ void phase_exp_down(Frame& F, KArgs a) {
    unsigned char* ws = F.ws;

    pg8::PolExpDown8 P{ws + WS_HID, ws + WS_WD, DE / 2}; pg8::ExpertOrder S; S.init(DM / 256, F.G, F.bid); pg8::EpiScaleRows E{(bf16*)(ws + WS_YB), (const float*)(ws + OFF_VAL), 1.0f / 512.0f};
    pg8::gemm_phase(F.lds, P, S, E, F.wave);
}
__device__ __forceinline__ void phase_combine(Frame& F, KArgs a) {
    unsigned char* ws = F.ws; float* RST = (float*)(ws + OFF_RST); bf16* X2B = (bf16*)(ws + WS_X2B); const bf16* YB = (const bf16*)(ws + WS_YB); const int* SLOT = (const int*)(ws + OFF_SLOT);
    const int gw = F.bid * 8 + F.wave, NW = F.G * 8, lane = F.lane();
    for (int m0 = gw * 4; m0 < T; m0 += NW * 4) {
        const int myslot = SLOT[(size_t)(lane & 15) * T + m0 + (lane >> 4)];
        f32x4 v[4][4];
#pragma unroll
        for (int r = 0; r < 4; ++r)
#pragma unroll
            for (int j = 0; j < 4; ++j) v[r][j] = __builtin_nontemporal_load((const f32x4*)(F.xo + (size_t)(m0 + r) * DM) + lane + 64 * j);
        asm volatile("s_waitcnt vmcnt(0)" ::: "memory");
        unsigned long long mk = __ballot(myslot >= 0); unsigned msk[4];
#pragma unroll
        for (int r = 0; r < 4; ++r) msk[r] = (unsigned)(mk >> (16 * r)) & 0xffffu;
        while ((msk[0] | msk[1] | msk[2] | msk[3]) != 0u) { u32x2 y[4][4]; bool act[4];
#pragma unroll
            for (int r = 0; r < 4; ++r) { act[r] = msk[r] != 0u; if (act[r]) { const int e = __builtin_ctz(msk[r]); msk[r] &= msk[r] - 1u; const int sl = __shfl(myslot, 16 * r + e);
                    const bf16* yr = YB + ((size_t)e * 4096 + sl) * DM + 4 * lane;
#pragma unroll
                    for (int j = 0; j < 4; ++j) y[r][j] = __builtin_nontemporal_load((const u32x2*)(yr + 256 * j)); } }
            asm volatile("s_waitcnt vmcnt(0)" ::: "memory");
#pragma unroll
            for (int r = 0; r < 4; ++r) if (act[r]) {
#pragma unroll
                for (int j = 0; j < 4; ++j) { const u32x2 w = y[r][j]; v[r][j] += (f32x4){__uint_as_float(w.x << 16), __uint_as_float(w.x & 0xffff0000u), __uint_as_float(w.y << 16), __uint_as_float(w.y & 0xffff0000u)}; } }
        }
#pragma unroll
        for (int r = 0; r < 4; ++r) { float sq = 0.f;
#pragma unroll
            for (int j = 0; j < 4; ++j) { store_bf16x4(X2B + (size_t)(m0 + r) * DM + 4 * lane + 256 * j, v[r][j]); sq += (v[r][j].x * v[r][j].x + v[r][j].y * v[r][j].y) + (v[r][j].z * v[r][j].z + v[r][j].w * v[r][j].w); }
            const float rstd = 1.0f / sqrtf(wave_sum(sq) * (1.0f / DM) + RMS_EPS);
            if (lane == 0) RST[m0 + r] = rstd; }
    }
}
__device__ __forceinline__ void phase_ple(Frame& F, KArgs a) {
    unsigned char* ws = F.ws;
    pg8::PolPlain P{(const bf16*)(ws + WS_X2B), (const bf16*)(ws + OFF_WPG), DM, DM, DM}; pg8::StaticOrder S; S.init(T, DM, F.G, F.bid); pg8::EpiPle E{(const bf16*)(ws + WS_X2B), (bf16*)(ws + WS_X3B), (const bf16*)(ws + WS_EB), (const float*)(ws + OFF_RST)};
    pg8::gemm_phase(F.lds, P, S, E, F.wave);
}

constexpr int LDS_BYTES = 147456;
constexpr int LDS_MISC = 140 * 1024;
__global__ void __launch_bounds__(NTHR, 2) mk_fwd(Args args) {
    extern __shared__ __attribute__((aligned(16))) unsigned char lds_raw[];
    Frame F; F.lds = (LAS unsigned char*)lds_raw; F.wave = __builtin_amdgcn_readfirstlane((int)threadIdx.x >> 6); F.G = gridDim.x; F.bid = blockIdx.x;
    const KArgs kp = (KArgs)__builtin_amdgcn_kernarg_segment_ptr();
    F.ws = args.ws; F.xo = args.out;
    volatile LAS unsigned* MISC = (volatile LAS unsigned*)(F.lds + LDS_MISC);
    { const int t0 = F.tid(); if (t0 < 64) MISC[t0] = 0u; }
    __syncthreads();
    XcdBarrier bar; bar.bar = (unsigned*)(args.ws + WS_CTL) + 4096; bar.x = 0; bar.st = nullptr; bar.wave = F.wave;
    if (MK_N_LAUNCHES == 1) bar = xcd_barrier_post((unsigned*)(args.ws + WS_CTL) + 4096, MISC + 8, F.wave);
    const int lo = args.ph_lo, hi = args.ph_hi;
#define IN(k) (lo <= (k) && (k) < hi)
    auto kpl = [&]() -> KArgs { KArgs p = kp; asm volatile("" : "+s"(p)); return p; };
#define SEAM(k) do { if (lo <= (k) && (k) + 1 < hi) xcd_barrier(bar); } while (0)
    if (IN(0))  { phase0(F, kpl());
    }         SEAM(0);
    if (IN(2))  { phase_gemm1(F, kpl()); }    SEAM(2);
    if (IN(3))  { phase_stageA(F, kpl()); }   SEAM(3);
    if (IN(4))  { phase_stageC(F, kpl()); }   SEAM(4);
    if (IN(5))  { phase_passB(F, kpl()); }    SEAM(5);
    if (IN(6))  { phase_glu(F, kpl()); }      SEAM(6);
    if (IN(7))  { phase_wout(F, kpl()); }     SEAM(7);
    if (IN(8))  { phase_router(F, kpl()); }   SEAM(8);
    if (IN(9))  { if (F.G == 256) { if (F.bid < NB * NE) phase_topk(F, kpl()); else phase_eproj(F, kpl(), 192, F.bid - NB * NE); } else { phase_topk(F, kpl()); __syncthreads(); phase_eproj(F, kpl(), F.G, F.bid); }
                  __syncthreads(); phase_expert_weights(F, kpl()); } SEAM(9);
    if (IN(10)) { phase_exp_up(F, kpl()); }   SEAM(10);
    if (IN(11)) { phase_exp_down(F, kpl()); } SEAM(11);
    if (IN(12)) { phase_combine(F, kpl()); }  SEAM(12);
    if (IN(13)) { phase_ple(F, kpl()); }      SEAM(13);
    if (IN(14)) { phase_final(F, kpl()); }
#undef IN
#undef SEAM
}

extern "C" void kernel_launch(void* const* d_in, const int* in_sizes, int n_in, void* d_out, int out_size, void* d_ws, size_t ws_size, hipStream_t stream) {
    static int grid = 0;
    if (grid == 0) {
        if (n_in != 24 || out_size != T * DM || ws_size < WS_END) { fprintf(stderr, "kernel_launch: unexpected shapes (n_in %d out %d ws %zu need %zu)\n", n_in, out_size, ws_size, (size_t)WS_END); grid = -1; return; }
        int dev = 0, cus = 0, per_cu = 0;
        if (hipGetDevice(&dev) != hipSuccess || hipDeviceGetAttribute(&cus, hipDeviceAttributeMultiprocessorCount, dev) != hipSuccess) { grid = -1; return; }
        if (hipFuncSetAttribute((const void*)mk_fwd, hipFuncAttributeMaxDynamicSharedMemorySize, LDS_BYTES) != hipSuccess) { fprintf(stderr, "kernel_launch: hipFuncSetAttribute failed\n"); grid = -1; return; }
        if (hipOccupancyMaxActiveBlocksPerMultiprocessor(&per_cu, (const void*)mk_fwd, NTHR, LDS_BYTES) != hipSuccess || per_cu < 1) { fprintf(stderr, "kernel_launch: occupancy query says %d\n", per_cu); (void)hipGetLastError(); grid = -1; return; }
        grid = cus;
    }
    if (grid < 0) return;
    (void)hipMemsetAsync((char*)d_ws + WS_CTL, 0, CTL_BYTES, stream);
    Args a{};
    for (int i = 0; i < 24; ++i) a.in[i] = (const float*)d_in[i];
    a.out = (float*)d_out; a.ws = (unsigned char*)d_ws;
    if (MK_N_LAUNCHES == 1) { a.ph_lo = 0; a.ph_hi = NPH; hipLaunchKernelGGL(mk_fwd, dim3(grid), dim3(NTHR), LDS_BYTES, stream, a); }
    else for (int p = 0; p < NPH; ++p) { a.ph_lo = p; a.ph_hi = p + 1; hipLaunchKernelGGL(mk_fwd, dim3(grid), dim3(NTHR), LDS_BYTES, stream, a); }
}
```

```cpp
#include <hip/hip_runtime.h>
#include <cstdint>
#include <cstdio>

#ifndef MK_N_LAUNCHES
#define MK_N_LAUNCHES 1
#endif

#define LAS __attribute__((address_space(3)))
#define GAS __attribute__((address_space(1)))
typedef unsigned short bf16;
typedef short bf16x8 __attribute__((ext_vector_type(8)));
typedef float f32x4 __attribute__((ext_vector_type(4)));
typedef float f32x2 __attribute__((ext_vector_type(2)));
typedef unsigned u32x2 __attribute__((ext_vector_type(2)));
typedef unsigned u32x4 __attribute__((ext_vector_type(4)));
typedef GAS unsigned gu32;

constexpr int NB = 4, SEQ = 8192, T = NB * SEQ, DM = 1024, DIN = 3072, NE = 16, DE = 2816, CAP = 1024, PLE = 256;
constexpr int NG = 32, NS = 64, LCH = 64, NCH = SEQ / LCH, NROWC = NB * NCH, KCAT = 1280;
constexpr float RMS_EPS = 1e-6f;
constexpr int NPH = 15;
constexpr int NTHR = 512;

constexpr size_t MiB = 1u << 20;
constexpr size_t WS_CTL = 0, CTL_BYTES = 1 * MiB;
constexpr size_t OFF_WFT = 1 * MiB;
constexpr size_t OFF_DFT1 = OFF_WFT + 1 * MiB;
constexpr size_t OFF_DFT2 = OFF_DFT1 + 64 * 1024;
constexpr size_t OFF_TW = OFF_DFT2 + 64 * 1024;
constexpr size_t OFF_L64 = OFF_TW + 64 * 1024;
constexpr size_t OFF_WGT = OFF_L64 + 64 * 1024;
constexpr size_t OFF_AFF = OFF_WGT + 64 * 1024;
constexpr size_t OFF_IDX = OFF_AFF + 2 * MiB;
constexpr size_t OFF_VAL = OFF_IDX + 256 * 1024;
constexpr size_t OFF_SLOT = OFF_VAL + 256 * 1024;
constexpr size_t OFF_RST = OFF_SLOT + 2 * MiB;
constexpr size_t OFF_RSD = OFF_RST + 128 * 1024;
constexpr size_t OFF_RSS = OFF_RSD + 128 * 1024;
static_assert(OFF_RSS + 256 * 1024 <= 16 * MiB, "small region");
constexpr size_t OFF_WB = 16 * MiB;
constexpr size_t OFF_WGLU = OFF_WB + 5 * MiB;
constexpr size_t OFF_WF = OFF_WGLU + 2 * MiB;
constexpr size_t OFF_WOUT = OFF_WF + 1 * MiB;
constexpr size_t OFF_WPG = OFF_WOUT + 2 * MiB;
constexpr size_t OFF_WPP = OFF_WPG + 2 * MiB;
constexpr size_t WS_H = 32 * MiB;
constexpr size_t WS_R = 96 * MiB;
constexpr size_t WS_GF = WS_R, WS_GS = WS_R + 32 * MiB;
constexpr size_t WS_MIXF = WS_R + 64 * MiB, WS_MIX = WS_MIXF;
constexpr size_t WS_XT = WS_R + 128 * MiB, WS_Y = WS_R + 160 * MiB, WS_FMIX = WS_R + 224 * MiB,
                 WS_ACAT = WS_R + 256 * MiB, WS_YS = WS_R + 296 * MiB, WS_EE = WS_R + 328 * MiB;
constexpr size_t WS_KC = WS_R + 352 * MiB;
constexpr size_t WS_CT = WS_R + 356 * MiB;
constexpr size_t WS_WEND = WS_R + 432 * MiB;
constexpr size_t WS_HID = WS_R;
constexpr size_t WS_WGU = WS_R + 352 * MiB;
constexpr size_t WS_WD = WS_R + 528 * MiB;
constexpr size_t WS_YB = WS_WGU;
constexpr size_t WS_PB = WS_R + 496 * MiB;
constexpr size_t WS_X2B = WS_R + 64 * MiB;
constexpr size_t WS_X3B = WS_R + 128 * MiB;
constexpr size_t WS_EB = WS_R + 192 * MiB;
constexpr size_t WS_END = WS_R + 616 * MiB;
static_assert(OFF_SLOT + 2 * MiB <= OFF_WB && OFF_WPP + 1 * MiB <= WS_H && WS_EE + 16 * MiB <= WS_WGU && WS_PB >= WS_YB + 128 * MiB && WS_PB + 16 * MiB <= WS_WD && WS_EB >= WS_HID + 176 * MiB && WS_EB + 64 * MiB <= WS_WGU, "ws map");

typedef __bf16 bf16v2_t __attribute__((ext_vector_type(2)));
__device__ __forceinline__ unsigned cvt_pk_bf16(float lo, float hi) { const bf16v2_t v = __builtin_convertvector((f32x2){lo, hi}, bf16v2_t); return __builtin_bit_cast(unsigned, v); }
__device__ __forceinline__ float clamp8(float v) { return fminf(fmaxf(v, -440.0f), 440.0f); }
__device__ __forceinline__ float bf2f(unsigned short h) { return __uint_as_float(((unsigned)h) << 16); }
__device__ __forceinline__ float sigmoidf_(float x) { return __builtin_amdgcn_rcpf(1.0f + __expf(-x)); }
__device__ __forceinline__ float gelu_tanh(float x) { const float u = 0.7978845608028654f * (x + 0.044715f * x * x * x); return x * __builtin_amdgcn_rcpf(1.0f + __expf(-2.0f * u)); }
__device__ __forceinline__ float wave_sum(float v) {
#pragma unroll
    for (int o = 1; o < 64; o <<= 1) v += __shfl_xor(v, o);
    return v;
}
__device__ __forceinline__ bf16x8 pack8(const f32x4 a, const f32x4 b) {
    u32x4 w; w.x = cvt_pk_bf16(a.x, a.y); w.y = cvt_pk_bf16(a.z, a.w); w.z = cvt_pk_bf16(b.x, b.y); w.w = cvt_pk_bf16(b.z, b.w);
    return __builtin_bit_cast(bf16x8, w);
}
__device__ __forceinline__ void store_bf16x4(bf16* p, const f32x4 v) { u32x2 w; w.x = cvt_pk_bf16(v.x, v.y); w.y = cvt_pk_bf16(v.z, v.w); *(u32x2*)p = w; }
__device__ __forceinline__ f32x4 load_bf16x4(const bf16* p) { const u32x2 w = *(const u32x2*)p; f32x4 r; r.x = __uint_as_float(w.x << 16); r.y = __uint_as_float(w.x & 0xffff0000u); r.z = __uint_as_float(w.y << 16); r.w = __uint_as_float(w.y & 0xffff0000u); return r; }

__device__ __forceinline__ int lane_id_here() { unsigned z = 0u; asm volatile("" : "+v"(z)); return (int)__builtin_amdgcn_mbcnt_hi(~0u, __builtin_amdgcn_mbcnt_lo(~0u, z)); }
#define XB_TMO      128
#define XB_XCNT(j)  (256  + 64 * (j))
#define XB_XSUB(j)  (1280 + 64 * (j))
#define XB_XGEN(j)  (2304 + 64 * (j))
#define XB_TOP      3328
#define XB_TOPGEN   3392
#define XCD_BAR_WORDS 3456
#define XB_SPIN_CAP (1u << 22)
__device__ __forceinline__ unsigned xb_ld(unsigned* p)              { return __hip_atomic_load(p, __ATOMIC_RELAXED, __HIP_MEMORY_SCOPE_AGENT); }
__device__ __forceinline__ unsigned xb_add(unsigned* p, unsigned v) { return __hip_atomic_fetch_add(p, v, __ATOMIC_RELAXED, __HIP_MEMORY_SCOPE_AGENT); }
__device__ __forceinline__ unsigned xb_xcc_id() { return (unsigned)__builtin_amdgcn_s_getreg((3 << 11) | 20) & 0xFu; }
#define XB_SPIN(cond, bar) do { unsigned _sp = 0; while (cond) { __builtin_amdgcn_s_sleep(1); \
    if ((++_sp & 255u) == 0u) { if (xb_ld(&(bar)[XB_TMO])) break; if (_sp > XB_SPIN_CAP) { atomicAdd(&(bar)[XB_TMO], 1u); break; } } } } while (0)
struct XcdBarrier { unsigned* bar; unsigned x; volatile LAS unsigned* st; int wave; };
__device__ __forceinline__ XcdBarrier xcd_barrier_post(unsigned* bar, volatile LAS unsigned* st, int wave) {
    XcdBarrier b; b.bar = bar; b.x = xb_xcc_id(); b.st = st; b.wave = wave;
    if (wave == 0 && lane_id_here() == 0) (void)xb_add(&bar[XB_XCNT(b.x)], 1u);
    return b;
}
__device__ __forceinline__ void xcd_barrier_complete(unsigned* bar, unsigned x, unsigned& nloc, unsigned& nx) {
    const unsigned G = gridDim.x * gridDim.y * gridDim.z;
    unsigned sum, cnt, mine, sp = 0u;
    for (;;) {
        sum = 0u; cnt = 0u; mine = 0u;
#pragma unroll
        for (unsigned j = 0; j < 16; ++j) { const unsigned c = xb_ld(&bar[XB_XCNT(j)]); sum += c; cnt += (c > 0u) ? 1u : 0u; mine = (j == x) ? c : mine; }
        if (sum == G) break;
        __builtin_amdgcn_s_sleep(1);
        if ((++sp & 255u) == 0u) { if (xb_ld(&bar[XB_TMO])) break; if (sp > XB_SPIN_CAP) { atomicAdd(&bar[XB_TMO], 1u); break; } }
    }
    nloc = mine > 0u ? mine : 1u; nx = cnt > 0u ? cnt : 1u;
}
__device__ __forceinline__ void xcd_barrier(const XcdBarrier& b) {
    asm volatile("s_waitcnt vmcnt(0)" ::: "memory");
    __syncthreads();
    if (b.wave == 0 && lane_id_here() == 0) {
        unsigned* bar = b.bar;
        __builtin_amdgcn_s_waitcnt(0);
        unsigned nloc = b.st[0], nx = b.st[1];
        if (nloc == 0u) { xcd_barrier_complete(bar, b.x, nloc, nx); b.st[0] = nloc; b.st[1] = nx; }
        const unsigned old = xb_add(&bar[XB_XSUB(b.x)], 1u);
        const unsigned gen = old / nloc;
        if (old + 1u == (gen + 1u) * nloc) {
            __builtin_amdgcn_fence(__ATOMIC_RELEASE, "agent");
            asm volatile("s_waitcnt vmcnt(0)" ::: "memory");
            const unsigned og = xb_add(&bar[XB_TOP], 1u);
            const unsigned tg = og / nx;
            if (og + 1u == (tg + 1u) * nx) xb_add(&bar[XB_TOPGEN], 1u);
            else XB_SPIN(xb_ld(&bar[XB_TOPGEN]) == tg, bar);
            __builtin_amdgcn_fence(__ATOMIC_ACQUIRE, "agent");
            xb_add(&bar[XB_XGEN(b.x)], 1u);
            asm volatile("s_waitcnt vmcnt(0)" ::: "memory");
        } else {
            XB_SPIN(xb_ld(&bar[XB_XGEN(b.x)]) == gen, bar);
            __builtin_amdgcn_fence(__ATOMIC_ACQUIRE, "agent");
            asm volatile("s_waitcnt vmcnt(0)" ::: "memory");
        }
    }
    __syncthreads();
}

constexpr int GG_LDS_ROW = 80;
constexpr int GG_LDS_B = 128 * GG_LDS_ROW;
template <class AF, class BF, class EF>
__device__ __forceinline__ void gg_tile(LAS unsigned char* lds, const AF& af, const BF& bfn, const EF& ef, int m0, int n0, int K, int wid) {
    const int lane = lane_id_here(), tid = wid * 64 + lane, wr = wid >> 2, wc = wid & 3, fr = lane & 15, fq = lane >> 4;
    const int a_row = AF::ROWFAST ? (tid & 127) : (tid >> 2), a_kc = AF::ROWFAST ? (tid >> 7) : (tid & 3);
    const int b_row = BF::ROWFAST ? (tid & 127) : (tid >> 2), b_kc = BF::ROWFAST ? (tid >> 7) : (tid & 3);
    f32x4 acc[4][2];
#pragma unroll
    for (int m = 0; m < 4; ++m)
#pragma unroll
        for (int n = 0; n < 2; ++n) acc[m][n] = (f32x4){0.f, 0.f, 0.f, 0.f};
    constexpr int GG_BUF = 2 * 128 * GG_LDS_ROW;
    bf16x8 av[4], bv[4];
#pragma unroll
    for (int d = 0; d < 4; ++d) { av[d] = af.load8(m0 + a_row, 32 * d + a_kc * 8); bv[d] = bfn.load8(n0 + b_row, 32 * d + b_kc * 8); }
    __syncthreads();
    *(LAS bf16x8*)(lds + a_row * GG_LDS_ROW + a_kc * 16) = av[0];
    *(LAS bf16x8*)(lds + GG_LDS_B + b_row * GG_LDS_ROW + b_kc * 16) = bv[0];
    for (int k0 = 0; k0 < K; k0 += 128) {
#pragma unroll
        for (int d = 0; d < 4; ++d) { LAS unsigned char* cur = lds + (d & 1) * GG_BUF; LAS unsigned char* oth = lds + ((d + 1) & 1) * GG_BUF;
            __syncthreads();
            bf16x8 Af[4], Bf[2];
#pragma unroll
            for (int m = 0; m < 4; ++m) Af[m] = *(const LAS bf16x8*)(cur + (wr * 64 + m * 16 + fr) * GG_LDS_ROW + fq * 16);
#pragma unroll
            for (int n = 0; n < 2; ++n) Bf[n] = *(const LAS bf16x8*)(cur + GG_LDS_B + (wc * 32 + n * 16 + fr) * GG_LDS_ROW + fq * 16);
            if (k0 + 128 < K) { av[d] = af.load8(m0 + a_row, k0 + 128 + 32 * d + a_kc * 8); bv[d] = bfn.load8(n0 + b_row, k0 + 128 + 32 * d + b_kc * 8); }
            if (d < 3 || k0 + 128 < K) { *(LAS bf16x8*)(oth + a_row * GG_LDS_ROW + a_kc * 16) = av[(d + 1) & 3]; *(LAS bf16x8*)(oth + GG_LDS_B + b_row * GG_LDS_ROW + b_kc * 16) = bv[(d + 1) & 3]; }
#pragma unroll
            for (int m = 0; m < 4; ++m)
#pragma unroll
                for (int n = 0; n < 2; ++n) acc[m][n] = __builtin_amdgcn_mfma_f32_16x16x32_bf16(Bf[n], Af[m], acc[m][n], 0, 0, 0);
        }
    }
    __syncthreads();
    ef.tile(m0 + wr * 64 + fr, n0 + wc * 32 + fq * 4, acc);
}

struct OpTrivA { static constexpr bool ROWFAST = false;
    __device__ __forceinline__ bf16x8 load8(int row, int k0) const { float v[8];
#pragma unroll
        for (int q = 0; q < 8; ++q) v[q] = (float)(((row * 5 + k0 + q) & 15) - 8);
        return pack8((f32x4){v[0], v[1], v[2], v[3]}, (f32x4){v[4], v[5], v[6], v[7]}); } };
struct OpBf16Rows {
    static constexpr bool ROWFAST = false; const bf16* p; int ld;
    __device__ __forceinline__ bf16x8 load8(int row, int k0) const { return *(const bf16x8*)(p + (size_t)row * ld + k0); }
};
struct OpF32Rows {
    static constexpr bool ROWFAST = false; const float* p; int ld;
    __device__ __forceinline__ bf16x8 load8(int row, int k0) const { const f32x4* q = (const f32x4*)(p + (size_t)row * ld + k0); return pack8(q[0], q[1]); }
};
struct OpF32KN {
    static constexpr bool ROWFAST = true; const float* p; int ld; int c0;
    __device__ __forceinline__ bf16x8 load8(int n, int k0) const {
        const float* q = p + (size_t)k0 * ld + c0 + n; float v[8];
#pragma unroll
        for (int j = 0; j < 8; ++j) v[j] = q[(size_t)j * ld];
        return pack8((f32x4){v[0], v[1], v[2], v[3]}, (f32x4){v[4], v[5], v[6], v[7]});
    }
};
struct OpF32KNPair {
    static constexpr bool ROWFAST = true; const float* w0; long delta; int ld;
    __device__ __forceinline__ bf16x8 load8(int n, int k0) const {
        const int f = ((n >> 5) << 4) | (n & 15); const float* q = w0 + (long)((n >> 4) & 1) * delta + (size_t)k0 * ld + f; float v[8];
#pragma unroll
        for (int j = 0; j < 8; ++j) v[j] = q[(size_t)j * ld];
        return pack8((f32x4){v[0], v[1], v[2], v[3]}, (f32x4){v[4], v[5], v[6], v[7]});
    }
};


struct Args { const float* in[24]; float* out; unsigned char* ws; int ph_lo, ph_hi; };
typedef const __attribute__((address_space(4))) Args* KArgs;
struct Frame {
    LAS unsigned char* lds; int wave, G, bid;
    unsigned char* ws; float* xo;
    __device__ __forceinline__ int lane() const { return lane_id_here(); }
    __device__ __forceinline__ int tid() const { return wave * 64 + lane_id_here(); }
};

namespace pg8 {
constexpr int BM = 256, BK = 64, HALF = 128, HTB = HALF * BK * 2, STAGE_BYTES = 8 * HTB, NXCD = 8, WGM = 8;
__device__ __forceinline__ int lds_byte(int r, int c) { const int st = (r >> 4) * 2 + (c >> 5), rr = r & 15, cc = c & 31, ob = rr * 64 + cc * 2; return st * 1024 + (ob ^ (((ob >> 9) & 1) << 5)); }
__device__ __forceinline__ void stage_rc(int b, int& R, int& C) { const int st = b / 1024, sb = b % 1024, swz = sb ^ (((sb >> 9) & 1) << 5); R = (st >> 1) * 16 + swz / 64; C = (st & 1) * 32 + (swz % 64) / 2; }
__device__ __forceinline__ int perm32(int rho) { const int n = rho >> 4, i = rho & 15; return 8 * (i >> 2) + 4 * n + (i & 3); }
struct Unit { int pm, pn; };
typedef int v8i_t __attribute__((ext_vector_type(8)));
__device__ __forceinline__ v8i_t cat8(const bf16x8 lo, const bf16x8 hi) { typedef int v4i_t __attribute__((ext_vector_type(4))); const v4i_t a = __builtin_bit_cast(v4i_t, lo), b = __builtin_bit_cast(v4i_t, hi); return (v8i_t){a.x, a.y, a.z, a.w, b.x, b.y, b.z, b.w}; }
struct StaticOrder {
    int nM, nN, nwg, G, c;
    __device__ void init(int M, int N, int G_, int c_) { nM = M / BM; nN = N / BM; nwg = nM * nN; G = G_; c = c_; }
    __device__ bool next(int i, Unit& u) const {
        const long L = (long)i * G + c; if (L >= nwg) return false;
        int wgid = (int)L; { const int q = nwg / NXCD, r = nwg % NXCD, xcd = wgid % NXCD, off = wgid / NXCD; wgid = (xcd < r ? xcd * (q + 1) : r * (q + 1) + (xcd - r) * q) + off; }
        const int nig = WGM * nN, gid = wgid / nig, fm = gid * WGM, gsz = (nM - fm) < WGM ? (nM - fm) : WGM;
        u.pm = fm + ((wgid % nig) % gsz); u.pn = (wgid % nig) / gsz; return true;
    }
};
struct ExpertOrder {
    int nN, nwg, G, c;
    __device__ void init(int nN_, int G_, int c_) { nN = nN_; nwg = NE * 16 * nN_; G = G_; c = c_; }
    __device__ bool next(int i, Unit& u) const { const long L = (long)i * G + c; if (L >= nwg) return false;
        int combo = (int)(L >> 4), pml = (int)(L & 15);
        if (G == 256) { const int x = c & 7, j = c >> 3; combo = 16 * i + 4 * (x >> 1) + (j >> 3); pml = 8 * (x & 1) + (j & 7); }
        const int e = combo / nN; u.pn = combo - e * nN; u.pm = e * 16 + pml; return true; }
};
struct PolPlain {
    static constexpr bool DYN = false, FP8 = false, BSWITCH = false; const bf16* A; const bf16* Bt; int lda, ldb, K;
    __device__ __forceinline__ const char* a_base(const Unit& u) const { return (const char*)(A + (size_t)u.pm * BM * lda); }
    __device__ __forceinline__ const char* b_base(const Unit& u) const { return (const char*)(Bt + (size_t)u.pn * BM * ldb); }
    __device__ __forceinline__ unsigned a_off(int h, int R, int C, const Unit&) const { return (unsigned)((h * HALF + R) * lda + C) * 2u; }
    __device__ __forceinline__ unsigned b_off(int h, int R, int C) const { return (unsigned)((h * HALF + R) * ldb + C) * 2u; }
};
struct PolG1a {
    static constexpr bool DYN = false, FP8 = false, BSWITCH = false; const bf16* A; const bf16* H; int K;
    __device__ __forceinline__ const char* a_base(const Unit& u) const { return (const char*)(A + (size_t)u.pm * BM * DM); }
    __device__ __forceinline__ const char* b_base(const Unit& u) const { return (const char*)(H + ((size_t)(u.pn >> 5) * SEQ + 2 * (u.pn & 31)) * DM); }
    __device__ __forceinline__ unsigned a_off(int h, int R, int C, const Unit&) const { return (unsigned)((h * HALF + R) * DM + C) * 2u; }
    __device__ __forceinline__ unsigned b_off(int h, int R, int C) const { return (unsigned)((64 * R + h) * DM + C) * 2u; }
};
struct PolExpUp {
    static constexpr bool DYN = true, FP8 = false, BSWITCH = false; const bf16* H2; const int* idx; const bf16* W; int K;
    __device__ __forceinline__ const char* a_base(const Unit&) const { return (const char*)H2; }
    __device__ __forceinline__ const char* b_base(const Unit& u) const { return (const char*)(W + ((size_t)(u.pm >> 4) * (2 * DE) + (size_t)u.pn * BM) * DM); }
    __device__ __forceinline__ unsigned a_off(int h, int R, int C, const Unit& u) const { return (unsigned)idx[u.pm * BM + h * HALF + R] * (unsigned)(DM * 2) + (unsigned)C * 2u; }
    __device__ __forceinline__ unsigned b_off(int h, int R, int C) const { return (unsigned)((h * HALF + R) * DM + C) * 2u; }
};
struct PolExpUp8 {
    static constexpr bool DYN = true, FP8 = true, BSWITCH = false; const unsigned char* H2; const int* idx; const unsigned char* W; int K;
    __device__ __forceinline__ const char* a_base(const Unit&) const { return (const char*)H2; }
    __device__ __forceinline__ const char* b_base(const Unit& u) const { return (const char*)(W + ((size_t)(u.pm >> 4) * (2 * DE) + (size_t)u.pn * BM) * DM); }
    __device__ __forceinline__ unsigned a_off(int h, int R, int C, const Unit& u) const { return (unsigned)idx[u.pm * BM + h * HALF + R] * (unsigned)DM + (unsigned)C * 2u; }
    __device__ __forceinline__ unsigned b_off(int h, int R, int C) const { return (unsigned)((h * HALF + R) * DM) + (unsigned)C * 2u; }
};
struct PolExpDown8 {
    static constexpr bool DYN = false, FP8 = true, BSWITCH = false; const unsigned char* A; const unsigned char* W; int K;
    __device__ __forceinline__ const char* a_base(const Unit& u) const { return (const char*)(A + (size_t)u.pm * BM * DE); }
    __device__ __forceinline__ const char* b_base(const Unit& u) const { return (const char*)(W + ((size_t)(u.pm >> 4) * DM + (size_t)u.pn * BM) * DE); }
    __device__ __forceinline__ unsigned a_off(int h, int R, int C, const Unit&) const { return (unsigned)((h * HALF + R) * DE) + (unsigned)C * 2u; }
    __device__ __forceinline__ unsigned b_off(int h, int R, int C) const { return (unsigned)((h * HALF + R) * DE) + (unsigned)C * 2u; }
};
struct PolExpDown {
    static constexpr bool DYN = false, FP8 = false, BSWITCH = false; const bf16* A; const bf16* W; int K;
    __device__ __forceinline__ const char* a_base(const Unit& u) const { return (const char*)(A + (size_t)u.pm * BM * DE); }
    __device__ __forceinline__ const char* b_base(const Unit& u) const { return (const char*)(W + ((size_t)(u.pm >> 4) * DM + (size_t)u.pn * BM) * DE); }
    __device__ __forceinline__ unsigned a_off(int h, int R, int C, const Unit&) const { return (unsigned)((h * HALF + R) * DE + C) * 2u; }
    __device__ __forceinline__ unsigned b_off(int h, int R, int C) const { return (unsigned)((h * HALF + R) * DE + C) * 2u; }
};

struct PolPassB {
    static constexpr bool DYN = false, FP8 = false, BSWITCH = false; const bf16* A; const bf16* W; int K;
    __device__ __forceinline__ const char* a_base(const Unit& u) const { return (const char*)(A + (size_t)u.pm * BM * KCAT); }
    __device__ __forceinline__ const char* b_base(const Unit& u) const { return (const char*)(W + ((size_t)(u.pm >> 1) * 1024 + (size_t)u.pn * BM) * KCAT); }
    __device__ __forceinline__ unsigned a_off(int h, int R, int C, const Unit&) const { return (unsigned)((h * HALF + R) * KCAT + C) * 2u; }
    __device__ __forceinline__ unsigned b_off(int h, int R, int C) const { return (unsigned)((h * HALF + R) * KCAT + C) * 2u; }
};
struct PolStageC {
    static constexpr bool DYN = false, FP8 = false, BSWITCH = false; const bf16* A; const bf16* Y; int K;
    __device__ __forceinline__ const char* a_base(const Unit&) const { return (const char*)A; }
    __device__ __forceinline__ const char* b_base(const Unit& u) const { return (const char*)(Y + (size_t)u.pn * 2 * 128 * 128); }
    __device__ __forceinline__ unsigned a_off(int h, int R, int C, const Unit&) const { return (unsigned)((h * HALF + R) * 128 + C) * 2u; }
    __device__ __forceinline__ unsigned b_off(int h, int R, int C) const { return (unsigned)((((R >> 6) * 128 + h * 64 + (R & 63)) * 128) + C) * 2u; }
};
struct PolPassB2 {
    static constexpr bool DYN = false, FP8 = false, BSWITCH = true; static constexpr int KSW = 16;
    const bf16* A; const bf16* KC; const bf16* CT; int K;
    __device__ __forceinline__ const char* a_base(const Unit& u) const { return (const char*)(A + (size_t)u.pm * BM * KCAT); }
    __device__ __forceinline__ unsigned a_off(int h, int R, int C, const Unit&) const { return (unsigned)((h * HALF + R) * KCAT + C) * 2u; }
    __device__ __forceinline__ const char* b_base(const Unit& u) const { return (const char*)(KC + (size_t)(u.pm >> 1) * (128 * 256)) + (size_t)u.pn * 8192; }
    __device__ __forceinline__ unsigned b_off(int h, int R, int C) const { const int row = h * HALF + R; return (unsigned)((((row >> 4) - (C >> 4) + 63) * 256 + (row & 15) * 16 + (C & 15)) * 2); }
    __device__ __forceinline__ long kstepB1() const { return -2048; }
    __device__ __forceinline__ const char* b_base2(const Unit& u) const { return (const char*)(CT + ((size_t)(u.pm >> 1) * 1024 + (size_t)u.pn * BM) * 256); }
    __device__ __forceinline__ unsigned b_off2(int h, int R, int C) const { return (unsigned)((h * HALF + R) * 256 + C) * 2u; }
    __device__ __forceinline__ long kstepB2() const { return 128; }
};
struct LinearOrder {
    int nN, nwg, G, c;
    __device__ void init(int nM_, int nN_, int G_, int c_) { nN = nN_; nwg = nM_ * nN_; G = G_; c = c_; }
    __device__ bool next(int i, Unit& u) const { const long L = (long)i * G + c; if (L >= nwg) return false; u.pm = (int)(L / nN); u.pn = (int)(L % nN); return true; }
};
template <class E, class = void> struct epi_side { static constexpr bool v = false; };
template <class E> struct epi_side<E, decltype((void)E::SIDE)> { static constexpr bool v = E::SIDE; };
constexpr int LDS_SIDE = 132 * 1024;
template <class Pol> __device__ __forceinline__ constexpr int ksw_of() { if constexpr (Pol::BSWITCH) return Pol::KSW; else return 0; }
template <class Pol, class Epi, class Sched>
__device__ __forceinline__ void gemm_phase(LAS unsigned char* lds, const Pol& P, const Sched& S, const Epi& E, int wid) {
    const int lane = lane_id_here(), tid = wid * 64 + lane, wr = wid >> 2, wc = wid & 3, fr = lane & 15, fq = lane >> 4;
    int nt = P.K / BK; asm volatile("" : "+s"(nt));
    Unit cur, nxt; int ui = 0;
    if (!S.next(0, cur)) return;
    int sR[2], sC[2], sRb[2];
#pragma unroll
    for (int i = 0; i < 2; ++i) { stage_rc(tid * 16 + i * 8192, sR[i], sC[i]); sRb[i] = Epi::PERM ? ((sR[i] & ~31) + perm32(sR[i] & 31)) : sR[i]; }
    unsigned vA[2][2], vB[2], vB2[2], vAn[2][2];
    const size_t hsB1 = (size_t)(P.b_off(1, 0, 0) - P.b_off(0, 0, 0)); size_t hsB2 = 0;
#pragma unroll
    for (int i = 0; i < 2; ++i) { vB[i] = P.b_off(0, sRb[i], sC[i]); vB2[i] = 0u;
#pragma unroll
        for (int h = 0; h < 2; ++h) { vA[h][i] = P.a_off(h, sR[i], sC[i], cur); vAn[h][i] = vA[h][i]; } }
    if constexpr (Pol::BSWITCH) { hsB2 = (size_t)(P.b_off2(1, 0, 0) - P.b_off2(0, 0, 0));
#pragma unroll
        for (int i = 0; i < 2; ++i) vB2[i] = P.b_off2(0, sRb[i], sC[i]); }
    if (Pol::DYN) asm volatile("s_waitcnt vmcnt(0)" ::: "memory");
    const size_t kstep = (size_t)(BK * 2);
    long ksB = (long)kstep, ksB2 = 0; if constexpr (Pol::BSWITCH) { ksB = P.kstepB1(); ksB2 = P.kstepB2(); }
    const unsigned ldsw = (unsigned)wid * 1024u;
    const int aoff = lds_byte(wr * 64 + fr, fq * 8), boff = lds_byte(wc * 32 + fr, fq * 8);
#define PG8_SA(b, h) (((b) * 2 + (h)) * HTB)
#define PG8_SB(b, h) ((4 + (b) * 2 + (h)) * HTB)
#define PG8_STG(bufoff, gbase, voff2) do { _Pragma("unroll") for (int _i = 0; _i < 2; ++_i) { unsigned _o = (voff2)[_i]; asm volatile("" : "+v"(_o));     \
        __builtin_amdgcn_global_load_lds((const unsigned*)((const char*)(gbase) + _o), (LAS unsigned*)(lds + (bufoff) + ldsw + _i * 8192), 16, 0, 0); } } while (0)
#define PG8_LDA(dst, b, h) do { if constexpr (Pol::FP8) { _Pragma("unroll") for (int m = 0; m < 4; ++m) dst##8[m] = cat8(*(const LAS bf16x8*)(lds + PG8_SA(b, h) + aoff + m * 2048), *(const LAS bf16x8*)(lds + PG8_SA(b, h) + aoff + m * 2048 + 1024)); } \
        else { _Pragma("unroll") for (int m = 0; m < 4; ++m) _Pragma("unroll") for (int k = 0; k < 2; ++k) dst[m][k] = *(const LAS bf16x8*)(lds + PG8_SA(b, h) + aoff + m * 2048 + k * 1024); } } while (0)
#define PG8_LDB(dst, b, h) do { if constexpr (Pol::FP8) { _Pragma("unroll") for (int n = 0; n < 2; ++n) dst##8[n] = cat8(*(const LAS bf16x8*)(lds + PG8_SB(b, h) + boff + n * 2048), *(const LAS bf16x8*)(lds + PG8_SB(b, h) + boff + n * 2048 + 1024)); } \
        else { _Pragma("unroll") for (int n = 0; n < 2; ++n) _Pragma("unroll") for (int k = 0; k < 2; ++k) dst[n][k] = *(const LAS bf16x8*)(lds + PG8_SB(b, h) + boff + n * 2048 + k * 1024); } } while (0)
#define PG8_MMA(ai, bj, At, Bt) do { __builtin_amdgcn_s_setprio(1); \
        if constexpr (Pol::FP8) { _Pragma("unroll") for (int m = 0; m < 4; ++m) _Pragma("unroll") for (int n = 0; n < 2; ++n) \
            acc[ai][bj][m][n] = __builtin_amdgcn_mfma_scale_f32_16x16x128_f8f6f4(Bt##8[n], At##8[m], acc[ai][bj][m][n], 0, 0, 0, 0x7f7f7f7f, 0, 0x7f7f7f7f); } \
        else { _Pragma("unroll") for (int m = 0; m < 4; ++m) _Pragma("unroll") for (int n = 0; n < 2; ++n) _Pragma("unroll") for (int k = 0; k < 2; ++k) \
            acc[ai][bj][m][n] = __builtin_amdgcn_mfma_f32_16x16x32_bf16(Bt[n][k], At[m][k], acc[ai][bj][m][n], 0, 0, 0); } \
        __builtin_amdgcn_s_setprio(0); } while (0)
#define PG8_WAIT_V(n) asm volatile("s_waitcnt vmcnt(" #n ")" ::: "memory")
#define PG8_WAIT_L(n) asm volatile("s_waitcnt lgkmcnt(" #n ")" ::: "memory")
#define PG8_BAR __builtin_amdgcn_s_barrier()
#define PG8_SCHED __builtin_amdgcn_sched_barrier(0)
    f32x4 acc[2][2][4][2];
#pragma unroll
    for (int a = 0; a < 2; ++a)
#pragma unroll
        for (int b = 0; b < 2; ++b)
#pragma unroll
            for (int m = 0; m < 4; ++m)
#pragma unroll
                for (int n = 0; n < 2; ++n) acc[a][b][m][n] = (f32x4){0.f, 0.f, 0.f, 0.f};
    bf16x8 At[4][2], B0[2][2], B1[2][2]; v8i_t At8[4], B08[2], B18[2]; (void)At; (void)B0; (void)B1; (void)At8; (void)B08; (void)B18;
    const char* cA = P.a_base(cur); const char* cB = P.b_base(cur);
    PG8_STG(PG8_SB(0, 0), cB, vB); PG8_STG(PG8_SB(0, 1), cB + hsB1, vB); PG8_STG(PG8_SA(0, 0), cA, vA[0]); PG8_STG(PG8_SA(0, 1), cA, vA[1]);
    if (wr == 1) PG8_BAR;
    PG8_WAIT_V(2); PG8_BAR;
    PG8_STG(PG8_SB(1, 0), cB + ksB, vB); PG8_STG(PG8_SA(1, 0), cA + kstep, vA[0]); PG8_STG(PG8_SB(1, 1), cB + ksB + hsB1, vB);
    PG8_WAIT_V(6); PG8_BAR;
    for (;;) {
        const bool has_next = S.next(ui + 1, nxt);
        const char* nA = has_next ? P.a_base(nxt) : cA; const char* nB = has_next ? P.b_base(nxt) : cB;
        const char* cB2 = cB; if constexpr (Pol::BSWITCH) cB2 = P.b_base2(cur);
        if constexpr (epi_side<Epi>::v) { if (wid == 0) { unsigned so = (unsigned)lane_id_here() * 16u; asm volatile("" : "+v"(so));
            __builtin_amdgcn_global_load_lds((const unsigned*)((const char*)E.side_ptr(cur) + so), (LAS unsigned*)(lds + LDS_SIDE + (ui & 1) * 1024), 16, 0, 0); } }
        if (Pol::DYN) {
            if (has_next) {
#pragma unroll
                for (int i = 0; i < 2; ++i) { int R_, C_; stage_rc(tid * 16 + i * 8192, R_, C_);
#pragma unroll
                    for (int h = 0; h < 2; ++h) vAn[h][i] = P.a_off(h, R_, C_, nxt); }
                asm volatile("s_waitcnt vmcnt(0)" ::: "memory");
            } else {
#pragma unroll
                for (int h = 0; h < 2; ++h)
#pragma unroll
                    for (int i = 0; i < 2; ++i) vAn[h][i] = vA[h][i];
            }
        }
        for (int t = 0; t < nt; t += 2) {
            const bool last = (t == nt - 2);
            const char* a1 = cA + (size_t)(t + 1) * kstep;
            const char* a2 = last ? nA : cA + (size_t)(t + 2) * kstep; const char* a3 = a2 + kstep;
            const char* b2; const char* b3; unsigned wB[2]; size_t hsB = hsB1;
            { bool r2 = false; if constexpr (Pol::BSWITCH) r2 = !last && (t + 2 >= ksw_of<Pol>());
              if (last) { b2 = nB; b3 = b2 + ksB; } else if (r2) { b2 = cB2 + (long)(t + 2 - ksw_of<Pol>()) * ksB2; b3 = b2 + ksB2; hsB = hsB2; } else { b2 = cB + (long)(t + 2) * ksB; b3 = b2 + ksB; }
#pragma unroll
              for (int i = 0; i < 2; ++i) wB[i] = r2 ? vB2[i] : vB[i]; }
            PG8_LDB(B0, 0, 0); PG8_LDB(B1, 0, 1); PG8_SCHED; PG8_LDA(At, 0, 0); PG8_STG(PG8_SA(1, 1), a1, vA[1]);
            if (Pol::DYN && last) {
#pragma unroll
                for (int h = 0; h < 2; ++h)
#pragma unroll
                    for (int i = 0; i < 2; ++i) vA[h][i] = vAn[h][i]; }
            PG8_WAIT_V(8); PG8_WAIT_L(0); PG8_BAR; PG8_MMA(0, 0, At, B0); PG8_MMA(0, 1, At, B1); PG8_BAR; PG8_SCHED;
            PG8_LDA(At, 0, 1); PG8_STG(PG8_SB(0, 0), b2, wB); PG8_STG(PG8_SB(0, 1), b2 + hsB, wB); PG8_STG(PG8_SA(0, 0), a2, vA[0]);
            PG8_WAIT_V(8); PG8_WAIT_L(0); PG8_BAR; PG8_MMA(1, 0, At, B0); PG8_MMA(1, 1, At, B1); PG8_BAR; PG8_SCHED;
            PG8_LDB(B0, 1, 0); PG8_LDB(B1, 1, 1); PG8_SCHED; PG8_LDA(At, 1, 0); PG8_STG(PG8_SA(0, 1), a2, vA[1]);
            PG8_WAIT_V(8); PG8_WAIT_L(0); PG8_BAR; PG8_MMA(0, 0, At, B0); PG8_MMA(0, 1, At, B1); PG8_BAR; PG8_SCHED;
            PG8_LDA(At, 1, 1); PG8_STG(PG8_SB(1, 0), b3, wB); PG8_STG(PG8_SB(1, 1), b3 + hsB, wB); PG8_STG(PG8_SA(1, 0), a3, vA[0]);
            PG8_WAIT_V(8); PG8_WAIT_L(0); PG8_BAR; PG8_MMA(1, 0, At, B0); PG8_MMA(1, 1, At, B1); PG8_BAR; PG8_SCHED;
        }
        if (wr == 0) PG8_BAR;
        { Unit eu = cur; int et = lane_id_here(); asm volatile("" : "+s"(eu.pm), "+s"(eu.pn), "+v"(et)); const int efr = et & 15, efq = (et >> 4) & 3;
          if constexpr (epi_side<Epi>::v) E(acc, eu, wr, wc, efr, efq, (const LAS float*)(lds + LDS_SIDE + (ui & 1) * 1024)); else E(acc, eu, wr, wc, efr, efq); }
        if (!has_next) break;
#pragma unroll
        for (int a = 0; a < 2; ++a)
#pragma unroll
            for (int b = 0; b < 2; ++b)
#pragma unroll
                for (int m = 0; m < 4; ++m)
#pragma unroll
                    for (int n = 0; n < 2; ++n) acc[a][b][m][n] = (f32x4){0.f, 0.f, 0.f, 0.f};
        cur = nxt; cA = nA; cB = nB; ++ui;
        if (Pol::DYN) {
#pragma unroll
            for (int h = 0; h < 2; ++h)
#pragma unroll
                for (int i = 0; i < 2; ++i) vA[h][i] = vAn[h][i];
        }
        if (wr == 1) PG8_BAR;
    }
    PG8_WAIT_V(0);
    PG8_BAR;
#undef PG8_SA
#undef PG8_SB
#undef PG8_STG
#undef PG8_LDA
#undef PG8_LDB
#undef PG8_MMA
#undef PG8_WAIT_V
#undef PG8_WAIT_L
#undef PG8_BAR
#undef PG8_SCHED
}

__device__ __forceinline__ u32x4 pk8(const f32x4 a, const f32x4 b) { u32x4 w; w.x = cvt_pk_bf16(a.x, a.y); w.y = cvt_pk_bf16(a.z, a.w); w.z = cvt_pk_bf16(b.x, b.y); w.w = cvt_pk_bf16(b.z, b.w); return w; }
__device__ __forceinline__ void unpk8(const u32x4 w, f32x4& a, f32x4& b) {
    a.x = __uint_as_float(w.x << 16); a.y = __uint_as_float(w.x & 0xffff0000u); a.z = __uint_as_float(w.y << 16); a.w = __uint_as_float(w.y & 0xffff0000u);
    b.x = __uint_as_float(w.z << 16); b.y = __uint_as_float(w.z & 0xffff0000u); b.z = __uint_as_float(w.w << 16); b.w = __uint_as_float(w.w & 0xffff0000u); }
__device__ __forceinline__ f32x4 sig4(const f32x4 v) { return (f32x4){sigmoidf_(v.x), sigmoidf_(v.y), sigmoidf_(v.z), sigmoidf_(v.w)}; }
__device__ __forceinline__ u32x2 pk8_u8(const f32x4 a, const f32x4 b) {
    unsigned lo = 0u, hi = 0u;
    lo = __builtin_amdgcn_cvt_pk_u8_f32(a.x * 255.0f, 0, lo); lo = __builtin_amdgcn_cvt_pk_u8_f32(a.y * 255.0f, 1, lo); lo = __builtin_amdgcn_cvt_pk_u8_f32(a.z * 255.0f, 2, lo); lo = __builtin_amdgcn_cvt_pk_u8_f32(a.w * 255.0f, 3, lo);
    hi = __builtin_amdgcn_cvt_pk_u8_f32(b.x * 255.0f, 0, hi); hi = __builtin_amdgcn_cvt_pk_u8_f32(b.y * 255.0f, 1, hi); hi = __builtin_amdgcn_cvt_pk_u8_f32(b.z * 255.0f, 2, hi); hi = __builtin_amdgcn_cvt_pk_u8_f32(b.w * 255.0f, 3, hi);
    return (u32x2){lo, hi};
}
__device__ __forceinline__ void unpk8_u8(const u32x2 w, f32x4& a, f32x4& b) {
    constexpr float k = 1.0f / 255.0f;
    a = (f32x4){(float)(w.x & 255u) * k, (float)((w.x >> 8) & 255u) * k, (float)((w.x >> 16) & 255u) * k, (float)(w.x >> 24) * k};
    b = (f32x4){(float)(w.y & 255u) * k, (float)((w.y >> 8) & 255u) * k, (float)((w.y >> 16) & 255u) * k, (float)(w.y >> 24) * k};
}
#define PG8_EPI_LOOP for (int ai = 0; ai < 2; ++ai) _Pragma("unroll") for (int m = 0; m < 4; ++m) _Pragma("unroll") for (int bj = 0; bj < 2; ++bj)
struct EpiXt {
    static constexpr bool PERM = true; bf16* XT;
    __device__ __forceinline__ void operator()(const f32x4 (&acc)[2][2][4][2], const Unit& u, int wr, int wc, int fr, int fq) const {
        const int b = u.pn >> 5, n1 = wc * 32 + 8 * fq;
#pragma unroll
        PG8_EPI_LOOP { const int r = u.pm * BM + ai * HALF + wr * 64 + m * 16 + fr, g = r >> 7, pqc = r & 127, n2 = 2 * (u.pn & 31) + bj;
            *(u32x4*)(XT + ((((size_t)(b * 4 + g) * 128 + pqc) * 64 + n2) * 128 + n1)) = pk8(acc[ai][bj][m][0], acc[ai][bj][m][1]); }
    }
};
struct EpiG1b {
    static constexpr bool PERM = true; bf16* ACAT; unsigned char* GF; unsigned char* GS;
    __device__ __forceinline__ void operator()(const f32x4 (&acc)[2][2][4][2], const Unit& u, int wr, int wc, int fr, int fq) const {
#pragma unroll
        PG8_EPI_LOOP { const int r = u.pm * BM + ai * HALF + wr * 64 + m * 16 + fr, c = u.pn * BM + bj * HALF + wc * 32 + 8 * fq;
            if (c < 512) { const int g = c >> 4; *(u32x4*)(ACAT + ((size_t)(g * NROWC + (r >> 6)) * KCAT + (r & 63) * 16 + (c & 15))) = pk8(acc[ai][bj][m][0], acc[ai][bj][m][1]); }
            else { const int cc = c - 512; const u32x2 w = pk8_u8(sig4(acc[ai][bj][m][0]), sig4(acc[ai][bj][m][1]));
                if (cc < 1024) *(u32x2*)(GF + (size_t)r * DM + cc) = w; else *(u32x2*)(GS + (size_t)r * DM + (cc - 1024)) = w; } }
    }
};
struct EpiPassB {
    static constexpr bool PERM = true; bf16* YS;
    __device__ __forceinline__ void operator()(const f32x4 (&acc)[2][2][4][2], const Unit& u, int wr, int wc, int fr, int fq) const {
#pragma unroll
        PG8_EPI_LOOP { const int r = u.pm * BM + ai * HALF + wr * 64 + m * 16 + fr, c = u.pn * BM + bj * HALF + wc * 32 + 8 * fq, g = r >> 9, s = c >> 4, o = c & 15;
            const f32x4 v0 = acc[ai][bj][m][0], v1 = acc[ai][bj][m][1];
            *(u32x4*)(YS + ((size_t)((r & 511) * 64 + s) * 512 + g * 16 + o)) = pk8((f32x4){gelu_tanh(v0.x), gelu_tanh(v0.y), gelu_tanh(v0.z), gelu_tanh(v0.w)}, (f32x4){gelu_tanh(v1.x), gelu_tanh(v1.y), gelu_tanh(v1.z), gelu_tanh(v1.w)}); }
    }
};
struct EpiStageA {
    static constexpr bool PERM = true; bf16* Y; const f32x2* TW;
    __device__ __forceinline__ void operator()(const f32x4 (&acc)[2][2][4][2], const Unit& u, int wr, int wc, int fr, int fq) const {
        const int bg = u.pn >> 5, n2 = 32 * (wc & 1) + 8 * fq;
        f32x2 tq0[4], tq1[4];
#pragma unroll
        for (int m = 0; m < 4; ++m) { const int k1 = 64 * wr + 16 * m + fr; tq0[m] = TW[n2 * k1]; tq1[m] = TW[k1]; }
        asm volatile("s_waitcnt vmcnt(0)" ::: "memory");
#pragma unroll
        for (int m = 0; m < 4; ++m) { const int k1 = 64 * wr + 16 * m + fr; const f32x2 t0 = tq0[m], t1 = tq1[m];
            float twc[8], tws[8]; twc[0] = t0.x; tws[0] = t0.y;
#pragma unroll
            for (int q = 1; q < 8; ++q) { twc[q] = twc[q - 1] * t1.x - tws[q - 1] * t1.y; tws[q] = tws[q - 1] * t1.x + twc[q - 1] * t1.y; }
#pragma unroll
            for (int bj = 0; bj < 2; ++bj) { const int pqc = 4 * (u.pn & 31) + 2 * bj + (wc >> 1); f32x4 xr[2], xi[2];
#pragma unroll
                for (int n = 0; n < 2; ++n)
#pragma unroll
                    for (int j = 0; j < 4; ++j) { const float c_ = twc[4 * n + j], s_ = tws[4 * n + j], ar = acc[0][bj][m][n][j], ai_ = acc[1][bj][m][n][j];
                        const float br = ar * c_ + ai_ * s_, bi = ai_ * c_ - ar * s_; if (pqc >= 65) { xr[n][j] = -bi; xi[n][j] = br; } else { xr[n][j] = br; xi[n][j] = bi; } }
                bf16* yp = Y + (((size_t)(bg * 128 + k1) * 128 + pqc) * 128 + n2); *(u32x4*)yp = pk8(xr[0], xr[1]); *(u32x4*)(yp + 64) = pk8(xi[0], xi[1]); }
            asm volatile("" ::: "memory"); }
    }
};
struct EpiStageC {
    static constexpr bool PERM = true; bf16* FM;
    __device__ __forceinline__ void operator()(const f32x4 (&acc)[2][2][4][2], const Unit& u, int wr, int wc, int fr, int fq) const {
        if (wr != 0) return;
        const int bgk1 = 2 * u.pn + (wc >> 1), bg = bgk1 >> 7, k1 = bgk1 & 127, b = bg >> 2, g = bg & 3, c0 = 32 * (wc & 1) + 8 * fq;
#pragma unroll
        for (int m = 0; m < 4; ++m) { const int k2 = 16 * m + fr; f32x4 dr0 = acc[0][0][m][0] - acc[0][1][m][0], dr1 = acc[0][0][m][1] - acc[0][1][m][1], mr0 = acc[0][0][m][0] + acc[0][1][m][0], mr1 = acc[0][0][m][1] + acc[0][1][m][1];
            if (c0 == 0) { dr0.x = acc[0][0][m][0].x; mr0.x = acc[0][1][m][0].x; }
            bf16* o = FM + (size_t)(b * SEQ + k1 + 128 * k2) * 512 + g * 128 + c0; *(u32x4*)o = pk8(dr0, dr1); *(u32x4*)(o + 64) = pk8(mr0, mr1); }
    }
};
struct EpiBf16 {
    static constexpr bool PERM = true; bf16* O; int ld;
    __device__ __forceinline__ void operator()(const f32x4 (&acc)[2][2][4][2], const Unit& u, int wr, int wc, int fr, int fq) const {
#pragma unroll
        PG8_EPI_LOOP { const int r = u.pm * BM + ai * HALF + wr * 64 + m * 16 + fr, c = u.pn * BM + bj * HALF + wc * 32 + 8 * fq;
            *(u32x4*)(O + (size_t)r * ld + c) = pk8(acc[ai][bj][m][0], acc[ai][bj][m][1]); }
    }
};
struct EpiMulGate {
    static constexpr bool PERM = true; bf16* O; const unsigned char* G;
    __device__ __forceinline__ void operator()(const f32x4 (&acc)[2][2][4][2], const Unit& u, int wr, int wc, int fr, int fq) const {
#pragma unroll
        for (int ai = 0; ai < 2; ++ai) { u32x2 t[4][2];
#pragma unroll
            for (int m = 0; m < 4; ++m)
#pragma unroll
                for (int bj = 0; bj < 2; ++bj) t[m][bj] = *(const u32x2*)(G + (size_t)(u.pm * BM + ai * HALF + wr * 64 + m * 16 + fr) * DM + u.pn * BM + bj * HALF + wc * 32 + 8 * fq);
            asm volatile("s_waitcnt vmcnt(0)" ::: "memory");
#pragma unroll
            for (int m = 0; m < 4; ++m)
#pragma unroll
                for (int bj = 0; bj < 2; ++bj) { bf16* p = O + (size_t)(u.pm * BM + ai * HALF + wr * 64 + m * 16 + fr) * DM + u.pn * BM + bj * HALF + wc * 32 + 8 * fq;
                    f32x4 g0, g1; unpk8_u8(t[m][bj], g0, g1); *(u32x4*)p = pk8(acc[ai][bj][m][0] * g0, acc[ai][bj][m][1] * g1); } }
    }
};
struct EpiGlu {
    static constexpr bool PERM = true; bf16* MIX; const unsigned char* GS;
    __device__ __forceinline__ void operator()(const f32x4 (&acc)[2][2][4][2], const Unit& u, int wr, int wc, int fr, int fq) const {
#pragma unroll
        for (int ai = 0; ai < 2; ++ai) { u32x2 ts[4]; u32x4 tx[4];
#pragma unroll
            for (int m = 0; m < 4; ++m) { const size_t off = (size_t)(u.pm * BM + ai * HALF + wr * 64 + m * 16 + fr) * DM + u.pn * HALF + wc * 32 + 8 * fq; ts[m] = *(const u32x2*)(GS + off); tx[m] = *(const u32x4*)(MIX + off); }
            asm volatile("s_waitcnt vmcnt(0)" ::: "memory");
#pragma unroll
            for (int m = 0; m < 4; ++m) { const size_t off = (size_t)(u.pm * BM + ai * HALF + wr * 64 + m * 16 + fr) * DM + u.pn * HALF + wc * 32 + 8 * fq;
                f32x4 s0, s1, x0, x1; unpk8_u8(ts[m], s0, s1); unpk8(tx[m], x0, x1);
                *(u32x4*)(MIX + off) = pk8(acc[ai][0][m][0] * sig4(acc[ai][1][m][0]) * s0 + x0, acc[ai][0][m][1] * sig4(acc[ai][1][m][1]) * s1 + x1); } }
    }
};
struct EpiResidual {
    static constexpr bool PERM = false; float* O; const float* X;
    __device__ __forceinline__ void operator()(const f32x4 (&acc)[2][2][4][2], const Unit& u, int wr, int wc, int fr, int fq) const {
#pragma unroll
        for (int ai = 0; ai < 2; ++ai)
#pragma unroll
            for (int mp = 0; mp < 2; ++mp) { f32x4 t[2][2][2];
#pragma unroll
                for (int mm = 0; mm < 2; ++mm)
#pragma unroll
                    for (int bj = 0; bj < 2; ++bj)
#pragma unroll
                        for (int n = 0; n < 2; ++n) t[mm][bj][n] = *(const f32x4*)(X + (size_t)(u.pm * BM + ai * HALF + wr * 64 + (2 * mp + mm) * 16 + fr) * DM + u.pn * BM + bj * HALF + wc * 32 + 4 * fq + 16 * n);
#pragma unroll
                for (int mm = 0; mm < 2; ++mm)
#pragma unroll
                    for (int bj = 0; bj < 2; ++bj)
#pragma unroll
                        for (int n = 0; n < 2; ++n) *(f32x4*)(O + (size_t)(u.pm * BM + ai * HALF + wr * 64 + (2 * mp + mm) * 16 + fr) * DM + u.pn * BM + bj * HALF + wc * 32 + 4 * fq + 16 * n) = t[mm][bj][n] + acc[ai][bj][2 * mp + mm][n]; }
    }
};
struct EpiPle {
    static constexpr bool PERM = true, SIDE = true; const bf16* XI; bf16* XO; const bf16* EB; const float* RST;
    __device__ __forceinline__ const float* side_ptr(const Unit& u) const { return RST + (size_t)u.pm * BM; }
    __device__ __forceinline__ void operator()(const f32x4 (&acc)[2][2][4][2], const Unit& u, int wr, int wc, int fr, int fq, const LAS float* sd) const {
        float rs[2][4];
#pragma unroll
        for (int ai = 0; ai < 2; ++ai)
#pragma unroll
            for (int m = 0; m < 4; ++m) rs[ai][m] = sd[ai * HALF + wr * 64 + m * 16 + fr];
#pragma unroll
        for (int ai = 0; ai < 2; ++ai)
#pragma unroll
            for (int mp = 0; mp < 2; ++mp) { u32x4 tx[2][2], te[2][2];
#pragma unroll
                for (int mm = 0; mm < 2; ++mm)
#pragma unroll
                    for (int bj = 0; bj < 2; ++bj) { const size_t off = (size_t)(u.pm * BM + ai * HALF + wr * 64 + (2 * mp + mm) * 16 + fr) * DM + u.pn * BM + bj * HALF + wc * 32 + 8 * fq; tx[mm][bj] = *(const u32x4*)(XI + off); te[mm][bj] = *(const u32x4*)(EB + off); }
#pragma unroll
                for (int mm = 0; mm < 2; ++mm)
#pragma unroll
                    for (int bj = 0; bj < 2; ++bj) { const int m = 2 * mp + mm; const size_t off = (size_t)(u.pm * BM + ai * HALF + wr * 64 + m * 16 + fr) * DM + u.pn * BM + bj * HALF + wc * 32 + 8 * fq;
                        f32x4 x0, x1, e0, e1; unpk8(tx[mm][bj], x0, x1); unpk8(te[mm][bj], e0, e1);
                        *(u32x4*)(XO + off) = pk8(x0 + sig4(acc[ai][bj][m][0] * rs[ai][m]) * e0, x1 + sig4(acc[ai][bj][m][1] * rs[ai][m]) * e1); } }
    }
};
struct EpiSwiglu {
    static constexpr bool PERM = true, SIDE = true; unsigned char* HID; const float* rs; float sc, hs;
    __device__ __forceinline__ const float* side_ptr(const Unit& u) const { return rs + (size_t)u.pm * BM; }
    __device__ __forceinline__ void operator()(const f32x4 (&acc)[2][2][4][2], const Unit& u, int wr, int wc, int fr, int fq, const LAS float* sd) const {
#pragma unroll
        for (int ai = 0; ai < 2; ++ai)
#pragma unroll
            for (int m = 0; m < 4; ++m) { const int rl = ai * HALF + wr * 64 + m * 16 + fr, r = u.pm * BM + rl, f = u.pn * HALF + wc * 32 + 8 * fq;
                const float s1 = sd[rl] * sc, s2 = s1 * hs;
                const f32x4 g0 = acc[ai][0][m][0] * s1, g1 = acc[ai][0][m][1] * s1; const f32x4 h0 = g0 * sig4(g0) * (acc[ai][1][m][0] * s2), h1 = g1 * sig4(g1) * (acc[ai][1][m][1] * s2);
                u32x2 w; unsigned t = 0u; t = __builtin_amdgcn_cvt_pk_fp8_f32(clamp8(h0.x), clamp8(h0.y), t, false); t = __builtin_amdgcn_cvt_pk_fp8_f32(clamp8(h0.z), clamp8(h0.w), t, true); w.x = t;
                t = 0u; t = __builtin_amdgcn_cvt_pk_fp8_f32(clamp8(h1.x), clamp8(h1.y), t, false); t = __builtin_amdgcn_cvt_pk_fp8_f32(clamp8(h1.z), clamp8(h1.w), t, true); w.y = t;
                *(u32x2*)(HID + (size_t)r * DE + f) = w; }
    }
};
struct EpiScaleRows {
    static constexpr bool PERM = true, SIDE = true; bf16* O; const float* val; float sc;
    __device__ __forceinline__ const float* side_ptr(const Unit& u) const { return val + (size_t)u.pm * BM; }
    __device__ __forceinline__ void operator()(const f32x4 (&acc)[2][2][4][2], const Unit& u, int wr, int wc, int fr, int fq, const LAS float* sd) const {
#pragma unroll
        for (int ai = 0; ai < 2; ++ai)
#pragma unroll
            for (int m = 0; m < 4; ++m) { const int rl = ai * HALF + wr * 64 + m * 16 + fr, r = u.pm * BM + rl; const float s = sd[rl] * sc;
#pragma unroll
                for (int bj = 0; bj < 2; ++bj) { const int c = u.pn * BM + bj * HALF + wc * 32 + 8 * fq; *(u32x4*)(O + (size_t)r * DM + c) = pk8(acc[ai][bj][m][0] * s, acc[ai][bj][m][1] * s); } }
    }
};
}

__device__ __forceinline__ void rms_row_to_bf16(const float* xrow, const float* g, bf16* orow, int lane) {
    const f32x4* xr = (const f32x4*)xrow + lane; const f32x4* gr = (const f32x4*)g + lane;
    f32x4 v[4]; float s = 0.f;
#pragma unroll
    for (int j = 0; j < 4; ++j) { v[j] = xr[64 * j]; s += (v[j].x * v[j].x + v[j].y * v[j].y) + (v[j].z * v[j].z + v[j].w * v[j].w); }
    const float rstd = 1.0f / sqrtf(wave_sum(s) * (1.0f / DM) + RMS_EPS);
#pragma unroll
    for (int j = 0; j < 4; ++j) { const f32x4 gg = gr[64 * j]; store_bf16x4(orow + 4 * lane + 256 * j, (f32x4){v[j].x * rstd * gg.x, v[j].y * rstd * gg.y, v[j].z * rstd * gg.z, v[j].w * rstd * gg.w}); }
}

struct EpiStageA {
    bf16* Y; const f32x2* TW;
    __device__ __forceinline__ void tile(int row, int col, const f32x4 (&acc)[4][2]) const {
#pragma unroll
        for (int mp = 0; mp < 2; ++mp) { const int r = row + 32 * mp, k1 = ((r >> 5) << 4) | (r & 15);
#pragma unroll
            for (int n = 0; n < 2; ++n) { const int c = col + 16 * n, bg = c >> 13, pqc = (c >> 6) & 127, n2 = c & 63; f32x4 xr, xi;
#pragma unroll
                for (int j = 0; j < 4; ++j) { const f32x2 tw = TW[(n2 + j) * k1]; const float ar = acc[2 * mp][n][j], ai = acc[2 * mp + 1][n][j];
                    const float br = ar * tw.x + ai * tw.y, bi = ai * tw.x - ar * tw.y; if (pqc >= 65) { xr[j] = -bi; xi[j] = br; } else { xr[j] = br; xi[j] = bi; } }
                bf16* yp = Y + (((size_t)(bg * 128 + k1) * 128 + pqc) * 128 + n2); store_bf16x4(yp, xr); store_bf16x4(yp + 64, xi); } }
    }
};
struct EpiF32Plain { float* O; int ld;
    __device__ __forceinline__ void tile(int row, int col, const f32x4 (&acc)[4][2]) const {
#pragma unroll
        for (int m = 0; m < 4; ++m)
#pragma unroll
            for (int n = 0; n < 2; ++n) *(f32x4*)(O + (size_t)(row + 16 * m) * ld + col + 16 * n) = acc[m][n];
    }
};

struct OpDft2 {
    static constexpr bool ROWFAST = false; const bf16* D2;
    __device__ __forceinline__ bf16x8 load8(int row, int k0) const { if (row < 64) return *(const bf16x8*)(D2 + row * 128 + k0); return (bf16x8){0, 0, 0, 0, 0, 0, 0, 0}; }
};
struct OpYcols {
    static constexpr bool ROWFAST = false; const bf16* Y;
    __device__ __forceinline__ bf16x8 load8(int n, int k0) const { const int w = n & 127, c = ((w >> 5) << 4) | (w & 15), pq = (w >> 4) & 1; return *(const bf16x8*)(Y + ((size_t)(n >> 7) * 128 + pq * 64 + c) * 128 + k0); }
};
struct EpiStageC {
    bf16* FM;
    __device__ __forceinline__ void tile(int row, int col, const f32x4 (&acc)[4][2]) const {
        const int bgk1 = col >> 7, bg = bgk1 >> 7, k1 = bgk1 & 127, b = bg >> 2, g = bg & 3, c0 = (((col & 127) >> 5) << 4) | (col & 15);
#pragma unroll
        for (int m = 0; m < 4; ++m) { const int k2 = row + 16 * m; if (k2 < 64) { const f32x4 P = acc[m][0], Q = acc[m][1]; f32x4 dr = P - Q, mr = P + Q; if (c0 == 0) { dr.x = P.x; mr.x = Q.x; }
            bf16* o = FM + (size_t)(b * SEQ + k1 + 128 * k2) * 512 + g * 128 + c0; store_bf16x4(o, dr); store_bf16x4(o + 64, mr); } }
    }
};


__device__ __forceinline__ void phase_router(Frame& F, KArgs a) {
    unsigned char* ws = F.ws; unsigned char* H2 = ws + WS_H; float* AFF = (float*)(ws + OFF_AFF); float* RSD = (float*)(ws + OFF_RSD); (void)a;
    const int gw = F.bid * 8 + F.wave, NW = F.G * 8, lane = F.lane(), ri = lane & 15, q = lane >> 4;
    LAS f32x4* wl = (LAS f32x4*)F.lds;
    { const float* src = (const float*)(ws + OFF_WGT); for (int idx = F.tid(); idx < 64 * 64; idx += NTHR) { const int e = idx & 15, qq = (idx >> 4) & 3, j = idx >> 6; wl[idx] = *(const f32x4*)(src + e * DM + 16 * j + 4 * qq); } }
    asm volatile("s_waitcnt vmcnt(0)" ::: "memory"); __syncthreads();
    for (int tile = gw; tile < T / 16; tile += NW) { const int m0 = tile * 16;
        const f32x4* xr = (const f32x4*)(F.xo + (size_t)(m0 + ri) * DM) + q; unsigned char* hr = H2 + (size_t)(m0 + ri) * DM + 4 * q; const LAS f32x4* wrow = wl + lane;
        f32x4 ac0 = (f32x4){0.f, 0.f, 0.f, 0.f}, ac1 = ac0, ac2 = ac0, ac3 = ac0; float ss = 0.f;
#pragma unroll 1
        for (int half = 0; half < 2; ++half) { f32x4 v[32];
#pragma unroll
            for (int t = 0; t < 32; ++t) v[t] = xr[4 * (32 * half + t)];
            asm volatile("s_waitcnt vmcnt(0)" ::: "memory");
#pragma unroll
            for (int t = 0; t < 32; ++t) { const int j = 32 * half + t; const f32x4 x = v[t]; const f32x4 w = wrow[64 * j];
                ss += (x.x * x.x + x.y * x.y) + (x.z * x.z + x.w * x.w);
                unsigned w8 = 0u; w8 = __builtin_amdgcn_cvt_pk_fp8_f32(clamp8(x.x), clamp8(x.y), w8, false); w8 = __builtin_amdgcn_cvt_pk_fp8_f32(clamp8(x.z), clamp8(x.w), w8, true);
                *(unsigned*)(hr + 16 * j) = w8;
                ac0 = __builtin_amdgcn_mfma_f32_16x16x4f32(x.x, w.x, ac0, 0, 0, 0); ac1 = __builtin_amdgcn_mfma_f32_16x16x4f32(x.y, w.y, ac1, 0, 0, 0);
                ac2 = __builtin_amdgcn_mfma_f32_16x16x4f32(x.z, w.z, ac2, 0, 0, 0); ac3 = __builtin_amdgcn_mfma_f32_16x16x4f32(x.w, w.w, ac3, 0, 0, 0); }
        }
        ss += __shfl_xor(ss, 16); ss += __shfl_xor(ss, 32);
        const float rstd = 1.0f / sqrtf(ss * (1.0f / DM) + RMS_EPS);
        if (q == 0) RSD[m0 + ri] = rstd;
        const f32x4 lgv = (ac0 + ac1) + (ac2 + ac3);
#pragma unroll
        for (int r = 0; r < 4; ++r) { const float rs = __shfl(rstd, 4 * q + r); const float lg = lgv[r] * rs; float mx = lg;
#pragma unroll
            for (int o = 1; o < 16; o <<= 1) mx = fmaxf(mx, __shfl_xor(mx, o));
            const float ex = expf(lg - mx); float den = ex;
#pragma unroll
            for (int o = 1; o < 16; o <<= 1) den += __shfl_xor(den, o);
            AFF[(size_t)(m0 + 4 * q + r) * NE + ri] = ex / den; }
    }
}
__device__ __forceinline__ void phase_topk(Frame& F, KArgs a) {
    unsigned char* ws = F.ws; const float* AFF = (const float*)(ws + OFF_AFF); int* IDX = (int*)(ws + OFF_IDX); float* VAL = (float*)(ws + OFF_VAL); int* SLOT = (int*)(ws + OFF_SLOT); const float* RSD = (const float*)(ws + OFF_RSD); float* RSS = (float*)(ws + OFF_RSS);
    LAS unsigned* keys = (LAS unsigned*)F.lds; LAS unsigned* hist = keys + SEQ; LAS unsigned* ctl = hist + 256; LAS unsigned* wtot = ctl + 8;
    const int tid = F.tid(), lane = F.lane(), wave = F.wave;
    for (int be = F.bid; be < NB * NE; be += F.G) { const int b = be >> 4, e = be & 15; const float* src = AFF + (size_t)b * SEQ * NE + e;
        __syncthreads();
        for (int i = tid; i < SEQ; i += NTHR) keys[i] = __float_as_uint(src[(size_t)i * NE]);
        if (tid == 0) { ctl[0] = 0u; ctl[1] = CAP; }
        unsigned mask = 0u;
        for (int p = 3; p >= 0; --p) {
            if (tid < 256) hist[tid] = 0u;
            __syncthreads();
            const unsigned prefix = ctl[0];
            for (int i = tid; i < SEQ; i += NTHR) { const unsigned k = keys[i]; if ((k & mask) == prefix) atomicAdd((unsigned*)&hist[(k >> (8 * p)) & 255u], 1u); }
            __syncthreads();
            if (wave == 0) {
                const unsigned need = ctl[1]; const unsigned h0 = hist[4 * lane], h1 = hist[4 * lane + 1], h2 = hist[4 * lane + 2], h3 = hist[4 * lane + 3]; const unsigned loc = (h0 + h1) + (h2 + h3);
                unsigned suf = loc;
#pragma unroll
                for (int o = 1; o < 64; o <<= 1) { const unsigned t = __shfl_down(suf, o); if (lane + o < 64) suf += t; }
                const unsigned above = suf - loc;
                if (above < need && need <= suf) { unsigned cum = above; int bsel;
                    if (cum + h3 >= need) bsel = 4 * lane + 3; else { cum += h3; if (cum + h2 >= need) bsel = 4 * lane + 2; else { cum += h2; if (cum + h1 >= need) bsel = 4 * lane + 1; else { cum += h1; bsel = 4 * lane; } } }
                    ctl[0] = prefix | ((unsigned)bsel << (8 * p)); ctl[1] = need - cum; } }
            mask |= 0xFFu << (8 * p);
            __syncthreads();
        }
        const unsigned Tk = ctl[0], need_eq = ctl[1];
        unsigned cg = 0u, ce = 0u; unsigned kk[16];
#pragma unroll
        for (int q = 0; q < 16; ++q) { kk[q] = keys[tid * 16 + q]; cg += kk[q] > Tk ? 1u : 0u; ce += kk[q] == Tk ? 1u : 0u; }
        unsigned ig = cg, ie = ce;
#pragma unroll
        for (int o = 1; o < 64; o <<= 1) { const unsigned tg = __shfl_up(ig, o), te = __shfl_up(ie, o); if (lane >= o) { ig += tg; ie += te; } }
        if (lane == 63) { wtot[wave] = ig; wtot[8 + wave] = ie; }
        __syncthreads();
        unsigned bg = ig - cg, beq = ie - ce;
        for (int w = 0; w < wave; ++w) { bg += wtot[w]; beq += wtot[8 + w]; }
#pragma unroll
        for (int q = 0; q < 16; ++q) { const unsigned k = kk[q]; const bool gtv = k > Tk, eqv = k == Tk; const bool sel = gtv || (eqv && beq < need_eq);
            if (sel) { const unsigned pos = bg + (beq < need_eq ? beq : need_eq); const int i = tid * 16 + q; const int slot = b * CAP + (int)pos;
                IDX[e * 4096 + slot] = b * SEQ + i; VAL[e * 4096 + slot] = __uint_as_float(k); RSS[e * 4096 + slot] = RSD[b * SEQ + i]; SLOT[(size_t)e * T + b * SEQ + i] = slot; }
            bg += gtv ? 1u : 0u; beq += eqv ? 1u : 0u; }
    }
}

__device__ __forceinline__ void phase_final(Frame& F, KArgs a) {
    const float* g = a->in[23]; const bf16* X3B = (const bf16*)(F.ws + WS_X3B); const int gw = F.bid * 8 + F.wave, NW = F.G * 8, lane = F.lane();
    f32x4 gg[4];
#pragma unroll
    for (int j = 0; j < 4; ++j) gg[j] = ((const f32x4*)g + lane)[64 * j];
    asm volatile("s_waitcnt vmcnt(0)" ::: "memory");
    for (int m0 = gw * 4; m0 < T; m0 += NW * 4) { f32x4 v[4][4];
#pragma unroll
        for (int r = 0; r < 4; ++r)
#pragma unroll
            for (int j = 0; j < 4; ++j) { const u32x2 w = __builtin_nontemporal_load((const u32x2*)(X3B + (size_t)(m0 + r) * DM + 4 * lane + 256 * j)); v[r][j] = (f32x4){__uint_as_float(w.x << 16), __uint_as_float(w.x & 0xffff0000u), __uint_as_float(w.y << 16), __uint_as_float(w.y & 0xffff0000u)}; }
#pragma unroll
        for (int r = 0; r < 4; ++r) { float sq = 0.f; f32x4* xr = (f32x4*)(F.xo + (size_t)(m0 + r) * DM) + lane;
#pragma unroll
            for (int j = 0; j < 4; ++j) sq += (v[r][j].x * v[r][j].x + v[r][j].y * v[r][j].y) + (v[r][j].z * v[r][j].z + v[r][j].w * v[r][j].w);
            const float rstd = 1.0f / sqrtf(wave_sum(sq) * (1.0f / DM) + RMS_EPS);
#pragma unroll
            for (int j = 0; j < 4; ++j) __builtin_nontemporal_store((f32x4){v[r][j].x * rstd * gg[j].x, v[r][j].y * rstd * gg[j].y, v[r][j].z * rstd * gg[j].z, v[r][j].w * rstd * gg[j].w}, xr + 64 * j); }
    }
}


__device__ __forceinline__ void transpose_item(const float* W, int ld, int c0, int k0, bf16* dst, int ldd, LAS float* scr, int lane) {
#pragma unroll 8
    for (int i = 0; i < 32; ++i) { const int kk = 2 * i + (lane >> 5); scr[kk * 33 + (lane & 31)] = W[(size_t)(k0 + kk) * ld + c0 + (lane & 31)]; }
    asm volatile("s_waitcnt vmcnt(0) lgkmcnt(0)" ::: "memory");
    const int c = lane & 7;
#pragma unroll
    for (int j = 0; j < 4; ++j) { const int n = (lane >> 3) + 8 * j; const LAS float* s = scr + (8 * c) * 33 + n;
        u32x4 o; o.x = cvt_pk_bf16(s[0 * 33], s[1 * 33]); o.y = cvt_pk_bf16(s[2 * 33], s[3 * 33]); o.z = cvt_pk_bf16(s[4 * 33], s[5 * 33]); o.w = cvt_pk_bf16(s[6 * 33], s[7 * 33]);
        *(u32x4*)(dst + (size_t)n * ldd + k0 + 8 * c) = o; }
    asm volatile("s_waitcnt lgkmcnt(0)" ::: "memory");
}
__device__ __forceinline__ int kperm_fourier(int p) { const int g = p >> 7, q = p & 127; return g * 128 + (q <= 64 ? q : 192 - q); }
template <bool KMAP>
__device__ __forceinline__ void transpose_item_t(const float* W, int ld, int c0, int k0, bf16* dst, int ldd, LAS float* scr, int lane) {
#pragma unroll 8
    for (int i = 0; i < 32; ++i) { const int kk = 2 * i + (lane >> 5); const int ks = KMAP ? kperm_fourier(k0 + kk) : (k0 + kk); scr[kk * 33 + (lane & 31)] = W[(size_t)ks * ld + c0 + (lane & 31)]; }
    asm volatile("s_waitcnt vmcnt(0) lgkmcnt(0)" ::: "memory");
    const int c = lane & 7;
#pragma unroll
    for (int j = 0; j < 4; ++j) { const int n = (lane >> 3) + 8 * j; const LAS float* s = scr + (8 * c) * 33 + n;
        u32x4 o; o.x = cvt_pk_bf16(s[0 * 33], s[1 * 33]); o.y = cvt_pk_bf16(s[2 * 33], s[3 * 33]); o.z = cvt_pk_bf16(s[4 * 33], s[5 * 33]); o.w = cvt_pk_bf16(s[6 * 33], s[7 * 33]);
        *(u32x4*)(dst + (size_t)n * ldd + k0 + 8 * c) = o; }
    asm volatile("s_waitcnt lgkmcnt(0)" ::: "memory");
}

struct OpTcTab {
    static constexpr bool ROWFAST = false; const LAS float* ct; const LAS float* st;
    __device__ __forceinline__ bf16x8 load8(int pqc, int k0) const { float v[8];
#pragma unroll
        for (int q = 0; q < 8; ++q) { const int c = k0 + q; v[q] = pqc < 64 ? ct[(c * pqc) & 127] : (pqc == 64 ? ((c & 1) ? -1.f : 1.f) : st[(c * (pqc - 64)) & 127]); }
        return pack8((f32x4){v[0], v[1], v[2], v[3]}, (f32x4){v[4], v[5], v[6], v[7]}); }
};
struct EpiBf16Plain { bf16* O; int ld;
    __device__ __forceinline__ void tile(int row, int col, const f32x4 (&acc)[4][2]) const {
#pragma unroll
        for (int m = 0; m < 4; ++m)
#pragma unroll
            for (int n = 0; n < 2; ++n) store_bf16x4(O + (size_t)(row + 16 * m) * ld + col + 16 * n, acc[m][n]);
    }
};
__device__ __forceinline__ void ssm_tables_group(Frame& F, KArgs a, int g, int part) {
    unsigned char* ws = F.ws; const int tid = F.tid();
    LAS f32x2* LB = (LAS f32x2*)(F.lds); LAS f32x2* BBl = (LAS f32x2*)(F.lds + 33280); LAS f32x2* Cl = (LAS f32x2*)(F.lds + 41472);
    LAS bf16* KTb = (LAS bf16*)(F.lds + 49664); LAS float* K0 = (LAS float*)(F.lds + 115200);
    const float* a_re = a->in[5]; const float* a_im = a->in[6]; const float* log_dt = a->in[7]; const float* b_re = a->in[8]; const float* b_im = a->in[9];
    const float* c_re = a->in[10]; const float* c_im = a->in[11]; const float* dvec = a->in[12];
    bf16* WE = (bf16*)(ws + WS_WEND) + (size_t)g * 256 * 1024; bf16* KC = (bf16*)(ws + WS_KC) + (size_t)g * 128 * 256; bf16* CT = (bf16*)(ws + WS_CT) + (size_t)g * 1024 * 256; f32x2* L64 = (f32x2*)(ws + OFF_L64);
    for (int d = 0; d < 2; ++d) {
        const int dg = d * NG + g; const float dt = expf(log_dt[dg]);
        __syncthreads();
        for (int it = tid; it < 64 * 65; it += NTHR) { const int n = it / 65, p = it - n * 65; const float are = a_re[dg * 64 + n], aim = a_im[dg * 64 + n];
            const float mag = expf(are * dt * (float)p); const double tr = (double)aim * (double)dt * (double)p * 0.15915494309189535; const float fr_ = (float)(tr - __builtin_rint(tr));
            float s_, c_; sincospif(2.0f * fr_, &s_, &c_); const f32x2 v = (f32x2){mag * c_, mag * s_}; LB[it] = v; if (p == 64 && part == 0) L64[dg * 64 + n] = v; }
        for (int it = tid; it < 64 * 16; it += NTHR) { const int n = it >> 4; const float are = a_re[dg * 64 + n], aim = a_im[dg * 64 + n];
            const float em1 = expm1f(are * dt), th = aim * dt; float sh, ch, s_, c_; sincosf(0.5f * th, &sh, &ch); sincosf(th, &s_, &c_); (void)ch;
            const float lr = em1 * c_ - 2.0f * sh * sh, li = (1.0f + em1) * s_, den = are * are + aim * aim, qr = (lr * are + li * aim) / den, qi = (li * are - lr * aim) / den;
            const float br = b_re[(size_t)dg * 1024 + it], bi = b_im[(size_t)dg * 1024 + it]; BBl[it] = (f32x2){qr * br - qi * bi, qr * bi + qi * br};
            Cl[it] = (f32x2){c_re[(size_t)dg * 1024 + it], c_im[(size_t)dg * 1024 + it]}; }
        asm volatile("s_waitcnt vmcnt(0)" ::: "memory"); __syncthreads();
        { const int lane = F.lane(), o_a = lane & 15, nq = 4 * (lane >> 4); f32x2 creg[4][4]; bf16x8 bfr[4];
#pragma unroll
          for (int q = 0; q < 4; ++q) { float bv[8];
#pragma unroll
              for (int jj = 0; jj < 4; ++jj) { const int n = 16 * q + nq + jj; creg[q][jj] = Cl[o_a * 64 + n]; const f32x2 b = BBl[n * 16 + (lane & 15)]; bv[2 * jj] = b.x; bv[2 * jj + 1] = b.y; }
              bfr[q] = pack8((f32x4){bv[0], bv[1], bv[2], bv[3]}, (f32x4){bv[4], bv[5], bv[6], bv[7]}); }
          for (int k = F.wave; k < 64; k += 8) { f32x4 acc = (f32x4){0.f, 0.f, 0.f, 0.f};
#pragma unroll
              for (int q = 0; q < 4; ++q) { float av[8];
#pragma unroll
                  for (int jj = 0; jj < 4; ++jj) { const int n = 16 * q + nq + jj; const f32x2 l = LB[n * 65 + k], c = creg[q][jj]; av[2 * jj] = c.x * l.x - c.y * l.y; av[2 * jj + 1] = -(c.x * l.y + c.y * l.x); }
                  acc = __builtin_amdgcn_mfma_f32_16x16x32_bf16(pack8((f32x4){av[0], av[1], av[2], av[3]}, (f32x4){av[4], av[5], av[6], av[7]}), bfr[q], acc, 0, 0, 0); }
#pragma unroll
              for (int r = 0; r < 4; ++r) { const int o = (lane >> 4) * 4 + r, i = lane & 15, oi = o * 16 + i; KTb[(d * 64 + k) * 256 + oi] = (bf16)(cvt_pk_bf16(acc[r], 0.f) & 0xffffu);
                  if (k == 0) { if (d == 0) K0[oi] = acc[r] + (o == i ? dvec[g * 16 + o] : 0.f); else K0[oi] += acc[r]; } } } }
        for (int it = part * 4096 + tid; it < (part + 1) * 4096; it += NTHR) { const int kc = it & 127, rr = it >> 7, n = rr >> 1, ri = rr & 1, j = kc >> 1, i0 = (kc & 1) * 8; const f32x2 l = LB[n * 65 + (d ? j : 63 - j)]; float v[8];
#pragma unroll
            for (int q = 0; q < 8; ++q) { const f32x2 b = BBl[n * 16 + i0 + q]; v[q] = ri ? (l.x * b.y + l.y * b.x) : (l.x * b.x - l.y * b.y); }
            *(bf16x8*)(WE + ((size_t)(d * 128 + rr) * 1024 + kc * 8)) = pack8((f32x4){v[0], v[1], v[2], v[3]}, (f32x4){v[4], v[5], v[6], v[7]}); }
        for (int it = part * 4096 + tid; it < (part + 1) * 4096; it += NTHR) { const int nb = (it & 15) * 4, row = it >> 4, sI = row >> 4, o = row & 15, p = d ? 64 - sI : sI + 1; float v[8];
#pragma unroll
            for (int q = 0; q < 4; ++q) { const f32x2 c = Cl[o * 64 + nb + q], l = LB[(nb + q) * 65 + p]; v[2 * q] = c.x * l.x - c.y * l.y; v[2 * q + 1] = -(c.x * l.y + c.y * l.x); }
            *(bf16x8*)(CT + ((size_t)row * 256 + d * 128 + nb * 2)) = pack8((f32x4){v[0], v[1], v[2], v[3]}, (f32x4){v[4], v[5], v[6], v[7]}); }
    }
    __syncthreads();
    for (int it = part * 1024 + tid; it < (part + 1) * 1024; it += NTHR) { const int L = it >> 5, pc = (it & 31) * 8; bf16x8 w;
        if (L == 127) continue;
        if (L != 63) { const int d = L > 63 ? 0 : 1, lag = L > 63 ? L - 63 : 63 - L; w = *(const LAS bf16x8*)(KTb + (d * 64 + lag) * 256 + pc); }
        else { const LAS float* k0 = K0 + pc; w = pack8((f32x4){k0[0], k0[1], k0[2], k0[3]}, (f32x4){k0[4], k0[5], k0[6], k0[7]}); }
        *(bf16x8*)(KC + (size_t)L * 256 + pc) = w; }
    __syncthreads();
}

__device__ __forceinline__ void transpose_item_fp8(const float* W, const float* gs, int ld, int c0, int k0, unsigned char* dst, int ldd, float scale, LAS float* scr, int lane) {
    { const int r8 = lane >> 3, c4 = (lane & 7) * 4; f32x4 v[8];
#pragma unroll
      for (int i = 0; i < 8; ++i) v[i] = __builtin_nontemporal_load((const f32x4*)(W + (size_t)(k0 + 8 * i + r8) * ld + c0 + c4));
#pragma unroll
      for (int i = 0; i < 8; ++i) { const float gk = gs ? gs[k0 + 8 * i + r8] : 1.0f; LAS float* p = scr + (8 * i + r8) * 33 + c4; p[0] = v[i].x * gk; p[1] = v[i].y * gk; p[2] = v[i].z * gk; p[3] = v[i].w * gk; } }
    asm volatile("s_waitcnt vmcnt(0) lgkmcnt(0)" ::: "memory");
    const int c = lane & 3;
#pragma unroll
    for (int j = 0; j < 2; ++j) { const int n = (lane >> 2) + 16 * j; const LAS float* s = scr + (16 * c) * 33 + n; u32x4 o;
#pragma unroll
        for (int q = 0; q < 4; ++q) { unsigned w8 = 0u; w8 = __builtin_amdgcn_cvt_pk_fp8_f32(clamp8(s[(4 * q) * 33] * scale), clamp8(s[(4 * q + 1) * 33] * scale), w8, false); w8 = __builtin_amdgcn_cvt_pk_fp8_f32(clamp8(s[(4 * q + 2) * 33] * scale), clamp8(s[(4 * q + 3) * 33] * scale), w8, true); o[q] = w8; }
        *(u32x4*)(dst + (size_t)n * ldd + k0 + 16 * c) = o; }
    asm volatile("s_waitcnt lgkmcnt(0)" ::: "memory");
}
__device__ __forceinline__ void transpose_item_rowscale(const float* W, const float* gs, int ld, int c0, int k0, bf16* dst, int ldd, LAS float* scr, int lane) {
#pragma unroll 8
    for (int i = 0; i < 32; ++i) { const int kk = 2 * i + (lane >> 5); scr[kk * 33 + (lane & 31)] = W[(size_t)(k0 + kk) * ld + c0 + (lane & 31)] * gs[k0 + kk]; }
    asm volatile("s_waitcnt vmcnt(0) lgkmcnt(0)" ::: "memory");
    const int c = lane & 7;
#pragma unroll
    for (int j = 0; j < 4; ++j) { const int n = (lane >> 3) + 8 * j; const LAS float* s = scr + (8 * c) * 33 + n;
        u32x4 o; o.x = cvt_pk_bf16(s[0 * 33], s[1 * 33]); o.y = cvt_pk_bf16(s[2 * 33], s[3 * 33]); o.z = cvt_pk_bf16(s[4 * 33], s[5 * 33]); o.w = cvt_pk_bf16(s[6 * 33], s[7 * 33]);
        *(u32x4*)(dst + (size_t)n * ldd + k0 + 8 * c) = o; }
    asm volatile("s_waitcnt lgkmcnt(0)" ::: "memory");
}
__device__ __forceinline__ void phase0(Frame& F, KArgs a, int qword = 2048) {
    const int NBUILD = F.G >= 192 ? 4 * NG : 0; const bool builder = F.bid < NBUILD; const int rb = builder ? 0 : F.bid - NBUILD, RG = F.G - NBUILD;
    const int gt = builder ? (1 << 30) : rb * NTHR + F.tid(), NT = RG * NTHR, gw = builder ? (1 << 30) : rb * 8 + F.wave, NW = RG * 8;
    const float* x = a->in[0]; const float* g_mix = a->in[2]; const float* w_in = a->in[3];
    unsigned char* ws = F.ws;
    LAS float* ct = (LAS float*)(F.lds + 96 * 1024); LAS float* st = ct + 128;
    if (F.tid() < 128) { float s, c; sincospif((float)F.tid() / 64.0f, &s, &c); ct[F.tid()] = c; st[F.tid()] = s; }
    __syncthreads();
    if (NBUILD == 0) { for (int u = F.bid; u < 4 * NG; u += F.G) ssm_tables_group(F, a, u >> 2, u & 3); }
    if (builder) { ssm_tables_group(F, a, F.bid >> 2, F.bid & 3);
        if (F.tid() < 128) { float s, c; sincospif((float)F.tid() / 64.0f, &s, &c); ct[F.tid()] = c; st[F.tid()] = s; }
        __syncthreads(); }
    { const int nb0 = NBUILD, nbw = RG < 32 ? RG : 32;
      if (F.bid >= nb0 && F.bid < nb0 + nbw) for (int t = F.bid - nb0; t < 32; t += nbw) { const int g = t >> 3, n0 = (t & 7) * 128;
          OpTcTab A{ct, st}; OpF32Rows Bo{w_in + g * 128, DIN}; EpiBf16Plain E{(bf16*)(ws + OFF_WFT) + (size_t)g * 128 * 1024, 1024};
          gg_tile(F.lds, A, Bo, E, 0, n0, 128, F.wave); }
      __syncthreads(); }
    { bf16* D1 = (bf16*)(ws + OFF_DFT1);
      for (int it = gt; it < 256 * 128; it += NT) { const int r = it >> 7, n1 = it & 127, ri = r >> 7, k1 = r & 127; const int m = (n1 * k1) & 127;
          const float v = ri ? -st[m] : ct[m]; D1[it] = (bf16)(cvt_pk_bf16(v, 0.f) & 0xffffu); } }
    { bf16* D2 = (bf16*)(ws + OFF_DFT2);
      for (int it = gt; it < 256 * 128; it += NT) { const int k2 = it >> 7, kk = it & 127, ri = kk >> 6, n2 = kk & 63; const int m = ((n2 * k2) & 63) * 2;
          const float v = k2 < 64 ? (ri ? st[m] : ct[m]) * (1.0f / 1024.0f) : 0.f; D2[it] = (bf16)(cvt_pk_bf16(v, 0.f) & 0xffffu); } }
    { f32x2* TW = (f32x2*)(ws + OFF_TW);
      for (int it = gt; it < 8192; it += NT) { float s, c; sincospif((float)it / 4096.0f, &s, &c); TW[it] = (f32x2){c, s}; } }
    { int* SL = (int*)(ws + OFF_SLOT); for (int it = gt; it < T * NE; it += NT) SL[it] = -1; }
    { float* WG = (float*)(ws + OFF_WGT); const float* gf = a->in[15]; const float* wrt = a->in[16]; for (int it = gt; it < NE * DM; it += NT) { const int e = it >> 10, d = it & 1023; WG[it] = gf[d] * wrt[d * NE + e]; } }
    { LAS float* scr = (LAS float*)(F.lds + F.wave * 8704);
      constexpr int I_WB = (DM / 64) * (2560 / 32), I_GLU = (512 / 64) * (2048 / 32), I_WF = (512 / 64) * (DM / 32), I_SQ = (DM / 64) * (DM / 32), I_PP = (PLE / 64) * (DM / 32);
      constexpr int NITEMS = I_WB + I_GLU + I_WF + 2 * I_SQ + I_PP;
      for (int it = gw; it < NITEMS; it += NW) { int r = it;
          if (r < I_WB) { const int nb = r % 80, kb = r / 80; transpose_item(w_in, DIN, 512 + nb * 32, kb * 64, (bf16*)(ws + OFF_WB) + (size_t)nb * 32 * DM, DM, scr, F.lane()); continue; } r -= I_WB;
          if (r < I_GLU) { const int nb = r % 64, kb = r / 64;
              const int n0 = nb * 32, pn = n0 >> 8, bj = (n0 >> 7) & 1, xx = n0 & 127; transpose_item(a->in[13], 2048, bj * 1024 + pn * 128 + xx, kb * 64, (bf16*)(ws + OFF_WGLU) + (size_t)n0 * 512, 512, scr, F.lane()); continue; } r -= I_GLU;
          if (r < I_WF) { const int nb = r % 32, kb = r / 32; transpose_item_t<true>(a->in[4], DM, nb * 32, kb * 64, (bf16*)(ws + OFF_WF) + (size_t)nb * 32 * 512, 512, scr, F.lane()); continue; } r -= I_WF;
          if (r < I_SQ) { const int nb = r % 32, kb = r / 32; transpose_item(a->in[14], DM, nb * 32, kb * 64, (bf16*)(ws + OFF_WOUT) + (size_t)nb * 32 * DM, DM, scr, F.lane()); continue; } r -= I_SQ;
          if (r < I_SQ) { const int nb = r % 32, kb = r / 32; transpose_item_rowscale(a->in[21], a->in[20], DM, nb * 32, kb * 64, (bf16*)(ws + OFF_WPG) + (size_t)nb * 32 * DM, DM, scr, F.lane()); continue; } r -= I_SQ;
          { const int nb = r % 32, kb = r / 32; transpose_item(a->in[22], DM, nb * 32, kb * 64, (bf16*)(ws + OFF_WPP) + (size_t)nb * 32 * PLE, PLE, scr, F.lane()); }
      } }
    { bf16* H = (bf16*)(ws + WS_H); unsigned* q = (unsigned*)(ws + WS_CTL) + qword; const int lane = F.lane(); const float* pin = a->in[1];
      f32x4 gg[4];
#pragma unroll
      for (int j = 0; j < 4; ++j) gg[j] = ((const f32x4*)g_mix + lane)[64 * j];
      for (;;) { unsigned r0 = 0; if (lane == 0) r0 = __hip_atomic_fetch_add(q, 16u, __ATOMIC_RELAXED, __HIP_MEMORY_SCOPE_AGENT); r0 = __builtin_amdgcn_readfirstlane(r0); if (r0 >= (unsigned)T) break;
          for (int m0 = (int)r0; m0 < (int)r0 + 16; m0 += 4) { f32x4 v[4][4], pv[4];
#pragma unroll
              for (int r = 0; r < 4; ++r) {
#pragma unroll
                  for (int j = 0; j < 4; ++j) v[r][j] = __builtin_nontemporal_load((const f32x4*)(x + (size_t)(m0 + r) * DM) + lane + 64 * j);
                  pv[r] = __builtin_nontemporal_load((const f32x4*)(pin + (size_t)(m0 + r) * PLE) + lane); }
#pragma unroll
              for (int r = 0; r < 4; ++r) { float sq = 0.f;
#pragma unroll
                  for (int j = 0; j < 4; ++j) sq += (v[r][j].x * v[r][j].x + v[r][j].y * v[r][j].y) + (v[r][j].z * v[r][j].z + v[r][j].w * v[r][j].w);
                  const float rstd = 1.0f / sqrtf(wave_sum(sq) * (1.0f / DM) + RMS_EPS);
#pragma unroll
                  for (int j = 0; j < 4; ++j) store_bf16x4(H + (size_t)(m0 + r) * DM + 4 * lane + 256 * j, (f32x4){v[r][j].x * rstd * gg[j].x, v[r][j].y * rstd * gg[j].y, v[r][j].z * rstd * gg[j].z, v[r][j].w * rstd * gg[j].w});
                  store_bf16x4((bf16*)(ws + WS_PB) + (size_t)(m0 + r) * PLE + 4 * lane, pv[r]); } } } }
}

__device__ __forceinline__ void phase_gemm1(Frame& F, KArgs a) {
    unsigned char* ws = F.ws; const bf16* H = (const bf16*)(ws + WS_H);
    { pg8::PolG1a P{(const bf16*)(ws + OFF_WFT), H, DM}; pg8::StaticOrder S; S.init(512, T, F.G, F.bid); pg8::EpiXt E{(bf16*)(ws + WS_XT)};
      pg8::gemm_phase(F.lds, P, S, E, F.wave); }
    { pg8::PolPlain P{H, (const bf16*)(ws + OFF_WB), DM, DM, DM}; pg8::StaticOrder S; S.init(T, 2560, F.G, F.bid); pg8::EpiG1b E{(bf16*)(ws + WS_ACAT), ws + WS_GF, ws + WS_GS};
      pg8::gemm_phase(F.lds, P, S, E, F.wave); }
}
__device__ __forceinline__ void phase_stageA(Frame& F, KArgs a) {
    unsigned char* ws = F.ws;
    { pg8::PolPlain P{(const bf16*)(ws + OFF_DFT1), (const bf16*)(ws + WS_XT), 128, 128, 128}; pg8::LinearOrder S; S.init(1, 131072 / 256, F.G, F.bid); pg8::EpiStageA E{(bf16*)(ws + WS_Y), (const f32x2*)(ws + OFF_TW)};
      pg8::gemm_phase(F.lds, P, S, E, F.wave); }
    { const int ntm = 4, ntn = 2;
      for (int t = F.bid; t < NG * ntm * ntn; t += F.G) { int g = t / (ntm * ntn), tt = t % (ntm * ntn);
          if (F.G == 256) { g = (t & 7) * 4 + (t >> 6); tt = (t >> 3) & 7; }
          OpBf16Rows A{(const bf16*)(ws + WS_ACAT) + (size_t)g * NROWC * KCAT, KCAT}; OpBf16Rows Bo{(const bf16*)(ws + WS_WEND) + (size_t)g * 256 * 1024, 1024};
          EpiF32Plain E{(float*)(ws + WS_EE) + (size_t)g * NROWC * 256, 256};
          gg_tile(F.lds, A, Bo, E, (tt % ntm) * 128, (tt / ntm) * 128, 1024, F.wave); } }
}
__device__ __forceinline__ void phase_stageC(Frame& F, KArgs a) {
    unsigned char* ws = F.ws;
    { pg8::PolStageC P{(const bf16*)(ws + OFF_DFT2), (const bf16*)(ws + WS_Y), 128}; pg8::LinearOrder S; S.init(1, 1024, F.G, F.bid); pg8::EpiStageC E{(bf16*)(ws + WS_FMIX)};
      pg8::gemm_phase(F.lds, P, S, E, F.wave); }
    { const float* EE = (const float*)(ws + WS_EE); bf16* ACAT = (bf16*)(ws + WS_ACAT); const f32x2* L64 = (const f32x2*)(ws + OFF_L64);
      if (F.G == 256) {
          const int b = F.bid >> 6, g = (F.bid >> 1) & 31, d = F.bid & 1, tid = F.tid(), lane = F.lane(); f32x4 v[8];
          __syncthreads();
#pragma unroll
          for (int k = 0; k < 8; ++k) { const int p = tid + NTHR * k, c = p >> 5, j = p & 31; v[k] = *(const f32x4*)(EE + ((size_t)g * NROWC + b * NCH + c) * 256 + d * 128 + j * 4); }
          asm volatile("s_waitcnt vmcnt(0)" ::: "memory");
#pragma unroll
          for (int k = 0; k < 8; ++k) *(LAS f32x4*)(F.lds + (size_t)(tid + NTHR * k) * 16) = v[k];
          __syncthreads();
          if (F.wave == 0) { const LAS f32x2* es = (const LAS f32x2*)F.lds; const f32x2 l64 = L64[(d * NG + g) * 64 + lane]; float cr = 0.f, ci = 0.f;
              for (int s0 = 0; s0 < NCH; s0 += 16) { f32x2 e[16];
#pragma unroll
                  for (int q = 0; q < 16; ++q) { const int c = d ? (NCH - 1 - s0 - q) : (s0 + q); e[q] = es[c * 64 + lane]; }
#pragma unroll
                  for (int q = 0; q < 16; ++q) { const int c = d ? (NCH - 1 - s0 - q) : (s0 + q); const size_t row = (size_t)g * NROWC + b * NCH + c;
                      *(unsigned*)(ACAT + row * KCAT + 1024 + d * 128 + lane * 2) = cvt_pk_bf16(cr, ci);
                      const float nr = l64.x * cr - l64.y * ci + e[q].x, ni = l64.x * ci + l64.y * cr + e[q].y; cr = nr; ci = ni; } } }
          __syncthreads();
      } else {
      const int gt = F.bid * NTHR + F.tid(), NT = F.G * NTHR;
      for (int it = gt; it < NB * NG * 2 * NS; it += NT) { const int n = it & 63, d = (it >> 6) & 1, g = (it >> 7) & 31, b = it >> 12;
          const f32x2 l64 = L64[(d * NG + g) * 64 + n]; float cr = 0.f, ci = 0.f;
          for (int s0 = 0; s0 < NCH; s0 += 16) { f32x2 e[16];
#pragma unroll
              for (int q = 0; q < 16; ++q) { const int c = d ? (NCH - 1 - s0 - q) : (s0 + q); e[q] = *(const f32x2*)(EE + ((size_t)g * NROWC + b * NCH + c) * 256 + d * 128 + n * 2); }
              asm volatile("s_waitcnt vmcnt(0)" ::: "memory");
#pragma unroll
              for (int q = 0; q < 16; ++q) { const int c = d ? (NCH - 1 - s0 - q) : (s0 + q); const size_t row = (size_t)g * NROWC + b * NCH + c;
                  *(unsigned*)(ACAT + row * KCAT + 1024 + d * 128 + n * 2) = cvt_pk_bf16(cr, ci);
                  const float nr = l64.x * cr - l64.y * ci + e[q].x, ni = l64.x * ci + l64.y * cr + e[q].y; cr = nr; ci = ni; } } } } }
}
__device__ __forceinline__ void phase_passB(Frame& F, KArgs a) {
    unsigned char* ws = F.ws;
    { pg8::PolPassB2 P{(const bf16*)(ws + WS_ACAT), (const bf16*)(ws + WS_KC), (const bf16*)(ws + WS_CT), KCAT}; pg8::LinearOrder S; S.init(NG * 2, 4, F.G, F.bid); pg8::EpiPassB E{(bf16*)(ws + WS_YS)};
      pg8::gemm_phase(F.lds, P, S, E, F.wave); }
    { pg8::PolPlain P{(const bf16*)(ws + WS_FMIX), (const bf16*)(ws + OFF_WF), 512, 512, 512}; pg8::StaticOrder S; S.init(T, DM, F.G, F.bid); pg8::EpiMulGate E{(bf16*)(ws + WS_MIXF), ws + WS_GF};
      pg8::gemm_phase(F.lds, P, S, E, F.wave); }
}
__device__ __forceinline__ void phase_glu(Frame& F, KArgs a) {
    unsigned char* ws = F.ws;
    pg8::PolPlain P{(const bf16*)(ws + WS_YS), (const bf16*)(ws + OFF_WGLU), 512, 512, 512}; pg8::StaticOrder S; S.init(T, 2048, F.G, F.bid); pg8::EpiGlu E{(bf16*)(ws + WS_MIX), ws + WS_GS};
    pg8::gemm_phase(F.lds, P, S, E, F.wave);
}
__device__ __forceinline__ void phase_wout(Frame& F, KArgs a) {
    unsigned char* ws = F.ws;
    pg8::PolPlain P{(const bf16*)(ws + WS_MIX), (const bf16*)(ws + OFF_WOUT), DM, DM, DM}; pg8::StaticOrder S; S.init(T, DM, F.G, F.bid); pg8::EpiResidual E{F.xo, a->in[0]};
    pg8::gemm_phase(F.lds, P, S, E, F.wave);
}
__device__ __forceinline__ void phase_expert_weights(Frame& F, KArgs a) {
    unsigned char* ws = F.ws; LAS float* scr = (LAS float*)(F.lds + 40 * 1024 + F.wave * 8704); const int gw = F.bid * 8 + F.wave, NW = F.G * 8;
    constexpr int I_GU = NE * 2 * (DM / 64) * (DE / 32), I_D = NE * (DE / 64) * (DM / 32);
    for (int it = gw; it < I_GU + I_D; it += NW) {
        if (it < I_GU) { const int nb = it % 88, kb = (it / 88) % 16, bj = (it / (88 * 16)) & 1, e = it / (88 * 16 * 2);
            const int f0 = nb * 32, tq = f0 >> 7, xx = f0 & 127; const float* W = (bj ? a->in[18] : a->in[17]) + (size_t)e * DM * DE;
            transpose_item_fp8(W, a->in[15], DE, f0, kb * 64, ws + WS_WGU + ((size_t)e * (2 * DE) + tq * 256 + bj * 128 + xx) * DM, DM, 64.0f, scr, F.lane()); }
        else { const int r = it - I_GU, nb = r % 32, kb = (r / 32) % 44, e = r / (32 * 44);
            transpose_item_fp8(a->in[19] + (size_t)e * DE * DM, nullptr, DM, nb * 32, kb * 64, ws + WS_WD + ((size_t)e * DM + nb * 32) * DE, DE, 64.0f, scr, F.lane()); }
    }
}
__device__ __forceinline__ void phase_eproj(Frame& F, KArgs a, int G2, int c2) {
    unsigned char* ws = F.ws; (void)a;
    pg8::PolPlain P{(const bf16*)(ws + WS_PB), (const bf16*)(ws + OFF_WPP), PLE, PLE, PLE}; pg8::StaticOrder S; S.init(T, DM, G2, c2); pg8::EpiBf16 E{(bf16*)(ws + WS_EB), DM};
    pg8::gemm_phase(F.lds, P, S, E, F.wave);
}
__device__ __forceinline__ void phase_exp_up(Frame& F, KArgs a) {
    unsigned char* ws = F.ws;
    pg8::PolExpUp8 P{ws + WS_H, (const int*)(ws + OFF_IDX), ws + WS_WGU, DM / 2}; pg8::ExpertOrder S; S.init(2 * DE / 256, F.G, F.bid); pg8::EpiSwiglu E{ws + WS_HID, (const float*)(ws + OFF_RSS), 1.0f / 64.0f, 8.0f};
    pg8::gemm_phase(F.lds, P, S, E, F.wave);
}
__device__ __forceinline__ void phase_exp_down(Frame& F, KArgs a) {
    unsigned char* ws = F.ws;

    pg8::PolExpDown8 P{ws + WS_HID, ws + WS_WD, DE / 2}; pg8::ExpertOrder S; S.init(DM / 256, F.G, F.bid); pg8::EpiScaleRows E{(bf16*)(ws + WS_YB), (const float*)(ws + OFF_VAL), 1.0f / 512.0f};
    pg8::gemm_phase(F.lds, P, S, E, F.wave);
}
__device__ __forceinline__ void phase_combine(Frame& F, KArgs a) {
    unsigned char* ws = F.ws; float* RST = (float*)(ws + OFF_RST); bf16* X2B = (bf16*)(ws + WS_X2B); const bf16* YB = (const bf16*)(ws + WS_YB); const int* SLOT = (const int*)(ws + OFF_SLOT);
    const int gw = F.bid * 8 + F.wave, NW = F.G * 8, lane = F.lane();
    for (int m0 = gw * 4; m0 < T; m0 += NW * 4) {
        const int myslot = SLOT[(size_t)(lane & 15) * T + m0 + (lane >> 4)];
        f32x4 v[4][4];
#pragma unroll
        for (int r = 0; r < 4; ++r)
#pragma unroll
            for (int j = 0; j < 4; ++j) v[r][j] = __builtin_nontemporal_load((const f32x4*)(F.xo + (size_t)(m0 + r) * DM) + lane + 64 * j);
        asm volatile("s_waitcnt vmcnt(0)" ::: "memory");
        unsigned long long mk = __ballot(myslot >= 0); unsigned msk[4];
#pragma unroll
        for (int r = 0; r < 4; ++r) msk[r] = (unsigned)(mk >> (16 * r)) & 0xffffu;
        while ((msk[0] | msk[1] | msk[2] | msk[3]) != 0u) { u32x2 y[4][4]; bool act[4];
#pragma unroll
            for (int r = 0; r < 4; ++r) { act[r] = msk[r] != 0u; if (act[r]) { const int e = __builtin_ctz(msk[r]); msk[r] &= msk[r] - 1u; const int sl = __shfl(myslot, 16 * r + e);
                    const bf16* yr = YB + ((size_t)e * 4096 + sl) * DM + 4 * lane;
#pragma unroll
                    for (int j = 0; j < 4; ++j) y[r][j] = __builtin_nontemporal_load((const u32x2*)(yr + 256 * j)); } }
            asm volatile("s_waitcnt vmcnt(0)" ::: "memory");
#pragma unroll
            for (int r = 0; r < 4; ++r) if (act[r]) {
#pragma unroll
                for (int j = 0; j < 4; ++j) { const u32x2 w = y[r][j]; v[r][j] += (f32x4){__uint_as_float(w.x << 16), __uint_as_float(w.x & 0xffff0000u), __uint_as_float(w.y << 16), __uint_as_float(w.y & 0xffff0000u)}; } }
        }
#pragma unroll
        for (int r = 0; r < 4; ++r) { float sq = 0.f;
#pragma unroll
            for (int j = 0; j < 4; ++j) { store_bf16x4(X2B + (size_t)(m0 + r) * DM + 4 * lane + 256 * j, v[r][j]); sq += (v[r][j].x * v[r][j].x + v[r][j].y * v[r][j].y) + (v[r][j].z * v[r][j].z + v[r][j].w * v[r][j].w); }
            const float rstd = 1.0f / sqrtf(wave_sum(sq) * (1.0f / DM) + RMS_EPS);
            if (lane == 0) RST[m0 + r] = rstd; }
    }
}
__device__ __forceinline__ void phase_ple(Frame& F, KArgs a) {
    unsigned char* ws = F.ws;
    pg8::PolPlain P{(const bf16*)(ws + WS_X2B), (const bf16*)(ws + OFF_WPG), DM, DM, DM}; pg8::StaticOrder S; S.init(T, DM, F.G, F.bid); pg8::EpiPle E{(const bf16*)(ws + WS_X2B), (bf16*)(ws + WS_X3B), (const bf16*)(ws + WS_EB), (const float*)(ws + OFF_RST)};
    pg8::gemm_phase(F.lds, P, S, E, F.wave);
}

constexpr int LDS_BYTES = 147456;
constexpr int LDS_MISC = 140 * 1024;
__global__ void __launch_bounds__(NTHR, 2) mk_fwd(Args args) {
    extern __shared__ __attribute__((aligned(16))) unsigned char lds_raw[];
    Frame F; F.lds = (LAS unsigned char*)lds_raw; F.wave = __builtin_amdgcn_readfirstlane((int)threadIdx.x >> 6); F.G = gridDim.x; F.bid = blockIdx.x;
    const KArgs kp = (KArgs)__builtin_amdgcn_kernarg_segment_ptr();
    F.ws = args.ws; F.xo = args.out;
    volatile LAS unsigned* MISC = (volatile LAS unsigned*)(F.lds + LDS_MISC);
    { const int t0 = F.tid(); if (t0 < 64) MISC[t0] = 0u; }
    __syncthreads();
    XcdBarrier bar; bar.bar = (unsigned*)(args.ws + WS_CTL) + 4096; bar.x = 0; bar.st = nullptr; bar.wave = F.wave;
    if (MK_N_LAUNCHES == 1) bar = xcd_barrier_post((unsigned*)(args.ws + WS_CTL) + 4096, MISC + 8, F.wave);
    const int lo = args.ph_lo, hi = args.ph_hi;
#define IN(k) (lo <= (k) && (k) < hi)
    auto kpl = [&]() -> KArgs { KArgs p = kp; asm volatile("" : "+s"(p)); return p; };
#define SEAM(k) do { if (lo <= (k) && (k) + 1 < hi) xcd_barrier(bar); } while (0)
    if (IN(0))  { phase0(F, kpl());
    }         SEAM(0);
    if (IN(2))  { phase_gemm1(F, kpl()); }    SEAM(2);
    if (IN(3))  { phase_stageA(F, kpl()); }   SEAM(3);
    if (IN(4))  { phase_stageC(F, kpl()); }   SEAM(4);
    if (IN(5))  { phase_passB(F, kpl()); }    SEAM(5);
    if (IN(6))  { phase_glu(F, kpl()); }      SEAM(6);
    if (IN(7))  { phase_wout(F, kpl()); }     SEAM(7);
    if (IN(8))  { phase_router(F, kpl()); }   SEAM(8);
    if (IN(9))  { if (F.G == 256) { if (F.bid < NB * NE) phase_topk(F, kpl()); else phase_eproj(F, kpl(), 192, F.bid - NB * NE); } else { phase_topk(F, kpl()); __syncthreads(); phase_eproj(F, kpl(), F.G, F.bid); }
                  __syncthreads(); phase_expert_weights(F, kpl()); } SEAM(9);
    if (IN(10)) { phase_exp_up(F, kpl()); }   SEAM(10);
    if (IN(11)) { phase_exp_down(F, kpl()); } SEAM(11);
    if (IN(12)) { phase_combine(F, kpl()); }  SEAM(12);
    if (IN(13)) { phase_ple(F, kpl()); }      SEAM(13);
    if (IN(14)) { phase_final(F, kpl()); }
#undef IN
#undef SEAM
}

extern "C" void kernel_launch(void* const* d_in, const int* in_sizes, int n_in, void* d_out, int out_size, void* d_ws, size_t ws_size, hipStream_t stream) {
    static int grid = 0;
    if (grid == 0) {
        if (n_in != 24 || out_size != T * DM || ws_size < WS_END) { fprintf(stderr, "kernel_launch: unexpected shapes (n_in %d out %d ws %zu need %zu)\n", n_in, out_size, ws_size, (size_t)WS_END); grid = -1; return; }
        int dev = 0, cus = 0, per_cu = 0;
        if (hipGetDevice(&dev) != hipSuccess || hipDeviceGetAttribute(&cus, hipDeviceAttributeMultiprocessorCount, dev) != hipSuccess) { grid = -1; return; }
        if (hipFuncSetAttribute((const void*)mk_fwd, hipFuncAttributeMaxDynamicSharedMemorySize, LDS_BYTES) != hipSuccess) { fprintf(stderr, "kernel_launch: hipFuncSetAttribute failed\n"); grid = -1; return; }
        if (hipOccupancyMaxActiveBlocksPerMultiprocessor(&per_cu, (const void*)mk_fwd, NTHR, LDS_BYTES) != hipSuccess || per_cu < 1) { fprintf(stderr, "kernel_launch: occupancy query says %d\n", per_cu); (void)hipGetLastError(); grid = -1; return; }
        grid = cus;
    }
    if (grid < 0) return;
    (void)hipMemsetAsync((char*)d_ws + WS_CTL, 0, CTL_BYTES, stream);
    Args a{};
    for (int i = 0; i < 24; ++i) a.in[i] = (const float*)d_in[i];
    a.out = (float*)d_out; a.ws = (unsigned char*)d_ws;
    if (MK_N_LAUNCHES == 1) { a.ph_lo = 0; a.ph_hi = NPH; hipLaunchKernelGGL(mk_fwd, dim3(grid), dim3(NTHR), LDS_BYTES, stream, a); }
    else for (int p = 0; p < NPH; ++p) { a.ph_lo = p; a.ph_hi = p + 1; hipLaunchKernelGGL(mk_fwd, dim3(grid), dim3(NTHR), LDS_BYTES, stream, a); }
}
```

```cpp
#include <hip/hip_runtime.h>
#include <cstdint>
#include <cstdio>

#ifndef MK_N_LAUNCHES
#define MK_N_LAUNCHES 1
#endif

#define LAS __attribute__((address_space(3)))
#define GAS __attribute__((address_space(1)))
typedef unsigned short bf16;
typedef short bf16x8 __attribute__((ext_vector_type(8)));
typedef float f32x4 __attribute__((ext_vector_type(4)));
typedef float f32x2 __attribute__((ext_vector_type(2)));
typedef unsigned u32x2 __attribute__((ext_vector_type(2)));
typedef unsigned u32x4 __attribute__((ext_vector_type(4)));
typedef GAS unsigned gu32;

constexpr int NB = 4, SEQ = 8192, T = NB * SEQ, DM = 1024, DIN = 3072, NE = 16, DE = 2816, CAP = 1024, PLE = 256;
constexpr int NG = 32, NS = 64, LCH = 64, NCH = SEQ / LCH, NROWC = NB * NCH, KCAT = 1280;
constexpr float RMS_EPS = 1e-6f;
constexpr int NPH = 15;
constexpr int NTHR = 512;

constexpr size_t MiB = 1u << 20;
constexpr size_t WS_CTL = 0, CTL_BYTES = 1 * MiB;
constexpr size_t OFF_WFT = 1 * MiB;
constexpr size_t OFF_DFT1 = OFF_WFT + 1 * MiB;
constexpr size_t OFF_DFT2 = OFF_DFT1 + 64 * 1024;
constexpr size_t OFF_TW = OFF_DFT2 + 64 * 1024;
constexpr size_t OFF_L64 = OFF_TW + 64 * 1024;
constexpr size_t OFF_WGT = OFF_L64 + 64 * 1024;
constexpr size_t OFF_AFF = OFF_WGT + 64 * 1024;
constexpr size_t OFF_IDX = OFF_AFF + 2 * MiB;
constexpr size_t OFF_VAL = OFF_IDX + 256 * 1024;
constexpr size_t OFF_SLOT = OFF_VAL + 256 * 1024;
constexpr size_t OFF_RST = OFF_SLOT + 2 * MiB;
constexpr size_t OFF_RSD = OFF_RST + 128 * 1024;
constexpr size_t OFF_RSS = OFF_RSD + 128 * 1024;
static_assert(OFF_RSS + 256 * 1024 <= 16 * MiB, "small region");
constexpr size_t OFF_WB = 16 * MiB;
constexpr size_t OFF_WGLU = OFF_WB + 5 * MiB;
constexpr size_t OFF_WF = OFF_WGLU + 2 * MiB;
constexpr size_t OFF_WOUT = OFF_WF + 1 * MiB;
constexpr size_t OFF_WPG = OFF_WOUT + 2 * MiB;
constexpr size_t OFF_WPP = OFF_WPG + 2 * MiB;
constexpr size_t WS_H = 32 * MiB;
constexpr size_t WS_R = 96 * MiB;
constexpr size_t WS_GF = WS_R, WS_GS = WS_R + 32 * MiB;
constexpr size_t WS_MIXF = WS_R + 64 * MiB, WS_MIX = WS_MIXF;
constexpr size_t WS_XT = WS_R + 128 * MiB, WS_Y = WS_R + 160 * MiB, WS_FMIX = WS_R + 224 * MiB,
                 WS_ACAT = WS_R + 256 * MiB, WS_YS = WS_R + 296 * MiB, WS_EE = WS_R + 328 * MiB;
constexpr size_t WS_KC = WS_R + 352 * MiB;
constexpr size_t WS_CT = WS_R + 356 * MiB;
constexpr size_t WS_WEND = WS_R + 432 * MiB;
constexpr size_t WS_HID = WS_R;
constexpr size_t WS_WGU = WS_R + 352 * MiB;
constexpr size_t WS_WD = WS_R + 528 * MiB;
constexpr size_t WS_YB = WS_WGU;
constexpr size_t WS_PB = WS_R + 496 * MiB;
constexpr size_t WS_X2B = WS_R + 64 * MiB;
constexpr size_t WS_X2F = WS_R + 256 * MiB;
constexpr size_t WS_X3B = WS_R + 128 * MiB;
constexpr size_t WS_EB = WS_R + 192 * MiB;
constexpr size_t WS_END = WS_R + 616 * MiB;
static_assert(OFF_SLOT + 2 * MiB <= OFF_WB && OFF_WPP + 1 * MiB <= WS_H && WS_EE + 16 * MiB <= WS_WGU && WS_PB >= WS_YB + 128 * MiB && WS_PB + 16 * MiB <= WS_WD && WS_EB >= WS_HID + 176 * MiB && WS_EB + 64 * MiB <= WS_WGU, "ws map");

typedef __bf16 bf16v2_t __attribute__((ext_vector_type(2)));
__device__ __forceinline__ unsigned cvt_pk_bf16(float lo, float hi) { const bf16v2_t v = __builtin_convertvector((f32x2){lo, hi}, bf16v2_t); return __builtin_bit_cast(unsigned, v); }
__device__ __forceinline__ float clamp8(float v) { return fminf(fmaxf(v, -440.0f), 440.0f); }
__device__ __forceinline__ float bf2f(unsigned short h) { return __uint_as_float(((unsigned)h) << 16); }
__device__ __forceinline__ float sigmoidf_(float x) { return __builtin_amdgcn_rcpf(1.0f + __expf(-x)); }
__device__ __forceinline__ float gelu_tanh(float x) { const float u = 0.7978845608028654f * (x + 0.044715f * x * x * x); return x * __builtin_amdgcn_rcpf(1.0f + __expf(-2.0f * u)); }
__device__ __forceinline__ float wave_sum(float v) {
#pragma unroll
    for (int o = 1; o < 64; o <<= 1) v += __shfl_xor(v, o);
    return v;
}
__device__ __forceinline__ bf16x8 pack8(const f32x4 a, const f32x4 b) {
    u32x4 w; w.x = cvt_pk_bf16(a.x, a.y); w.y = cvt_pk_bf16(a.z, a.w); w.z = cvt_pk_bf16(b.x, b.y); w.w = cvt_pk_bf16(b.z, b.w);
    return __builtin_bit_cast(bf16x8, w);
}
__device__ __forceinline__ void store_bf16x4(bf16* p, const f32x4 v) { u32x2 w; w.x = cvt_pk_bf16(v.x, v.y); w.y = cvt_pk_bf16(v.z, v.w); *(u32x2*)p = w; }
__device__ __forceinline__ f32x4 load_bf16x4(const bf16* p) { const u32x2 w = *(const u32x2*)p; f32x4 r; r.x = __uint_as_float(w.x << 16); r.y = __uint_as_float(w.x & 0xffff0000u); r.z = __uint_as_float(w.y << 16); r.w = __uint_as_float(w.y & 0xffff0000u); return r; }

__device__ __forceinline__ int lane_id_here() { unsigned z = 0u; asm volatile("" : "+v"(z)); return (int)__builtin_amdgcn_mbcnt_hi(~0u, __builtin_amdgcn_mbcnt_lo(~0u, z)); }
#define XB_TMO      128
#define XB_XCNT(j)  (256  + 64 * (j))
#define XB_XSUB(j)  (1280 + 64 * (j))
#define XB_XGEN(j)  (2304 + 64 * (j))
#define XB_TOP      3328
#define XB_TOPGEN   3392
#define XCD_BAR_WORDS 3456
#define XB_SPIN_CAP (1u << 22)
__device__ __forceinline__ unsigned xb_ld(unsigned* p)              { return __hip_atomic_load(p, __ATOMIC_RELAXED, __HIP_MEMORY_SCOPE_AGENT); }
__device__ __forceinline__ unsigned xb_add(unsigned* p, unsigned v) { return __hip_atomic_fetch_add(p, v, __ATOMIC_RELAXED, __HIP_MEMORY_SCOPE_AGENT); }
__device__ __forceinline__ unsigned xb_xcc_id() { return (unsigned)__builtin_amdgcn_s_getreg((3 << 11) | 20) & 0xFu; }
#define XB_SPIN(cond, bar) do { unsigned _sp = 0; while (cond) { __builtin_amdgcn_s_sleep(1); \
    if ((++_sp & 255u) == 0u) { if (xb_ld(&(bar)[XB_TMO])) break; if (_sp > XB_SPIN_CAP) { atomicAdd(&(bar)[XB_TMO], 1u); break; } } } } while (0)
struct XcdBarrier { unsigned* bar; unsigned x; volatile LAS unsigned* st; int wave; };
__device__ __forceinline__ XcdBarrier xcd_barrier_post(unsigned* bar, volatile LAS unsigned* st, int wave) {
    XcdBarrier b; b.bar = bar; b.x = xb_xcc_id(); b.st = st; b.wave = wave;
    if (wave == 0 && lane_id_here() == 0) (void)xb_add(&bar[XB_XCNT(b.x)], 1u);
    return b;
}
__device__ __forceinline__ void xcd_barrier_complete(unsigned* bar, unsigned x, unsigned& nloc, unsigned& nx) {
    const unsigned G = gridDim.x * gridDim.y * gridDim.z;
    unsigned sum, cnt, mine, sp = 0u;
    for (;;) {
        sum = 0u; cnt = 0u; mine = 0u;
#pragma unroll
        for (unsigned j = 0; j < 16; ++j) { const unsigned c = xb_ld(&bar[XB_XCNT(j)]); sum += c; cnt += (c > 0u) ? 1u : 0u; mine = (j == x) ? c : mine; }
        if (sum == G) break;
        __builtin_amdgcn_s_sleep(1);
        if ((++sp & 255u) == 0u) { if (xb_ld(&bar[XB_TMO])) break; if (sp > XB_SPIN_CAP) { atomicAdd(&bar[XB_TMO], 1u); break; } }
    }
    nloc = mine > 0u ? mine : 1u; nx = cnt > 0u ? cnt : 1u;
}
__device__ __forceinline__ void xcd_barrier(const XcdBarrier& b) {
    asm volatile("s_waitcnt vmcnt(0)" ::: "memory");
    __syncthreads();
    if (b.wave == 0 && lane_id_here() == 0) {
        unsigned* bar = b.bar;
        __builtin_amdgcn_s_waitcnt(0);
        unsigned nloc = b.st[0], nx = b.st[1];
        if (nloc == 0u) { xcd_barrier_complete(bar, b.x, nloc, nx); b.st[0] = nloc; b.st[1] = nx; }
        const unsigned old = xb_add(&bar[XB_XSUB(b.x)], 1u);
        const unsigned gen = old / nloc;
        if (old + 1u == (gen + 1u) * nloc) {
            __builtin_amdgcn_fence(__ATOMIC_RELEASE, "agent");
            asm volatile("s_waitcnt vmcnt(0)" ::: "memory");
            const unsigned og = xb_add(&bar[XB_TOP], 1u);
            const unsigned tg = og / nx;
            if (og + 1u == (tg + 1u) * nx) xb_add(&bar[XB_TOPGEN], 1u);
            else XB_SPIN(xb_ld(&bar[XB_TOPGEN]) == tg, bar);
            __builtin_amdgcn_fence(__ATOMIC_ACQUIRE, "agent");
            xb_add(&bar[XB_XGEN(b.x)], 1u);
            asm volatile("s_waitcnt vmcnt(0)" ::: "memory");
        } else {
            XB_SPIN(xb_ld(&bar[XB_XGEN(b.x)]) == gen, bar);
            __builtin_amdgcn_fence(__ATOMIC_ACQUIRE, "agent");
            asm volatile("s_waitcnt vmcnt(0)" ::: "memory");
        }
    }
    __syncthreads();
}

constexpr int GG_LDS_ROW = 80;
constexpr int GG_LDS_B = 128 * GG_LDS_ROW;
template <class AF, class BF, class EF>
__device__ __forceinline__ void gg_tile(LAS unsigned char* lds, const AF& af, const BF& bfn, const EF& ef, int m0, int n0, int K, int wid) {
    const int lane = lane_id_here(), tid = wid * 64 + lane, wr = wid >> 2, wc = wid & 3, fr = lane & 15, fq = lane >> 4;
    const int a_row = AF::ROWFAST ? (tid & 127) : (tid >> 2), a_kc = AF::ROWFAST ? (tid >> 7) : (tid & 3);
    const int b_row = BF::ROWFAST ? (tid & 127) : (tid >> 2), b_kc = BF::ROWFAST ? (tid >> 7) : (tid & 3);
    f32x4 acc[4][2];
#pragma unroll
    for (int m = 0; m < 4; ++m)
#pragma unroll
        for (int n = 0; n < 2; ++n) acc[m][n] = (f32x4){0.f, 0.f, 0.f, 0.f};
    constexpr int GG_BUF = 2 * 128 * GG_LDS_ROW;
    bf16x8 av[4], bv[4];
#pragma unroll
    for (int d = 0; d < 4; ++d) { av[d] = af.load8(m0 + a_row, 32 * d + a_kc * 8); bv[d] = bfn.load8(n0 + b_row, 32 * d + b_kc * 8); }
    __syncthreads();
    *(LAS bf16x8*)(lds + a_row * GG_LDS_ROW + a_kc * 16) = av[0];
    *(LAS bf16x8*)(lds + GG_LDS_B + b_row * GG_LDS_ROW + b_kc * 16) = bv[0];
    for (int k0 = 0; k0 < K; k0 += 128) {
#pragma unroll
        for (int d = 0; d < 4; ++d) { LAS unsigned char* cur = lds + (d & 1) * GG_BUF; LAS unsigned char* oth = lds + ((d + 1) & 1) * GG_BUF;
            __syncthreads();
            bf16x8 Af[4], Bf[2];
#pragma unroll
            for (int m = 0; m < 4; ++m) Af[m] = *(const LAS bf16x8*)(cur + (wr * 64 + m * 16 + fr) * GG_LDS_ROW + fq * 16);
#pragma unroll
            for (int n = 0; n < 2; ++n) Bf[n] = *(const LAS bf16x8*)(cur + GG_LDS_B + (wc * 32 + n * 16 + fr) * GG_LDS_ROW + fq * 16);
            if (k0 + 128 < K) { av[d] = af.load8(m0 + a_row, k0 + 128 + 32 * d + a_kc * 8); bv[d] = bfn.load8(n0 + b_row, k0 + 128 + 32 * d + b_kc * 8); }
            if (d < 3 || k0 + 128 < K) { *(LAS bf16x8*)(oth + a_row * GG_LDS_ROW + a_kc * 16) = av[(d + 1) & 3]; *(LAS bf16x8*)(oth + GG_LDS_B + b_row * GG_LDS_ROW + b_kc * 16) = bv[(d + 1) & 3]; }
#pragma unroll
            for (int m = 0; m < 4; ++m)
#pragma unroll
                for (int n = 0; n < 2; ++n) acc[m][n] = __builtin_amdgcn_mfma_f32_16x16x32_bf16(Bf[n], Af[m], acc[m][n], 0, 0, 0);
        }
    }
    __syncthreads();
    ef.tile(m0 + wr * 64 + fr, n0 + wc * 32 + fq * 4, acc);
}

struct OpTrivA { static constexpr bool ROWFAST = false;
    __device__ __forceinline__ bf16x8 load8(int row, int k0) const { float v[8];
#pragma unroll
        for (int q = 0; q < 8; ++q) v[q] = (float)(((row * 5 + k0 + q) & 15) - 8);
        return pack8((f32x4){v[0], v[1], v[2], v[3]}, (f32x4){v[4], v[5], v[6], v[7]}); } };
struct OpBf16Rows {
    static constexpr bool ROWFAST = false; const bf16* p; int ld;
    __device__ __forceinline__ bf16x8 load8(int row, int k0) const { return *(const bf16x8*)(p + (size_t)row * ld + k0); }
};
struct OpF32Rows {
    static constexpr bool ROWFAST = false; const float* p; int ld;
    __device__ __forceinline__ bf16x8 load8(int row, int k0) const { const f32x4* q = (const f32x4*)(p + (size_t)row * ld + k0); return pack8(q[0], q[1]); }
};
struct OpF32KN {
    static constexpr bool ROWFAST = true; const float* p; int ld; int c0;
    __device__ __forceinline__ bf16x8 load8(int n, int k0) const {
        const float* q = p + (size_t)k0 * ld + c0 + n; float v[8];
#pragma unroll
        for (int j = 0; j < 8; ++j) v[j] = q[(size_t)j * ld];
        return pack8((f32x4){v[0], v[1], v[2], v[3]}, (f32x4){v[4], v[5], v[6], v[7]});
    }
};
struct OpF32KNPair {
    static constexpr bool ROWFAST = true; const float* w0; long delta; int ld;
    __device__ __forceinline__ bf16x8 load8(int n, int k0) const {
        const int f = ((n >> 5) << 4) | (n & 15); const float* q = w0 + (long)((n >> 4) & 1) * delta + (size_t)k0 * ld + f; float v[8];
#pragma unroll
        for (int j = 0; j < 8; ++j) v[j] = q[(size_t)j * ld];
        return pack8((f32x4){v[0], v[1], v[2], v[3]}, (f32x4){v[4], v[5], v[6], v[7]});
    }
};


struct Args { const float* in[24]; float* out; unsigned char* ws; int ph_lo, ph_hi; };
typedef const __attribute__((address_space(4))) Args* KArgs;
struct Frame {
    LAS unsigned char* lds; int wave, G, bid;
    unsigned char* ws; float* xo;
    __device__ __forceinline__ int lane() const { return lane_id_here(); }
    __device__ __forceinline__ int tid() const { return wave * 64 + lane_id_here(); }
};

namespace pg8 {
constexpr int BM = 256, BK = 64, HALF = 128, HTB = HALF * BK * 2, STAGE_BYTES = 8 * HTB, NXCD = 8, WGM = 8;
__device__ __forceinline__ int lds_byte(int r, int c) { const int st = (r >> 4) * 2 + (c >> 5), rr = r & 15, cc = c & 31, ob = rr * 64 + cc * 2; return st * 1024 + (ob ^ (((ob >> 9) & 1) << 5)); }
__device__ __forceinline__ void stage_rc(int b, int& R, int& C) { const int st = b / 1024, sb = b % 1024, swz = sb ^ (((sb >> 9) & 1) << 5); R = (st >> 1) * 16 + swz / 64; C = (st & 1) * 32 + (swz % 64) / 2; }
__device__ __forceinline__ int perm32(int rho) { const int n = rho >> 4, i = rho & 15; return 8 * (i >> 2) + 4 * n + (i & 3); }
struct Unit { int pm, pn; };
typedef int v8i_t __attribute__((ext_vector_type(8)));
__device__ __forceinline__ v8i_t cat8(const bf16x8 lo, const bf16x8 hi) { typedef int v4i_t __attribute__((ext_vector_type(4))); const v4i_t a = __builtin_bit_cast(v4i_t, lo), b = __builtin_bit_cast(v4i_t, hi); return (v8i_t){a.x, a.y, a.z, a.w, b.x, b.y, b.z, b.w}; }
struct StaticOrder {
    int nM, nN, nwg, G, c;
    __device__ void init(int M, int N, int G_, int c_) { nM = M / BM; nN = N / BM; nwg = nM * nN; G = G_; c = c_; }
    __device__ bool next(int i, Unit& u) const {
        const long L = (long)i * G + c; if (L >= nwg) return false;
        int wgid = (int)L; { const int q = nwg / NXCD, r = nwg % NXCD, xcd = wgid % NXCD, off = wgid / NXCD; wgid = (xcd < r ? xcd * (q + 1) : r * (q + 1) + (xcd - r) * q) + off; }
        const int nig = WGM * nN, gid = wgid / nig, fm = gid * WGM, gsz = (nM - fm) < WGM ? (nM - fm) : WGM;
        u.pm = fm + ((wgid % nig) % gsz); u.pn = (wgid % nig) / gsz; return true;
    }
};
struct ExpertOrder {
    int nN, nwg, G, c;
    __device__ void init(int nN_, int G_, int c_) { nN = nN_; nwg = NE * 16 * nN_; G = G_; c = c_; }
    __device__ bool next(int i, Unit& u) const { const long L = (long)i * G + c; if (L >= nwg) return false;
        int combo = (int)(L >> 4), pml = (int)(L & 15);
        if (G == 256) { const int x = c & 7, j = c >> 3; combo = 16 * i + 4 * (x >> 1) + (j >> 3); pml = 8 * (x & 1) + (j & 7); }
        const int e = combo / nN; u.pn = combo - e * nN; u.pm = e * 16 + pml; return true; }
};
struct PolPlain {
    static constexpr bool DYN = false, FP8 = false, BSWITCH = false; const bf16* A; const bf16* Bt; int lda, ldb, K;
    __device__ __forceinline__ const char* a_base(const Unit& u) const { return (const char*)(A + (size_t)u.pm * BM * lda); }
    __device__ __forceinline__ const char* b_base(const Unit& u) const { return (const char*)(Bt + (size_t)u.pn * BM * ldb); }
    __device__ __forceinline__ unsigned a_off(int h, int R, int C, const Unit&) const { return (unsigned)((h * HALF + R) * lda + C) * 2u; }
    __device__ __forceinline__ unsigned b_off(int h, int R, int C) const { return (unsigned)((h * HALF + R) * ldb + C) * 2u; }
};
struct PolG1a {
    static constexpr bool DYN = false, FP8 = false, BSWITCH = false; const bf16* A; const bf16* H; int K;
    __device__ __forceinline__ const char* a_base(const Unit& u) const { return (const char*)(A + (size_t)u.pm * BM * DM); }
    __device__ __forceinline__ const char* b_base(const Unit& u) const { return (const char*)(H + ((size_t)(u.pn >> 5) * SEQ + 2 * (u.pn & 31)) * DM); }
    __device__ __forceinline__ unsigned a_off(int h, int R, int C, const Unit&) const { return (unsigned)((h * HALF + R) * DM + C) * 2u; }
    __device__ __forceinline__ unsigned b_off(int h, int R, int C) const { return (unsigned)((64 * R + h) * DM + C) * 2u; }
};
struct PolExpUp {
    static constexpr bool DYN = true, FP8 = false, BSWITCH = false; const bf16* H2; const int* idx; const bf16* W; int K;
    __device__ __forceinline__ const char* a_base(const Unit&) const { return (const char*)H2; }
    __device__ __forceinline__ const char* b_base(const Unit& u) const { return (const char*)(W + ((size_t)(u.pm >> 4) * (2 * DE) + (size_t)u.pn * BM) * DM); }
    __device__ __forceinline__ unsigned a_off(int h, int R, int C, const Unit& u) const { return (unsigned)idx[u.pm * BM + h * HALF + R] * (unsigned)(DM * 2) + (unsigned)C * 2u; }
    __device__ __forceinline__ unsigned b_off(int h, int R, int C) const { return (unsigned)((h * HALF + R) * DM + C) * 2u; }
};
struct PolExpUp8 {
    static constexpr bool DYN = true, FP8 = true, BSWITCH = false; const unsigned char* H2; const int* idx; const unsigned char* W; int K;
    __device__ __forceinline__ const char* a_base(const Unit&) const { return (const char*)H2; }
    __device__ __forceinline__ const char* b_base(const Unit& u) const { return (const char*)(W + ((size_t)(u.pm >> 4) * (2 * DE) + (size_t)u.pn * BM) * DM); }
    __device__ __forceinline__ unsigned a_off(int h, int R, int C, const Unit& u) const { return (unsigned)idx[u.pm * BM + h * HALF + R] * (unsigned)DM + (unsigned)C * 2u; }
    __device__ __forceinline__ unsigned b_off(int h, int R, int C) const { return (unsigned)((h * HALF + R) * DM) + (unsigned)C * 2u; }
};
struct PolPlain8 {
    static constexpr bool DYN = false, FP8 = true, BSWITCH = false; const unsigned char* A; const unsigned char* W; int lda, ldb, K;
    __device__ __forceinline__ const char* a_base(const Unit& u) const { return (const char*)(A + (size_t)u.pm * BM * lda); }
    __device__ __forceinline__ const char* b_base(const Unit& u) const { return (const char*)(W + (size_t)u.pn * BM * ldb); }
    __device__ __forceinline__ unsigned a_off(int h, int R, int C, const Unit&) const { return (unsigned)((h * HALF + R) * lda) + (unsigned)C * 2u; }
    __device__ __forceinline__ unsigned b_off(int h, int R, int C) const { return (unsigned)((h * HALF + R) * ldb) + (unsigned)C * 2u; }
};
struct PolExpDown8 {
    static constexpr bool DYN = false, FP8 = true, BSWITCH = false; const unsigned char* A; const unsigned char* W; int K;
    __device__ __forceinline__ const char* a_base(const Unit& u) const { return (const char*)(A + (size_t)u.pm * BM * DE); }
    __device__ __forceinline__ const char* b_base(const Unit& u) const { return (const char*)(W + ((size_t)(u.pm >> 4) * DM + (size_t)u.pn * BM) * DE); }
    __device__ __forceinline__ unsigned a_off(int h, int R, int C, const Unit&) const { return (unsigned)((h * HALF + R) * DE) + (unsigned)C * 2u; }
    __device__ __forceinline__ unsigned b_off(int h, int R, int C) const { return (unsigned)((h * HALF + R) * DE) + (unsigned)C * 2u; }
};
struct PolExpDown {
    static constexpr bool DYN = false, FP8 = false, BSWITCH = false; const bf16* A; const bf16* W; int K;
    __device__ __forceinline__ const char* a_base(const Unit& u) const { return (const char*)(A + (size_t)u.pm * BM * DE); }
    __device__ __forceinline__ const char* b_base(const Unit& u) const { return (const char*)(W + ((size_t)(u.pm >> 4) * DM + (size_t)u.pn * BM) * DE); }
    __device__ __forceinline__ unsigned a_off(int h, int R, int C, const Unit&) const { return (unsigned)((h * HALF + R) * DE + C) * 2u; }
    __device__ __forceinline__ unsigned b_off(int h, int R, int C) const { return (unsigned)((h * HALF + R) * DE + C) * 2u; }
};

struct PolPassB {
    static constexpr bool DYN = false, FP8 = false, BSWITCH = false; const bf16* A; const bf16* W; int K;
    __device__ __forceinline__ const char* a_base(const Unit& u) const { return (const char*)(A + (size_t)u.pm * BM * KCAT); }
    __device__ __forceinline__ const char* b_base(const Unit& u) const { return (const char*)(W + ((size_t)(u.pm >> 1) * 1024 + (size_t)u.pn * BM) * KCAT); }
    __device__ __forceinline__ unsigned a_off(int h, int R, int C, const Unit&) const { return (unsigned)((h * HALF + R) * KCAT + C) * 2u; }
    __device__ __forceinline__ unsigned b_off(int h, int R, int C) const { return (unsigned)((h * HALF + R) * KCAT + C) * 2u; }
};
struct PolStageC {
    static constexpr bool DYN = false, FP8 = false, BSWITCH = false; const bf16* A; const bf16* Y; int K;
    __device__ __forceinline__ const char* a_base(const Unit&) const { return (const char*)A; }
    __device__ __forceinline__ const char* b_base(const Unit& u) const { return (const char*)(Y + (size_t)u.pn * 2 * 128 * 128); }
    __device__ __forceinline__ unsigned a_off(int h, int R, int C, const Unit&) const { return (unsigned)((h * HALF + R) * 128 + C) * 2u; }
    __device__ __forceinline__ unsigned b_off(int h, int R, int C) const { return (unsigned)((((R >> 6) * 128 + h * 64 + (R & 63)) * 128) + C) * 2u; }
};
struct PolPassB2 {
    static constexpr bool DYN = false, FP8 = false, BSWITCH = true; static constexpr int KSW = 16;
    const bf16* A; const bf16* KC; const bf16* CT; int K;
    __device__ __forceinline__ const char* a_base(const Unit& u) const { return (const char*)(A + (size_t)u.pm * BM * KCAT); }
    __device__ __forceinline__ unsigned a_off(int h, int R, int C, const Unit&) const { return (unsigned)((h * HALF + R) * KCAT + C) * 2u; }
    __device__ __forceinline__ const char* b_base(const Unit& u) const { return (const char*)(KC + (size_t)(u.pm >> 1) * (128 * 256)) + (size_t)u.pn * 8192; }
    __device__ __forceinline__ unsigned b_off(int h, int R, int C) const { const int row = h * HALF + R; return (unsigned)((((row >> 4) - (C >> 4) + 63) * 256 + (row & 15) * 16 + (C & 15)) * 2); }
    __device__ __forceinline__ long kstepB1() const { return -2048; }
    __device__ __forceinline__ const char* b_base2(const Unit& u) const { return (const char*)(CT + ((size_t)(u.pm >> 1) * 1024 + (size_t)u.pn * BM) * 256); }
    __device__ __forceinline__ unsigned b_off2(int h, int R, int C) const { return (unsigned)((h * HALF + R) * 256 + C) * 2u; }
    __device__ __forceinline__ long kstepB2() const { return 128; }
};
struct LinearOrder {
    int nN, nwg, G, c;
    __device__ void init(int nM_, int nN_, int G_, int c_) { nN = nN_; nwg = nM_ * nN_; G = G_; c = c_; }
    __device__ bool next(int i, Unit& u) const { const long L = (long)i * G + c; if (L >= nwg) return false; u.pm = (int)(L / nN); u.pn = (int)(L % nN); return true; }
};
template <class E, class = void> struct epi_side { static constexpr bool v = false; };
template <class E> struct epi_side<E, decltype((void)E::SIDE)> { static constexpr bool v = E::SIDE; };
constexpr int LDS_SIDE = 132 * 1024;
template <class Pol> __device__ __forceinline__ constexpr int ksw_of() { if constexpr (Pol::BSWITCH) return Pol::KSW; else return 0; }
template <class Pol, class Epi, class Sched>
__device__ __forceinline__ void gemm_phase(LAS unsigned char* lds, const Pol& P, const Sched& S, const Epi& E, int wid) {
    const int lane = lane_id_here(), tid = wid * 64 + lane, wr = wid >> 2, wc = wid & 3, fr = lane & 15, fq = lane >> 4;
    int nt = P.K / BK; asm volatile("" : "+s"(nt));
    Unit cur, nxt; int ui = 0;
    if (!S.next(0, cur)) return;
    int sR[2], sC[2], sRb[2];
#pragma unroll
    for (int i = 0; i < 2; ++i) { stage_rc(tid * 16 + i * 8192, sR[i], sC[i]); sRb[i] = Epi::PERM ? ((sR[i] & ~31) + perm32(sR[i] & 31)) : sR[i]; }
    unsigned vA[2][2], vB[2], vB2[2], vAn[2][2];
    const size_t hsB1 = (size_t)(P.b_off(1, 0, 0) - P.b_off(0, 0, 0)); size_t hsB2 = 0;
#pragma unroll
    for (int i = 0; i < 2; ++i) { vB[i] = P.b_off(0, sRb[i], sC[i]); vB2[i] = 0u;
#pragma unroll
        for (int h = 0; h < 2; ++h) { vA[h][i] = P.a_off(h, sR[i], sC[i], cur); vAn[h][i] = vA[h][i]; } }
    if constexpr (Pol::BSWITCH) { hsB2 = (size_t)(P.b_off2(1, 0, 0) - P.b_off2(0, 0, 0));
#pragma unroll
        for (int i = 0; i < 2; ++i) vB2[i] = P.b_off2(0, sRb[i], sC[i]); }
    if (Pol::DYN) asm volatile("s_waitcnt vmcnt(0)" ::: "memory");
    const size_t kstep = (size_t)(BK * 2);
    long ksB = (long)kstep, ksB2 = 0; if constexpr (Pol::BSWITCH) { ksB = P.kstepB1(); ksB2 = P.kstepB2(); }
    const unsigned ldsw = (unsigned)wid * 1024u;
    const int aoff = lds_byte(wr * 64 + fr, fq * 8), boff = lds_byte(wc * 32 + fr, fq * 8);
#define PG8_SA(b, h) (((b) * 2 + (h)) * HTB)
#define PG8_SB(b, h) ((4 + (b) * 2 + (h)) * HTB)
#define PG8_STG(bufoff, gbase, voff2) do { _Pragma("unroll") for (int _i = 0; _i < 2; ++_i) { unsigned _o = (voff2)[_i]; asm volatile("" : "+v"(_o));     \
        __builtin_amdgcn_global_load_lds((const unsigned*)((const char*)(gbase) + _o), (LAS unsigned*)(lds + (bufoff) + ldsw + _i * 8192), 16, 0, 0); } } while (0)
#define PG8_LDA(dst, b, h) do { if constexpr (Pol::FP8) { _Pragma("unroll") for (int m = 0; m < 4; ++m) dst##8[m] = cat8(*(const LAS bf16x8*)(lds + PG8_SA(b, h) + aoff + m * 2048), *(const LAS bf16x8*)(lds + PG8_SA(b, h) + aoff + m * 2048 + 1024)); } \
        else { _Pragma("unroll") for (int m = 0; m < 4; ++m) _Pragma("unroll") for (int k = 0; k < 2; ++k) dst[m][k] = *(const LAS bf16x8*)(lds + PG8_SA(b, h) + aoff + m * 2048 + k * 1024); } } while (0)
#define PG8_LDB(dst, b, h) do { if constexpr (Pol::FP8) { _Pragma("unroll") for (int n = 0; n < 2; ++n) dst##8[n] = cat8(*(const LAS bf16x8*)(lds + PG8_SB(b, h) + boff + n * 2048), *(const LAS bf16x8*)(lds + PG8_SB(b, h) + boff + n * 2048 + 1024)); } \
        else { _Pragma("unroll") for (int n = 0; n < 2; ++n) _Pragma("unroll") for (int k = 0; k < 2; ++k) dst[n][k] = *(const LAS bf16x8*)(lds + PG8_SB(b, h) + boff + n * 2048 + k * 1024); } } while (0)
#define PG8_MMA(ai, bj, At, Bt) do { __builtin_amdgcn_s_setprio(1); \
        if constexpr (Pol::FP8) { _Pragma("unroll") for (int m = 0; m < 4; ++m) _Pragma("unroll") for (int n = 0; n < 2; ++n) \
            acc[ai][bj][m][n] = __builtin_amdgcn_mfma_scale_f32_16x16x128_f8f6f4(Bt##8[n], At##8[m], acc[ai][bj][m][n], 0, 0, 0, 0x7f7f7f7f, 0, 0x7f7f7f7f); } \
        else { _Pragma("unroll") for (int m = 0; m < 4; ++m) _Pragma("unroll") for (int n = 0; n < 2; ++n) _Pragma("unroll") for (int k = 0; k < 2; ++k) \
            acc[ai][bj][m][n] = __builtin_amdgcn_mfma_f32_16x16x32_bf16(Bt[n][k], At[m][k], acc[ai][bj][m][n], 0, 0, 0); } \
        __builtin_amdgcn_s_setprio(0); } while (0)
#define PG8_WAIT_V(n) asm volatile("s_waitcnt vmcnt(" #n ")" ::: "memory")
#define PG8_WAIT_L(n) asm volatile("s_waitcnt lgkmcnt(" #n ")" ::: "memory")
#define PG8_BAR __builtin_amdgcn_s_barrier()
#define PG8_SCHED __builtin_amdgcn_sched_barrier(0)
    f32x4 acc[2][2][4][2];
#pragma unroll
    for (int a = 0; a < 2; ++a)
#pragma unroll
        for (int b = 0; b < 2; ++b)
#pragma unroll
            for (int m = 0; m < 4; ++m)
#pragma unroll
                for (int n = 0; n < 2; ++n) acc[a][b][m][n] = (f32x4){0.f, 0.f, 0.f, 0.f};
    bf16x8 At[4][2], B0[2][2], B1[2][2]; v8i_t At8[4], B08[2], B18[2]; (void)At; (void)B0; (void)B1; (void)At8; (void)B08; (void)B18;
    const char* cA = P.a_base(cur); const char* cB = P.b_base(cur);
    PG8_STG(PG8_SB(0, 0), cB, vB); PG8_STG(PG8_SB(0, 1), cB + hsB1, vB); PG8_STG(PG8_SA(0, 0), cA, vA[0]); PG8_STG(PG8_SA(0, 1), cA, vA[1]);
    if (wr == 1) PG8_BAR;
    PG8_WAIT_V(2); PG8_BAR;
    PG8_STG(PG8_SB(1, 0), cB + ksB, vB); PG8_STG(PG8_SA(1, 0), cA + kstep, vA[0]); PG8_STG(PG8_SB(1, 1), cB + ksB + hsB1, vB);
    PG8_WAIT_V(6); PG8_BAR;
    for (;;) {
        const bool has_next = S.next(ui + 1, nxt);
        const char* nA = has_next ? P.a_base(nxt) : cA; const char* nB = has_next ? P.b_base(nxt) : cB;
        const char* cB2 = cB; if constexpr (Pol::BSWITCH) cB2 = P.b_base2(cur);
        if constexpr (epi_side<Epi>::v) { if (wid == 0) { unsigned so = (unsigned)lane_id_here() * 16u; asm volatile("" : "+v"(so));
            __builtin_amdgcn_global_load_lds((const unsigned*)((const char*)E.side_ptr(cur) + so), (LAS unsigned*)(lds + LDS_SIDE + (ui & 1) * 1024), 16, 0, 0); } }
        if (Pol::DYN) {
            if (has_next) {
#pragma unroll
                for (int i = 0; i < 2; ++i) { int R_, C_; stage_rc(tid * 16 + i * 8192, R_, C_);
#pragma unroll
                    for (int h = 0; h < 2; ++h) vAn[h][i] = P.a_off(h, R_, C_, nxt); }
                asm volatile("s_waitcnt vmcnt(0)" ::: "memory");
            } else {
#pragma unroll
                for (int h = 0; h < 2; ++h)
#pragma unroll
                    for (int i = 0; i < 2; ++i) vAn[h][i] = vA[h][i];
            }
        }
        for (int t = 0; t < nt; t += 2) {
            const bool last = (t == nt - 2);
            const char* a1 = cA + (size_t)(t + 1) * kstep;
            const char* a2 = last ? nA : cA + (size_t)(t + 2) * kstep; const char* a3 = a2 + kstep;
            const char* b2; const char* b3; unsigned wB[2]; size_t hsB = hsB1;
            { bool r2 = false; if constexpr (Pol::BSWITCH) r2 = !last && (t + 2 >= ksw_of<Pol>());
              if (last) { b2 = nB; b3 = b2 + ksB; } else if (r2) { b2 = cB2 + (long)(t + 2 - ksw_of<Pol>()) * ksB2; b3 = b2 + ksB2; hsB = hsB2; } else { b2 = cB + (long)(t + 2) * ksB; b3 = b2 + ksB; }
#pragma unroll
              for (int i = 0; i < 2; ++i) wB[i] = r2 ? vB2[i] : vB[i]; }
            PG8_LDB(B0, 0, 0); PG8_LDB(B1, 0, 1); PG8_SCHED; PG8_LDA(At, 0, 0); PG8_STG(PG8_SA(1, 1), a1, vA[1]);
            if (Pol::DYN && last) {
#pragma unroll
                for (int h = 0; h < 2; ++h)
#pragma unroll
                    for (int i = 0; i < 2; ++i) vA[h][i] = vAn[h][i]; }
            PG8_WAIT_V(8); PG8_WAIT_L(0); PG8_BAR; PG8_MMA(0, 0, At, B0); PG8_MMA(0, 1, At, B1); PG8_BAR; PG8_SCHED;
            PG8_LDA(At, 0, 1); PG8_STG(PG8_SB(0, 0), b2, wB); PG8_STG(PG8_SB(0, 1), b2 + hsB, wB); PG8_STG(PG8_SA(0, 0), a2, vA[0]);
            PG8_WAIT_V(8); PG8_WAIT_L(0); PG8_BAR; PG8_MMA(1, 0, At, B0); PG8_MMA(1, 1, At, B1); PG8_BAR; PG8_SCHED;
            PG8_LDB(B0, 1, 0); PG8_LDB(B1, 1, 1); PG8_SCHED; PG8_LDA(At, 1, 0); PG8_STG(PG8_SA(0, 1), a2, vA[1]);
            PG8_WAIT_V(8); PG8_WAIT_L(0); PG8_BAR; PG8_MMA(0, 0, At, B0); PG8_MMA(0, 1, At, B1); PG8_BAR; PG8_SCHED;
            PG8_LDA(At, 1, 1); PG8_STG(PG8_SB(1, 0), b3, wB); PG8_STG(PG8_SB(1, 1), b3 + hsB, wB); PG8_STG(PG8_SA(1, 0), a3, vA[0]);
            PG8_WAIT_V(8); PG8_WAIT_L(0); PG8_BAR; PG8_MMA(1, 0, At, B0); PG8_MMA(1, 1, At, B1); PG8_BAR; PG8_SCHED;
        }
        if (wr == 0) PG8_BAR;
        { Unit eu = cur; int et = lane_id_here(); asm volatile("" : "+s"(eu.pm), "+s"(eu.pn), "+v"(et)); const int efr = et & 15, efq = (et >> 4) & 3;
          if constexpr (epi_side<Epi>::v) E(acc, eu, wr, wc, efr, efq, (const LAS float*)(lds + LDS_SIDE + (ui & 1) * 1024)); else E(acc, eu, wr, wc, efr, efq); }
        if (!has_next) break;
#pragma unroll
        for (int a = 0; a < 2; ++a)
#pragma unroll
            for (int b = 0; b < 2; ++b)
#pragma unroll
                for (int m = 0; m < 4; ++m)
#pragma unroll
                    for (int n = 0; n < 2; ++n) acc[a][b][m][n] = (f32x4){0.f, 0.f, 0.f, 0.f};
        cur = nxt; cA = nA; cB = nB; ++ui;
        if (Pol::DYN) {
#pragma unroll
            for (int h = 0; h < 2; ++h)
#pragma unroll
                for (int i = 0; i < 2; ++i) vA[h][i] = vAn[h][i];
        }
        if (wr == 1) PG8_BAR;
    }
    PG8_WAIT_V(0);
    PG8_BAR;
#undef PG8_SA
#undef PG8_SB
#undef PG8_STG
#undef PG8_LDA
#undef PG8_LDB
#undef PG8_MMA
#undef PG8_WAIT_V
#undef PG8_WAIT_L
#undef PG8_BAR
#undef PG8_SCHED
}

__device__ __forceinline__ u32x4 pk8(const f32x4 a, const f32x4 b) { u32x4 w; w.x = cvt_pk_bf16(a.x, a.y); w.y = cvt_pk_bf16(a.z, a.w); w.z = cvt_pk_bf16(b.x, b.y); w.w = cvt_pk_bf16(b.z, b.w); return w; }
__device__ __forceinline__ void unpk8(const u32x4 w, f32x4& a, f32x4& b) {
    a.x = __uint_as_float(w.x << 16); a.y = __uint_as_float(w.x & 0xffff0000u); a.z = __uint_as_float(w.y << 16); a.w = __uint_as_float(w.y & 0xffff0000u);
    b.x = __uint_as_float(w.z << 16); b.y = __uint_as_float(w.z & 0xffff0000u); b.z = __uint_as_float(w.w << 16); b.w = __uint_as_float(w.w & 0xffff0000u); }
__device__ __forceinline__ f32x4 sig4(const f32x4 v) { return (f32x4){sigmoidf_(v.x), sigmoidf_(v.y), sigmoidf_(v.z), sigmoidf_(v.w)}; }
__device__ __forceinline__ u32x2 pk8_u8(const f32x4 a, const f32x4 b) {
    unsigned lo = 0u, hi = 0u;
    lo = __builtin_amdgcn_cvt_pk_u8_f32(a.x * 255.0f, 0, lo); lo = __builtin_amdgcn_cvt_pk_u8_f32(a.y * 255.0f, 1, lo); lo = __builtin_amdgcn_cvt_pk_u8_f32(a.z * 255.0f, 2, lo); lo = __builtin_amdgcn_cvt_pk_u8_f32(a.w * 255.0f, 3, lo);
    hi = __builtin_amdgcn_cvt_pk_u8_f32(b.x * 255.0f, 0, hi); hi = __builtin_amdgcn_cvt_pk_u8_f32(b.y * 255.0f, 1, hi); hi = __builtin_amdgcn_cvt_pk_u8_f32(b.z * 255.0f, 2, hi); hi = __builtin_amdgcn_cvt_pk_u8_f32(b.w * 255.0f, 3, hi);
    return (u32x2){lo, hi};
}
__device__ __forceinline__ void unpk8_u8(const u32x2 w, f32x4& a, f32x4& b) {
    constexpr float k = 1.0f / 255.0f;
    a = (f32x4){(float)(w.x & 255u) * k, (float)((w.x >> 8) & 255u) * k, (float)((w.x >> 16) & 255u) * k, (float)(w.x >> 24) * k};
    b = (f32x4){(float)(w.y & 255u) * k, (float)((w.y >> 8) & 255u) * k, (float)((w.y >> 16) & 255u) * k, (float)(w.y >> 24) * k};
}
#define PG8_EPI_LOOP for (int ai = 0; ai < 2; ++ai) _Pragma("unroll") for (int m = 0; m < 4; ++m) _Pragma("unroll") for (int bj = 0; bj < 2; ++bj)
struct EpiXt {
    static constexpr bool PERM = true; bf16* XT;
    __device__ __forceinline__ void operator()(const f32x4 (&acc)[2][2][4][2], const Unit& u, int wr, int wc, int fr, int fq) const {
        const int b = u.pn >> 5, n1 = wc * 32 + 8 * fq;
#pragma unroll
        PG8_EPI_LOOP { const int r = u.pm * BM + ai * HALF + wr * 64 + m * 16 + fr, g = r >> 7, pqc = r & 127, n2 = 2 * (u.pn & 31) + bj;
            *(u32x4*)(XT + ((((size_t)(b * 4 + g) * 128 + pqc) * 64 + n2) * 128 + n1)) = pk8(acc[ai][bj][m][0], acc[ai][bj][m][1]); }
    }
};
struct EpiG1b {
    static constexpr bool PERM = true; bf16* ACAT; unsigned char* GF; unsigned char* GS;
    __device__ __forceinline__ void operator()(const f32x4 (&acc)[2][2][4][2], const Unit& u, int wr, int wc, int fr, int fq) const {
#pragma unroll
        PG8_EPI_LOOP { const int r = u.pm * BM + ai * HALF + wr * 64 + m * 16 + fr, c = u.pn * BM + bj * HALF + wc * 32 + 8 * fq;
            if (c < 512) { const int g = c >> 4; *(u32x4*)(ACAT + ((size_t)(g * NROWC + (r >> 6)) * KCAT + (r & 63) * 16 + (c & 15))) = pk8(acc[ai][bj][m][0], acc[ai][bj][m][1]); }
            else { const int cc = c - 512; const u32x2 w = pk8_u8(sig4(acc[ai][bj][m][0]), sig4(acc[ai][bj][m][1]));
                if (cc < 1024) *(u32x2*)(GF + (size_t)r * DM + cc) = w; else *(u32x2*)(GS + (size_t)r * DM + (cc - 1024)) = w; } }
    }
};
struct EpiPassB {
    static constexpr bool PERM = true; bf16* YS;
    __device__ __forceinline__ void operator()(const f32x4 (&acc)[2][2][4][2], const Unit& u, int wr, int wc, int fr, int fq) const {
#pragma unroll
        PG8_EPI_LOOP { const int r = u.pm * BM + ai * HALF + wr * 64 + m * 16 + fr, c = u.pn * BM + bj * HALF + wc * 32 + 8 * fq, g = r >> 9, s = c >> 4, o = c & 15;
            const f32x4 v0 = acc[ai][bj][m][0], v1 = acc[ai][bj][m][1];
            *(u32x4*)(YS + ((size_t)((r & 511) * 64 + s) * 512 + g * 16 + o)) = pk8((f32x4){gelu_tanh(v0.x), gelu_tanh(v0.y), gelu_tanh(v0.z), gelu_tanh(v0.w)}, (f32x4){gelu_tanh(v1.x), gelu_tanh(v1.y), gelu_tanh(v1.z), gelu_tanh(v1.w)}); }
    }
};
struct EpiStageA {
    static constexpr bool PERM = true; bf16* Y; const f32x2* TW;
    __device__ __forceinline__ void operator()(const f32x4 (&acc)[2][2][4][2], const Unit& u, int wr, int wc, int fr, int fq) const {
        const int bg = u.pn >> 5, n2 = 32 * (wc & 1) + 8 * fq;
        f32x2 tq0[4], tq1[4];
#pragma unroll
        for (int m = 0; m < 4; ++m) { const int k1 = 64 * wr + 16 * m + fr; tq0[m] = TW[n2 * k1]; tq1[m] = TW[k1]; }
        asm volatile("s_waitcnt vmcnt(0)" ::: "memory");
#pragma unroll
        for (int m = 0; m < 4; ++m) { const int k1 = 64 * wr + 16 * m + fr; const f32x2 t0 = tq0[m], t1 = tq1[m];
            float twc[8], tws[8]; twc[0] = t0.x; tws[0] = t0.y;
#pragma unroll
            for (int q = 1; q < 8; ++q) { twc[q] = twc[q - 1] * t1.x - tws[q - 1] * t1.y; tws[q] = tws[q - 1] * t1.x + twc[q - 1] * t1.y; }
#pragma unroll
            for (int bj = 0; bj < 2; ++bj) { const int pqc = 4 * (u.pn & 31) + 2 * bj + (wc >> 1); f32x4 xr[2], xi[2];
#pragma unroll
                for (int n = 0; n < 2; ++n)
#pragma unroll
                    for (int j = 0; j < 4; ++j) { const float c_ = twc[4 * n + j], s_ = tws[4 * n + j], ar = acc[0][bj][m][n][j], ai_ = acc[1][bj][m][n][j];
                        const float br = ar * c_ + ai_ * s_, bi = ai_ * c_ - ar * s_; if (pqc >= 65) { xr[n][j] = -bi; xi[n][j] = br; } else { xr[n][j] = br; xi[n][j] = bi; } }
                bf16* yp = Y + (((size_t)(bg * 128 + k1) * 128 + pqc) * 128 + n2); *(u32x4*)yp = pk8(xr[0], xr[1]); *(u32x4*)(yp + 64) = pk8(xi[0], xi[1]); }
            asm volatile("" ::: "memory"); }
    }
};
struct EpiStageC {
    static constexpr bool PERM = true; bf16* FM;
    __device__ __forceinline__ void operator()(const f32x4 (&acc)[2][2][4][2], const Unit& u, int wr, int wc, int fr, int fq) const {
        if (wr != 0) return;
        const int bgk1 = 2 * u.pn + (wc >> 1), bg = bgk1 >> 7, k1 = bgk1 & 127, b = bg >> 2, g = bg & 3, c0 = 32 * (wc & 1) + 8 * fq;
#pragma unroll
        for (int m = 0; m < 4; ++m) { const int k2 = 16 * m + fr; f32x4 dr0 = acc[0][0][m][0] - acc[0][1][m][0], dr1 = acc[0][0][m][1] - acc[0][1][m][1], mr0 = acc[0][0][m][0] + acc[0][1][m][0], mr1 = acc[0][0][m][1] + acc[0][1][m][1];
            if (c0 == 0) { dr0.x = acc[0][0][m][0].x; mr0.x = acc[0][1][m][0].x; }
            bf16* o = FM + (size_t)(b * SEQ + k1 + 128 * k2) * 512 + g * 128 + c0; *(u32x4*)o = pk8(dr0, dr1); *(u32x4*)(o + 64) = pk8(mr0, mr1); }
    }
};
struct EpiBf16 {
    static constexpr bool PERM = true; bf16* O; int ld;
    __device__ __forceinline__ void operator()(const f32x4 (&acc)[2][2][4][2], const Unit& u, int wr, int wc, int fr, int fq) const {
#pragma unroll
        PG8_EPI_LOOP { const int r = u.pm * BM + ai * HALF + wr * 64 + m * 16 + fr, c = u.pn * BM + bj * HALF + wc * 32 + 8 * fq;
            *(u32x4*)(O + (size_t)r * ld + c) = pk8(acc[ai][bj][m][0], acc[ai][bj][m][1]); }
    }
};
struct EpiMulGate {
    static constexpr bool PERM = true; bf16* O; const unsigned char* G;
    __device__ __forceinline__ void operator()(const f32x4 (&acc)[2][2][4][2], const Unit& u, int wr, int wc, int fr, int fq) const {
#pragma unroll
        for (int ai = 0; ai < 2; ++ai) { u32x2 t[4][2];
#pragma unroll
            for (int m = 0; m < 4; ++m)
#pragma unroll
                for (int bj = 0; bj < 2; ++bj) t[m][bj] = *(const u32x2*)(G + (size_t)(u.pm * BM + ai * HALF + wr * 64 + m * 16 + fr) * DM + u.pn * BM + bj * HALF + wc * 32 + 8 * fq);
            asm volatile("s_waitcnt vmcnt(0)" ::: "memory");
#pragma unroll
            for (int m = 0; m < 4; ++m)
#pragma unroll
                for (int bj = 0; bj < 2; ++bj) { bf16* p = O + (size_t)(u.pm * BM + ai * HALF + wr * 64 + m * 16 + fr) * DM + u.pn * BM + bj * HALF + wc * 32 + 8 * fq;
                    f32x4 g0, g1; unpk8_u8(t[m][bj], g0, g1); *(u32x4*)p = pk8(acc[ai][bj][m][0] * g0, acc[ai][bj][m][1] * g1); } }
    }
};
struct EpiGlu {
    static constexpr bool PERM = true; bf16* MIX; const unsigned char* GS;
    __device__ __forceinline__ void operator()(const f32x4 (&acc)[2][2][4][2], const Unit& u, int wr, int wc, int fr, int fq) const {
#pragma unroll
        for (int ai = 0; ai < 2; ++ai) { u32x2 ts[4]; u32x4 tx[4];
#pragma unroll
            for (int m = 0; m < 4; ++m) { const size_t off = (size_t)(u.pm * BM + ai * HALF + wr * 64 + m * 16 + fr) * DM + u.pn * HALF + wc * 32 + 8 * fq; ts[m] = *(const u32x2*)(GS + off); tx[m] = *(const u32x4*)(MIX + off); }
            asm volatile("s_waitcnt vmcnt(0)" ::: "memory");
#pragma unroll
            for (int m = 0; m < 4; ++m) { const size_t off = (size_t)(u.pm * BM + ai * HALF + wr * 64 + m * 16 + fr) * DM + u.pn * HALF + wc * 32 + 8 * fq;
                f32x4 s0, s1, x0, x1; unpk8_u8(ts[m], s0, s1); unpk8(tx[m], x0, x1);
                *(u32x4*)(MIX + off) = pk8(acc[ai][0][m][0] * sig4(acc[ai][1][m][0]) * s0 + x0, acc[ai][0][m][1] * sig4(acc[ai][1][m][1]) * s1 + x1); } }
    }
};
struct EpiResidual {
    static constexpr bool PERM = false; float* O; const float* X;
    __device__ __forceinline__ void operator()(const f32x4 (&acc)[2][2][4][2], const Unit& u, int wr, int wc, int fr, int fq) const {
#pragma unroll
        for (int ai = 0; ai < 2; ++ai)
#pragma unroll
            for (int mp = 0; mp < 2; ++mp) { f32x4 t[2][2][2];
#pragma unroll
                for (int mm = 0; mm < 2; ++mm)
#pragma unroll
                    for (int bj = 0; bj < 2; ++bj)
#pragma unroll
                        for (int n = 0; n < 2; ++n) t[mm][bj][n] = *(const f32x4*)(X + (size_t)(u.pm * BM + ai * HALF + wr * 64 + (2 * mp + mm) * 16 + fr) * DM + u.pn * BM + bj * HALF + wc * 32 + 4 * fq + 16 * n);
#pragma unroll
                for (int mm = 0; mm < 2; ++mm)
#pragma unroll
                    for (int bj = 0; bj < 2; ++bj)
#pragma unroll
                        for (int n = 0; n < 2; ++n) *(f32x4*)(O + (size_t)(u.pm * BM + ai * HALF + wr * 64 + (2 * mp + mm) * 16 + fr) * DM + u.pn * BM + bj * HALF + wc * 32 + 4 * fq + 16 * n) = t[mm][bj][n] + acc[ai][bj][2 * mp + mm][n]; }
    }
};
struct EpiPle {
    static constexpr bool PERM = true, SIDE = true; const bf16* XI; bf16* XO; const bf16* EB; const float* RST; float sc;
    __device__ __forceinline__ const float* side_ptr(const Unit& u) const { return RST + (size_t)u.pm * BM; }
    __device__ __forceinline__ void operator()(const f32x4 (&acc)[2][2][4][2], const Unit& u, int wr, int wc, int fr, int fq, const LAS float* sd) const {
        float rs[2][4];
#pragma unroll
        for (int ai = 0; ai < 2; ++ai)
#pragma unroll
            for (int m = 0; m < 4; ++m) rs[ai][m] = sd[ai * HALF + wr * 64 + m * 16 + fr] * sc;
#pragma unroll
        for (int ai = 0; ai < 2; ++ai)
#pragma unroll
            for (int mp = 0; mp < 2; ++mp) { u32x4 tx[2][2], te[2][2];
#pragma unroll
                for (int mm = 0; mm < 2; ++mm)
#pragma unroll
                    for (int bj = 0; bj < 2; ++bj) { const size_t off = (size_t)(u.pm * BM + ai * HALF + wr * 64 + (2 * mp + mm) * 16 + fr) * DM + u.pn * BM + bj * HALF + wc * 32 + 8 * fq; tx[mm][bj] = *(const u32x4*)(XI + off); te[mm][bj] = *(const u32x4*)(EB + off); }
#pragma unroll
                for (int mm = 0; mm < 2; ++mm)
#pragma unroll
                    for (int bj = 0; bj < 2; ++bj) { const int m = 2 * mp + mm; const size_t off = (size_t)(u.pm * BM + ai * HALF + wr * 64 + m * 16 + fr) * DM + u.pn * BM + bj * HALF + wc * 32 + 8 * fq;
                        f32x4 x0, x1, e0, e1; unpk8(tx[mm][bj], x0, x1); unpk8(te[mm][bj], e0, e1);
                        *(u32x4*)(XO + off) = pk8(x0 + sig4(acc[ai][bj][m][0] * rs[ai][m]) * e0, x1 + sig4(acc[ai][bj][m][1] * rs[ai][m]) * e1); } }
    }
};
struct EpiSwiglu {
    static constexpr bool PERM = true, SIDE = true; unsigned char* HID; const float* rs; float sc, hs;
    __device__ __forceinline__ const float* side_ptr(const Unit& u) const { return rs + (size_t)u.pm * BM; }
    __device__ __forceinline__ void operator()(const f32x4 (&acc)[2][2][4][2], const Unit& u, int wr, int wc, int fr, int fq, const LAS float* sd) const {
#pragma unroll
        for (int ai = 0; ai < 2; ++ai)
#pragma unroll
            for (int m = 0; m < 4; ++m) { const int rl = ai * HALF + wr * 64 + m * 16 + fr, r = u.pm * BM + rl, f = u.pn * HALF + wc * 32 + 8 * fq;
                const float s1 = sd[rl] * sc, s2 = s1 * hs;
                const f32x4 g0 = acc[ai][0][m][0] * s1, g1 = acc[ai][0][m][1] * s1; const f32x4 h0 = g0 * sig4(g0) * (acc[ai][1][m][0] * s2), h1 = g1 * sig4(g1) * (acc[ai][1][m][1] * s2);
                u32x2 w; unsigned t = 0u; t = __builtin_amdgcn_cvt_pk_fp8_f32(clamp8(h0.x), clamp8(h0.y), t, false); t = __builtin_amdgcn_cvt_pk_fp8_f32(clamp8(h0.z), clamp8(h0.w), t, true); w.x = t;
                t = 0u; t = __builtin_amdgcn_cvt_pk_fp8_f32(clamp8(h1.x), clamp8(h1.y), t, false); t = __builtin_amdgcn_cvt_pk_fp8_f32(clamp8(h1.z), clamp8(h1.w), t, true); w.y = t;
                *(u32x2*)(HID + (size_t)r * DE + f) = w; }
    }
};
struct EpiScaleRows {
    static constexpr bool PERM = true, SIDE = true; bf16* O; const float* val; float sc;
    __device__ __forceinline__ const float* side_ptr(const Unit& u) const { return val + (size_t)u.pm * BM; }
    __device__ __forceinline__ void operator()(const f32x4 (&acc)[2][2][4][2], const Unit& u, int wr, int wc, int fr, int fq, const LAS float* sd) const {
#pragma unroll
        for (int ai = 0; ai < 2; ++ai)
#pragma unroll
            for (int m = 0; m < 4; ++m) { const int rl = ai * HALF + wr * 64 + m * 16 + fr, r = u.pm * BM + rl; const float s = sd[rl] * sc;
#pragma unroll
                for (int bj = 0; bj < 2; ++bj) { const int c = u.pn * BM + bj * HALF + wc * 32 + 8 * fq; *(u32x4*)(O + (size_t)r * DM + c) = pk8(acc[ai][bj][m][0] * s, acc[ai][bj][m][1] * s); } }
    }
};
}

__device__ __forceinline__ void rms_row_to_bf16(const float* xrow, const float* g, bf16* orow, int lane) {
    const f32x4* xr = (const f32x4*)xrow + lane; const f32x4* gr = (const f32x4*)g + lane;
    f32x4 v[4]; float s = 0.f;
#pragma unroll
    for (int j = 0; j < 4; ++j) { v[j] = xr[64 * j]; s += (v[j].x * v[j].x + v[j].y * v[j].y) + (v[j].z * v[j].z + v[j].w * v[j].w); }
    const float rstd = 1.0f / sqrtf(wave_sum(s) * (1.0f / DM) + RMS_EPS);
#pragma unroll
    for (int j = 0; j < 4; ++j) { const f32x4 gg = gr[64 * j]; store_bf16x4(orow + 4 * lane + 256 * j, (f32x4){v[j].x * rstd * gg.x, v[j].y * rstd * gg.y, v[j].z * rstd * gg.z, v[j].w * rstd * gg.w}); }
}

struct EpiStageA {
    bf16* Y; const f32x2* TW;
    __device__ __forceinline__ void tile(int row, int col, const f32x4 (&acc)[4][2]) const {
#pragma unroll
        for (int mp = 0; mp < 2; ++mp) { const int r = row + 32 * mp, k1 = ((r >> 5) << 4) | (r & 15);
#pragma unroll
            for (int n = 0; n < 2; ++n) { const int c = col + 16 * n, bg = c >> 13, pqc = (c >> 6) & 127, n2 = c & 63; f32x4 xr, xi;
#pragma unroll
                for (int j = 0; j < 4; ++j) { const f32x2 tw = TW[(n2 + j) * k1]; const float ar = acc[2 * mp][n][j], ai = acc[2 * mp + 1][n][j];
                    const float br = ar * tw.x + ai * tw.y, bi = ai * tw.x - ar * tw.y; if (pqc >= 65) { xr[j] = -bi; xi[j] = br; } else { xr[j] = br; xi[j] = bi; } }
                bf16* yp = Y + (((size_t)(bg * 128 + k1) * 128 + pqc) * 128 + n2); store_bf16x4(yp, xr); store_bf16x4(yp + 64, xi); } }
    }
};
struct EpiF32Plain { float* O; int ld;
    __device__ __forceinline__ void tile(int row, int col, const f32x4 (&acc)[4][2]) const {
#pragma unroll
        for (int m = 0; m < 4; ++m)
#pragma unroll
            for (int n = 0; n < 2; ++n) *(f32x4*)(O + (size_t)(row + 16 * m) * ld + col + 16 * n) = acc[m][n];
    }
};

struct OpDft2 {
    static constexpr bool ROWFAST = false; const bf16* D2;
    __device__ __forceinline__ bf16x8 load8(int row, int k0) const { if (row < 64) return *(const bf16x8*)(D2 + row * 128 + k0); return (bf16x8){0, 0, 0, 0, 0, 0, 0, 0}; }
};
struct OpYcols {
    static constexpr bool ROWFAST = false; const bf16* Y;
    __device__ __forceinline__ bf16x8 load8(int n, int k0) const { const int w = n & 127, c = ((w >> 5) << 4) | (w & 15), pq = (w >> 4) & 1; return *(const bf16x8*)(Y + ((size_t)(n >> 7) * 128 + pq * 64 + c) * 128 + k0); }
};
struct EpiStageC {
    bf16* FM;
    __device__ __forceinline__ void tile(int row, int col, const f32x4 (&acc)[4][2]) const {
        const int bgk1 = col >> 7, bg = bgk1 >> 7, k1 = bgk1 & 127, b = bg >> 2, g = bg & 3, c0 = (((col & 127) >> 5) << 4) | (col & 15);
#pragma unroll
        for (int m = 0; m < 4; ++m) { const int k2 = row + 16 * m; if (k2 < 64) { const f32x4 P = acc[m][0], Q = acc[m][1]; f32x4 dr = P - Q, mr = P + Q; if (c0 == 0) { dr.x = P.x; mr.x = Q.x; }
            bf16* o = FM + (size_t)(b * SEQ + k1 + 128 * k2) * 512 + g * 128 + c0; store_bf16x4(o, dr); store_bf16x4(o + 64, mr); } }
    }
};


__device__ __forceinline__ void phase_router(Frame& F, KArgs a) {
    unsigned char* ws = F.ws; unsigned char* H2 = ws + WS_H; float* AFF = (float*)(ws + OFF_AFF); float* RSD = (float*)(ws + OFF_RSD); (void)a;
    const int gw = F.bid * 8 + F.wave, NW = F.G * 8, lane = F.lane(), ri = lane & 15, q = lane >> 4;
    LAS f32x4* wl = (LAS f32x4*)F.lds;
    { const float* src = (const float*)(ws + OFF_WGT); for (int idx = F.tid(); idx < 64 * 64; idx += NTHR) { const int e = idx & 15, qq = (idx >> 4) & 3, j = idx >> 6; wl[idx] = *(const f32x4*)(src + e * DM + 16 * j + 4 * qq); } }
    asm volatile("s_waitcnt vmcnt(0)" ::: "memory"); __syncthreads();
    for (int tile = gw; tile < T / 16; tile += NW) { const int m0 = tile * 16;
        const f32x4* xr = (const f32x4*)(F.xo + (size_t)(m0 + ri) * DM) + q; unsigned char* hr = H2 + (size_t)(m0 + ri) * DM + 4 * q; const LAS f32x4* wrow = wl + lane;
        f32x4 ac0 = (f32x4){0.f, 0.f, 0.f, 0.f}, ac1 = ac0, ac2 = ac0, ac3 = ac0; float ss = 0.f;
#pragma unroll 1
        for (int half = 0; half < 2; ++half) { f32x4 v[32];
#pragma unroll
            for (int t = 0; t < 32; ++t) v[t] = xr[4 * (32 * half + t)];
            asm volatile("s_waitcnt vmcnt(0)" ::: "memory");
#pragma unroll
            for (int t = 0; t < 32; ++t) { const int j = 32 * half + t; const f32x4 x = v[t]; const f32x4 w = wrow[64 * j];
                ss += (x.x * x.x + x.y * x.y) + (x.z * x.z + x.w * x.w);
                unsigned w8 = 0u; w8 = __builtin_amdgcn_cvt_pk_fp8_f32(clamp8(x.x), clamp8(x.y), w8, false); w8 = __builtin_amdgcn_cvt_pk_fp8_f32(clamp8(x.z), clamp8(x.w), w8, true);
                *(unsigned*)(hr + 16 * j) = w8;
                ac0 = __builtin_amdgcn_mfma_f32_16x16x4f32(x.x, w.x, ac0, 0, 0, 0); ac1 = __builtin_amdgcn_mfma_f32_16x16x4f32(x.y, w.y, ac1, 0, 0, 0);
                ac2 = __builtin_amdgcn_mfma_f32_16x16x4f32(x.z, w.z, ac2, 0, 0, 0); ac3 = __builtin_amdgcn_mfma_f32_16x16x4f32(x.w, w.w, ac3, 0, 0, 0); }
        }
        ss += __shfl_xor(ss, 16); ss += __shfl_xor(ss, 32);
        const float rstd = 1.0f / sqrtf(ss * (1.0f / DM) + RMS_EPS);
        if (q == 0) RSD[m0 + ri] = rstd;
        const f32x4 lgv = (ac0 + ac1) + (ac2 + ac3);
#pragma unroll
        for (int r = 0; r < 4; ++r) { const float rs = __shfl(rstd, 4 * q + r); const float lg = lgv[r] * rs; float mx = lg;
#pragma unroll
            for (int o = 1; o < 16; o <<= 1) mx = fmaxf(mx, __shfl_xor(mx, o));
            const float ex = expf(lg - mx); float den = ex;
#pragma unroll
            for (int o = 1; o < 16; o <<= 1) den += __shfl_xor(den, o);
            AFF[(size_t)(m0 + 4 * q + r) * NE + ri] = ex / den; }
    }
}
__device__ __forceinline__ void phase_topk(Frame& F, KArgs a) {
    unsigned char* ws = F.ws; const float* AFF = (const float*)(ws + OFF_AFF); int* IDX = (int*)(ws + OFF_IDX); float* VAL = (float*)(ws + OFF_VAL); int* SLOT = (int*)(ws + OFF_SLOT); const float* RSD = (const float*)(ws + OFF_RSD); float* RSS = (float*)(ws + OFF_RSS);
    LAS unsigned* keys = (LAS unsigned*)F.lds; LAS unsigned* hist = keys + SEQ; LAS unsigned* ctl = hist + 256; LAS unsigned* wtot = ctl + 8;
    const int tid = F.tid(), lane = F.lane(), wave = F.wave;
    for (int be = F.bid; be < NB * NE; be += F.G) { const int b = be >> 4, e = be & 15; const float* src = AFF + (size_t)b * SEQ * NE + e;
        __syncthreads();
        for (int i = tid; i < SEQ; i += NTHR) keys[i] = __float_as_uint(src[(size_t)i * NE]);
        if (tid == 0) { ctl[0] = 0u; ctl[1] = CAP; }
        unsigned mask = 0u;
        for (int p = 3; p >= 0; --p) {
            if (tid < 256) hist[tid] = 0u;
            __syncthreads();
            const unsigned prefix = ctl[0];
            for (int i = tid; i < SEQ; i += NTHR) { const unsigned k = keys[i]; if ((k & mask) == prefix) atomicAdd((unsigned*)&hist[(k >> (8 * p)) & 255u], 1u); }
            __syncthreads();
            if (wave == 0) {
                const unsigned need = ctl[1]; const unsigned h0 = hist[4 * lane], h1 = hist[4 * lane + 1], h2 = hist[4 * lane + 2], h3 = hist[4 * lane + 3]; const unsigned loc = (h0 + h1) + (h2 + h3);
                unsigned suf = loc;
#pragma unroll
                for (int o = 1; o < 64; o <<= 1) { const unsigned t = __shfl_down(suf, o); if (lane + o < 64) suf += t; }
                const unsigned above = suf - loc;
                if (above < need && need <= suf) { unsigned cum = above; int bsel;
                    if (cum + h3 >= need) bsel = 4 * lane + 3; else { cum += h3; if (cum + h2 >= need) bsel = 4 * lane + 2; else { cum += h2; if (cum + h1 >= need) bsel = 4 * lane + 1; else { cum += h1; bsel = 4 * lane; } } }
                    ctl[0] = prefix | ((unsigned)bsel << (8 * p)); ctl[1] = need - cum; } }
            mask |= 0xFFu << (8 * p);
            __syncthreads();
        }
        const unsigned Tk = ctl[0], need_eq = ctl[1];
        unsigned cg = 0u, ce = 0u; unsigned kk[16];
#pragma unroll
        for (int q = 0; q < 16; ++q) { kk[q] = keys[tid * 16 + q]; cg += kk[q] > Tk ? 1u : 0u; ce += kk[q] == Tk ? 1u : 0u; }
        unsigned ig = cg, ie = ce;
#pragma unroll
        for (int o = 1; o < 64; o <<= 1) { const unsigned tg = __shfl_up(ig, o), te = __shfl_up(ie, o); if (lane >= o) { ig += tg; ie += te; } }
        if (lane == 63) { wtot[wave] = ig; wtot[8 + wave] = ie; }
        __syncthreads();
        unsigned bg = ig - cg, beq = ie - ce;
        for (int w = 0; w < wave; ++w) { bg += wtot[w]; beq += wtot[8 + w]; }
#pragma unroll
        for (int q = 0; q < 16; ++q) { const unsigned k = kk[q]; const bool gtv = k > Tk, eqv = k == Tk; const bool sel = gtv || (eqv && beq < need_eq);
            if (sel) { const unsigned pos = bg + (beq < need_eq ? beq : need_eq); const int i = tid * 16 + q; const int slot = b * CAP + (int)pos;
                IDX[e * 4096 + slot] = b * SEQ + i; VAL[e * 4096 + slot] = __uint_as_float(k); RSS[e * 4096 + slot] = RSD[b * SEQ + i]; SLOT[(size_t)e * T + b * SEQ + i] = slot; }
            bg += gtv ? 1u : 0u; beq += eqv ? 1u : 0u; }
    }
}

__device__ __forceinline__ void phase_final(Frame& F, KArgs a) {
    const float* g = a->in[23]; const bf16* X3B = (const bf16*)(F.ws + WS_X3B); const int gw = F.bid * 8 + F.wave, NW = F.G * 8, lane = F.lane();
    f32x4 gg[4];
#pragma unroll
    for (int j = 0; j < 4; ++j) gg[j] = ((const f32x4*)g + lane)[64 * j];
    asm volatile("s_waitcnt vmcnt(0)" ::: "memory");
    for (int m0 = gw * 4; m0 < T; m0 += NW * 4) { f32x4 v[4][4];
#pragma unroll
        for (int r = 0; r < 4; ++r)
#pragma unroll
            for (int j = 0; j < 4; ++j) { const u32x2 w = __builtin_nontemporal_load((const u32x2*)(X3B + (size_t)(m0 + r) * DM + 4 * lane + 256 * j)); v[r][j] = (f32x4){__uint_as_float(w.x << 16), __uint_as_float(w.x & 0xffff0000u), __uint_as_float(w.y << 16), __uint_as_float(w.y & 0xffff0000u)}; }
#pragma unroll
        for (int r = 0; r < 4; ++r) { float sq = 0.f; f32x4* xr = (f32x4*)(F.xo + (size_t)(m0 + r) * DM) + lane;
#pragma unroll
            for (int j = 0; j < 4; ++j) sq += (v[r][j].x * v[r][j].x + v[r][j].y * v[r][j].y) + (v[r][j].z * v[r][j].z + v[r][j].w * v[r][j].w);
            const float rstd = 1.0f / sqrtf(wave_sum(sq) * (1.0f / DM) + RMS_EPS);
#pragma unroll
            for (int j = 0; j < 4; ++j) __builtin_nontemporal_store((f32x4){v[r][j].x * rstd * gg[j].x, v[r][j].y * rstd * gg[j].y, v[r][j].z * rstd * gg[j].z, v[r][j].w * rstd * gg[j].w}, xr + 64 * j); }
    }
}


__device__ __forceinline__ void transpose_item(const float* W, int ld, int c0, int k0, bf16* dst, int ldd, LAS float* scr, int lane) {
#pragma unroll 8
    for (int i = 0; i < 32; ++i) { const int kk = 2 * i + (lane >> 5); scr[kk * 33 + (lane & 31)] = W[(size_t)(k0 + kk) * ld + c0 + (lane & 31)]; }
    asm volatile("s_waitcnt vmcnt(0) lgkmcnt(0)" ::: "memory");
    const int c = lane & 7;
#pragma unroll
    for (int j = 0; j < 4; ++j) { const int n = (lane >> 3) + 8 * j; const LAS float* s = scr + (8 * c) * 33 + n;
        u32x4 o; o.x = cvt_pk_bf16(s[0 * 33], s[1 * 33]); o.y = cvt_pk_bf16(s[2 * 33], s[3 * 33]); o.z = cvt_pk_bf16(s[4 * 33], s[5 * 33]); o.w = cvt_pk_bf16(s[6 * 33], s[7 * 33]);
        *(u32x4*)(dst + (size_t)n * ldd + k0 + 8 * c) = o; }
    asm volatile("s_waitcnt lgkmcnt(0)" ::: "memory");
}
__device__ __forceinline__ int kperm_fourier(int p) { const int g = p >> 7, q = p & 127; return g * 128 + (q <= 64 ? q : 192 - q); }
template <bool KMAP>
__device__ __forceinline__ void transpose_item_t(const float* W, int ld, int c0, int k0, bf16* dst, int ldd, LAS float* scr, int lane) {
#pragma unroll 8
    for (int i = 0; i < 32; ++i) { const int kk = 2 * i + (lane >> 5); const int ks = KMAP ? kperm_fourier(k0 + kk) : (k0 + kk); scr[kk * 33 + (lane & 31)] = W[(size_t)ks * ld + c0 + (lane & 31)]; }
    asm volatile("s_waitcnt vmcnt(0) lgkmcnt(0)" ::: "memory");
    const int c = lane & 7;
#pragma unroll
    for (int j = 0; j < 4; ++j) { const int n = (lane >> 3) + 8 * j; const LAS float* s = scr + (8 * c) * 33 + n;
        u32x4 o; o.x = cvt_pk_bf16(s[0 * 33], s[1 * 33]); o.y = cvt_pk_bf16(s[2 * 33], s[3 * 33]); o.z = cvt_pk_bf16(s[4 * 33], s[5 * 33]); o.w = cvt_pk_bf16(s[6 * 33], s[7 * 33]);
        *(u32x4*)(dst + (size_t)n * ldd + k0 + 8 * c) = o; }
    asm volatile("s_waitcnt lgkmcnt(0)" ::: "memory");
}

struct OpTcTab {
    static constexpr bool ROWFAST = false; const LAS float* ct; const LAS float* st;
    __device__ __forceinline__ bf16x8 load8(int pqc, int k0) const { float v[8];
#pragma unroll
        for (int q = 0; q < 8; ++q) { const int c = k0 + q; v[q] = pqc < 64 ? ct[(c * pqc) & 127] : (pqc == 64 ? ((c & 1) ? -1.f : 1.f) : st[(c * (pqc - 64)) & 127]); }
        return pack8((f32x4){v[0], v[1], v[2], v[3]}, (f32x4){v[4], v[5], v[6], v[7]}); }
};
struct EpiBf16Plain { bf16* O; int ld;
    __device__ __forceinline__ void tile(int row, int col, const f32x4 (&acc)[4][2]) const {
#pragma unroll
        for (int m = 0; m < 4; ++m)
#pragma unroll
            for (int n = 0; n < 2; ++n) store_bf16x4(O + (size_t)(row + 16 * m) * ld + col + 16 * n, acc[m][n]);
    }
};
__device__ __forceinline__ void ssm_tables_group(Frame& F, KArgs a, int g, int part) {
    unsigned char* ws = F.ws; const int tid = F.tid();
    LAS f32x2* LB = (LAS f32x2*)(F.lds); LAS f32x2* BBl = (LAS f32x2*)(F.lds + 33280); LAS f32x2* Cl = (LAS f32x2*)(F.lds + 41472);
    LAS bf16* KTb = (LAS bf16*)(F.lds + 49664); LAS float* K0 = (LAS float*)(F.lds + 115200);
    const float* a_re = a->in[5]; const float* a_im = a->in[6]; const float* log_dt = a->in[7]; const float* b_re = a->in[8]; const float* b_im = a->in[9];
    const float* c_re = a->in[10]; const float* c_im = a->in[11]; const float* dvec = a->in[12];
    bf16* WE = (bf16*)(ws + WS_WEND) + (size_t)g * 256 * 1024; bf16* KC = (bf16*)(ws + WS_KC) + (size_t)g * 128 * 256; bf16* CT = (bf16*)(ws + WS_CT) + (size_t)g * 1024 * 256; f32x2* L64 = (f32x2*)(ws + OFF_L64);
    for (int d = 0; d < 2; ++d) {
        const int dg = d * NG + g; const float dt = expf(log_dt[dg]);
        __syncthreads();
        for (int it = tid; it < 64 * 65; it += NTHR) { const int n = it / 65, p = it - n * 65; const float are = a_re[dg * 64 + n], aim = a_im[dg * 64 + n];
            const float mag = expf(are * dt * (float)p); const double tr = (double)aim * (double)dt * (double)p * 0.15915494309189535; const float fr_ = (float)(tr - __builtin_rint(tr));
            float s_, c_; sincospif(2.0f * fr_, &s_, &c_); const f32x2 v = (f32x2){mag * c_, mag * s_}; LB[it] = v; if (p == 64 && part == 0) L64[dg * 64 + n] = v; }
        for (int it = tid; it < 64 * 16; it += NTHR) { const int n = it >> 4; const float are = a_re[dg * 64 + n], aim = a_im[dg * 64 + n];
            const float em1 = expm1f(are * dt), th = aim * dt; float sh, ch, s_, c_; sincosf(0.5f * th, &sh, &ch); sincosf(th, &s_, &c_); (void)ch;
            const float lr = em1 * c_ - 2.0f * sh * sh, li = (1.0f + em1) * s_, den = are * are + aim * aim, qr = (lr * are + li * aim) / den, qi = (li * are - lr * aim) / den;
            const float br = b_re[(size_t)dg * 1024 + it], bi = b_im[(size_t)dg * 1024 + it]; BBl[it] = (f32x2){qr * br - qi * bi, qr * bi + qi * br};
            Cl[it] = (f32x2){c_re[(size_t)dg * 1024 + it], c_im[(size_t)dg * 1024 + it]}; }
        asm volatile("s_waitcnt vmcnt(0)" ::: "memory"); __syncthreads();
        { const int lane = F.lane(), o_a = lane & 15, nq = 4 * (lane >> 4); f32x2 creg[4][4]; bf16x8 bfr[4];
#pragma unroll
          for (int q = 0; q < 4; ++q) { float bv[8];
#pragma unroll
              for (int jj = 0; jj < 4; ++jj) { const int n = 16 * q + nq + jj; creg[q][jj] = Cl[o_a * 64 + n]; const f32x2 b = BBl[n * 16 + (lane & 15)]; bv[2 * jj] = b.x; bv[2 * jj + 1] = b.y; }
              bfr[q] = pack8((f32x4){bv[0], bv[1], bv[2], bv[3]}, (f32x4){bv[4], bv[5], bv[6], bv[7]}); }
          for (int k = F.wave; k < 64; k += 8) { f32x4 acc = (f32x4){0.f, 0.f, 0.f, 0.f};
#pragma unroll
              for (int q = 0; q < 4; ++q) { float av[8];
#pragma unroll
                  for (int jj = 0; jj < 4; ++jj) { const int n = 16 * q + nq + jj; const f32x2 l = LB[n * 65 + k], c = creg[q][jj]; av[2 * jj] = c.x * l.x - c.y * l.y; av[2 * jj + 1] = -(c.x * l.y + c.y * l.x); }
                  acc = __builtin_amdgcn_mfma_f32_16x16x32_bf16(pack8((f32x4){av[0], av[1], av[2], av[3]}, (f32x4){av[4], av[5], av[6], av[7]}), bfr[q], acc, 0, 0, 0); }
#pragma unroll
              for (int r = 0; r < 4; ++r) { const int o = (lane >> 4) * 4 + r, i = lane & 15, oi = o * 16 + i; KTb[(d * 64 + k) * 256 + oi] = (bf16)(cvt_pk_bf16(acc[r], 0.f) & 0xffffu);
                  if (k == 0) { if (d == 0) K0[oi] = acc[r] + (o == i ? dvec[g * 16 + o] : 0.f); else K0[oi] += acc[r]; } } } }
        for (int it = part * 4096 + tid; it < (part + 1) * 4096; it += NTHR) { const int kc = it & 127, rr = it >> 7, n = rr >> 1, ri = rr & 1, j = kc >> 1, i0 = (kc & 1) * 8; const f32x2 l = LB[n * 65 + (d ? j : 63 - j)]; float v[8];
#pragma unroll
            for (int q = 0; q < 8; ++q) { const f32x2 b = BBl[n * 16 + i0 + q]; v[q] = ri ? (l.x * b.y + l.y * b.x) : (l.x * b.x - l.y * b.y); }
            *(bf16x8*)(WE + ((size_t)(d * 128 + rr) * 1024 + kc * 8)) = pack8((f32x4){v[0], v[1], v[2], v[3]}, (f32x4){v[4], v[5], v[6], v[7]}); }
        for (int it = part * 4096 + tid; it < (part + 1) * 4096; it += NTHR) { const int nb = (it & 15) * 4, row = it >> 4, sI = row >> 4, o = row & 15, p = d ? 64 - sI : sI + 1; float v[8];
#pragma unroll
            for (int q = 0; q < 4; ++q) { const f32x2 c = Cl[o * 64 + nb + q], l = LB[(nb + q) * 65 + p]; v[2 * q] = c.x * l.x - c.y * l.y; v[2 * q + 1] = -(c.x * l.y + c.y * l.x); }
            *(bf16x8*)(CT + ((size_t)row * 256 + d * 128 + nb * 2)) = pack8((f32x4){v[0], v[1], v[2], v[3]}, (f32x4){v[4], v[5], v[6], v[7]}); }
    }
    __syncthreads();
    for (int it = part * 1024 + tid; it < (part + 1) * 1024; it += NTHR) { const int L = it >> 5, pc = (it & 31) * 8; bf16x8 w;
        if (L == 127) continue;
        if (L != 63) { const int d = L > 63 ? 0 : 1, lag = L > 63 ? L - 63 : 63 - L; w = *(const LAS bf16x8*)(KTb + (d * 64 + lag) * 256 + pc); }
        else { const LAS float* k0 = K0 + pc; w = pack8((f32x4){k0[0], k0[1], k0[2], k0[3]}, (f32x4){k0[4], k0[5], k0[6], k0[7]}); }
        *(bf16x8*)(KC + (size_t)L * 256 + pc) = w; }
    __syncthreads();
}

__device__ __forceinline__ void transpose_item_fp8(const float* W, const float* gs, int ld, int c0, int k0, unsigned char* dst, int ldd, float scale, LAS float* scr, int lane) {
    { const int r8 = lane >> 3, c4 = (lane & 7) * 4; f32x4 v[8];
#pragma unroll
      for (int i = 0; i < 8; ++i) v[i] = __builtin_nontemporal_load((const f32x4*)(W + (size_t)(k0 + 8 * i + r8) * ld + c0 + c4));
#pragma unroll
      for (int i = 0; i < 8; ++i) { const float gk = gs ? gs[k0 + 8 * i + r8] : 1.0f; LAS float* p = scr + (8 * i + r8) * 33 + c4; p[0] = v[i].x * gk; p[1] = v[i].y * gk; p[2] = v[i].z * gk; p[3] = v[i].w * gk; } }
    asm volatile("s_waitcnt vmcnt(0) lgkmcnt(0)" ::: "memory");
    const int c = lane & 3;
#pragma unroll
    for (int j = 0; j < 2; ++j) { const int n = (lane >> 2) + 16 * j; const LAS float* s = scr + (16 * c) * 33 + n; u32x4 o;
#pragma unroll
        for (int q = 0; q < 4; ++q) { unsigned w8 = 0u; w8 = __builtin_amdgcn_cvt_pk_fp8_f32(clamp8(s[(4 * q) * 33] * scale), clamp8(s[(4 * q + 1) * 33] * scale), w8, false); w8 = __builtin_amdgcn_cvt_pk_fp8_f32(clamp8(s[(4 * q + 2) * 33] * scale), clamp8(s[(4 * q + 3) * 33] * scale), w8, true); o[q] = w8; }
        *(u32x4*)(dst + (size_t)n * ldd + k0 + 16 * c) = o; }
    asm volatile("s_waitcnt lgkmcnt(0)" ::: "memory");
}
__device__ __forceinline__ void transpose_item_rowscale(const float* W, const float* gs, int ld, int c0, int k0, bf16* dst, int ldd, LAS float* scr, int lane) {
#pragma unroll 8
    for (int i = 0; i < 32; ++i) { const int kk = 2 * i + (lane >> 5); scr[kk * 33 + (lane & 31)] = W[(size_t)(k0 + kk) * ld + c0 + (lane & 31)] * gs[k0 + kk]; }
    asm volatile("s_waitcnt vmcnt(0) lgkmcnt(0)" ::: "memory");
    const int c = lane & 7;
#pragma unroll
    for (int j = 0; j < 4; ++j) { const int n = (lane >> 3) + 8 * j; const LAS float* s = scr + (8 * c) * 33 + n;
        u32x4 o; o.x = cvt_pk_bf16(s[0 * 33], s[1 * 33]); o.y = cvt_pk_bf16(s[2 * 33], s[3 * 33]); o.z = cvt_pk_bf16(s[4 * 33], s[5 * 33]); o.w = cvt_pk_bf16(s[6 * 33], s[7 * 33]);
        *(u32x4*)(dst + (size_t)n * ldd + k0 + 8 * c) = o; }
    asm volatile("s_waitcnt lgkmcnt(0)" ::: "memory");
}
__device__ __forceinline__ void phase0(Frame& F, KArgs a, int qword = 2048) {
    const int NBUILD = F.G >= 192 ? 4 * NG : 0; const bool builder = F.bid < NBUILD; const int rb = builder ? 0 : F.bid - NBUILD, RG = F.G - NBUILD;
    const int gt = builder ? (1 << 30) : rb * NTHR + F.tid(), NT = RG * NTHR, gw = builder ? (1 << 30) : rb * 8 + F.wave, NW = RG * 8;
    const float* x = a->in[0]; const float* g_mix = a->in[2]; const float* w_in = a->in[3];
    unsigned char* ws = F.ws;
    LAS float* ct = (LAS float*)(F.lds + 96 * 1024); LAS float* st = ct + 128;
    if (F.tid() < 128) { float s, c; sincospif((float)F.tid() / 64.0f, &s, &c); ct[F.tid()] = c; st[F.tid()] = s; }
    __syncthreads();
    if (NBUILD == 0) { for (int u = F.bid; u < 4 * NG; u += F.G) ssm_tables_group(F, a, u >> 2, u & 3); }
    if (builder) { ssm_tables_group(F, a, F.bid >> 2, F.bid & 3);
        if (F.tid() < 128) { float s, c; sincospif((float)F.tid() / 64.0f, &s, &c); ct[F.tid()] = c; st[F.tid()] = s; }
        __syncthreads(); }
    { const int nb0 = NBUILD, nbw = RG < 32 ? RG : 32;
      if (F.bid >= nb0 && F.bid < nb0 + nbw) for (int t = F.bid - nb0; t < 32; t += nbw) { const int g = t >> 3, n0 = (t & 7) * 128;
          OpTcTab A{ct, st}; OpF32Rows Bo{w_in + g * 128, DIN}; EpiBf16Plain E{(bf16*)(ws + OFF_WFT) + (size_t)g * 128 * 1024, 1024};
          gg_tile(F.lds, A, Bo, E, 0, n0, 128, F.wave); }
      __syncthreads(); }
    { bf16* D1 = (bf16*)(ws + OFF_DFT1);
      for (int it = gt; it < 256 * 128; it += NT) { const int r = it >> 7, n1 = it & 127, ri = r >> 7, k1 = r & 127; const int m = (n1 * k1) & 127;
          const float v = ri ? -st[m] : ct[m]; D1[it] = (bf16)(cvt_pk_bf16(v, 0.f) & 0xffffu); } }
    { bf16* D2 = (bf16*)(ws + OFF_DFT2);
      for (int it = gt; it < 256 * 128; it += NT) { const int k2 = it >> 7, kk = it & 127, ri = kk >> 6, n2 = kk & 63; const int m = ((n2 * k2) & 63) * 2;
          const float v = k2 < 64 ? (ri ? st[m] : ct[m]) * (1.0f / 1024.0f) : 0.f; D2[it] = (bf16)(cvt_pk_bf16(v, 0.f) & 0xffffu); } }
    { f32x2* TW = (f32x2*)(ws + OFF_TW);
      for (int it = gt; it < 8192; it += NT) { float s, c; sincospif((float)it / 4096.0f, &s, &c); TW[it] = (f32x2){c, s}; } }
    { int* SL = (int*)(ws + OFF_SLOT); for (int it = gt; it < T * NE; it += NT) SL[it] = -1; }
    { float* WG = (float*)(ws + OFF_WGT); const float* gf = a->in[15]; const float* wrt = a->in[16]; for (int it = gt; it < NE * DM; it += NT) { const int e = it >> 10, d = it & 1023; WG[it] = gf[d] * wrt[d * NE + e]; } }
    { LAS float* scr = (LAS float*)(F.lds + F.wave * 8704);
      constexpr int I_WB = (DM / 64) * (2560 / 32), I_GLU = (512 / 64) * (2048 / 32), I_WF = (512 / 64) * (DM / 32), I_SQ = (DM / 64) * (DM / 32), I_PP = (PLE / 64) * (DM / 32);
      constexpr int NITEMS = I_WB + I_GLU + I_WF + 2 * I_SQ + I_PP;
      for (int it = gw; it < NITEMS; it += NW) { int r = it;
          if (r < I_WB) { const int nb = r % 80, kb = r / 80; transpose_item(w_in, DIN, 512 + nb * 32, kb * 64, (bf16*)(ws + OFF_WB) + (size_t)nb * 32 * DM, DM, scr, F.lane()); continue; } r -= I_WB;
          if (r < I_GLU) { const int nb = r % 64, kb = r / 64;
              const int n0 = nb * 32, pn = n0 >> 8, bj = (n0 >> 7) & 1, xx = n0 & 127; transpose_item(a->in[13], 2048, bj * 1024 + pn * 128 + xx, kb * 64, (bf16*)(ws + OFF_WGLU) + (size_t)n0 * 512, 512, scr, F.lane()); continue; } r -= I_GLU;
          if (r < I_WF) { const int nb = r % 32, kb = r / 32; transpose_item_t<true>(a->in[4], DM, nb * 32, kb * 64, (bf16*)(ws + OFF_WF) + (size_t)nb * 32 * 512, 512, scr, F.lane()); continue; } r -= I_WF;
          if (r < I_SQ) { const int nb = r % 32, kb = r / 32; transpose_item(a->in[14], DM, nb * 32, kb * 64, (bf16*)(ws + OFF_WOUT) + (size_t)nb * 32 * DM, DM, scr, F.lane()); continue; } r -= I_SQ;
          if (r < I_SQ) { const int nb = r % 32, kb = r / 32; transpose_item_fp8(a->in[21], a->in[20], DM, nb * 32, kb * 64, ws + OFF_WPG + (size_t)nb * 32 * DM, DM, 64.0f, scr, F.lane()); continue; } r -= I_SQ;
          { const int nb = r % 32, kb = r / 32; transpose_item(a->in[22], DM, nb * 32, kb * 64, (bf16*)(ws + OFF_WPP) + (size_t)nb * 32 * PLE, PLE, scr, F.lane()); }
      } }
    { bf16* H = (bf16*)(ws + WS_H); unsigned* q = (unsigned*)(ws + WS_CTL) + qword; const int lane = F.lane(); const float* pin = a->in[1];
      f32x4 gg[4];
#pragma unroll
      for (int j = 0; j < 4; ++j) gg[j] = ((const f32x4*)g_mix + lane)[64 * j];
      for (;;) { unsigned r0 = 0; if (lane == 0) r0 = __hip_atomic_fetch_add(q, 16u, __ATOMIC_RELAXED, __HIP_MEMORY_SCOPE_AGENT); r0 = __builtin_amdgcn_readfirstlane(r0); if (r0 >= (unsigned)T) break;
          for (int m0 = (int)r0; m0 < (int)r0 + 16; m0 += 4) { f32x4 v[4][4], pv[4];
#pragma unroll
              for (int r = 0; r < 4; ++r) {
#pragma unroll
                  for (int j = 0; j < 4; ++j) v[r][j] = __builtin_nontemporal_load((const f32x4*)(x + (size_t)(m0 + r) * DM) + lane + 64 * j);
                  pv[r] = __builtin_nontemporal_load((const f32x4*)(pin + (size_t)(m0 + r) * PLE) + lane); }
#pragma unroll
              for (int r = 0; r < 4; ++r) { float sq = 0.f;
#pragma unroll
                  for (int j = 0; j < 4; ++j) sq += (v[r][j].x * v[r][j].x + v[r][j].y * v[r][j].y) + (v[r][j].z * v[r][j].z + v[r][j].w * v[r][j].w);
                  const float rstd = 1.0f / sqrtf(wave_sum(sq) * (1.0f / DM) + RMS_EPS);
#pragma unroll
                  for (int j = 0; j < 4; ++j) store_bf16x4(H + (size_t)(m0 + r) * DM + 4 * lane + 256 * j, (f32x4){v[r][j].x * rstd * gg[j].x, v[r][j].y * rstd * gg[j].y, v[r][j].z * rstd * gg[j].z, v[r][j].w * rstd * gg[j].w});
                  store_bf16x4((bf16*)(ws + WS_PB) + (size_t)(m0 + r) * PLE + 4 * lane, pv[r]); } } } }
}

__device__ __forceinline__ void phase_gemm1(Frame& F, KArgs a) {
    unsigned char* ws = F.ws; const bf16* H = (const bf16*)(ws + WS_H);
    { pg8::PolG1a P{(const bf16*)(ws + OFF_WFT), H, DM}; pg8::StaticOrder S; S.init(512, T, F.G, F.bid); pg8::EpiXt E{(bf16*)(ws + WS_XT)};
      pg8::gemm_phase(F.lds, P, S, E, F.wave); }
    { pg8::PolPlain P{H, (const bf16*)(ws + OFF_WB), DM, DM, DM}; pg8::StaticOrder S; S.init(T, 2560, F.G, F.bid); pg8::EpiG1b E{(bf16*)(ws + WS_ACAT), ws + WS_GF, ws + WS_GS};
      pg8::gemm_phase(F.lds, P, S, E, F.wave); }
}
__device__ __forceinline__ void phase_stageA(Frame& F, KArgs a) {
    unsigned char* ws = F.ws;
    { pg8::PolPlain P{(const bf16*)(ws + OFF_DFT1), (const bf16*)(ws + WS_XT), 128, 128, 128}; pg8::LinearOrder S; S.init(1, 131072 / 256, F.G, F.bid); pg8::EpiStageA E{(bf16*)(ws + WS_Y), (const f32x2*)(ws + OFF_TW)};
      pg8::gemm_phase(F.lds, P, S, E, F.wave); }
    { const int ntm = 4, ntn = 2;
      for (int t = F.bid; t < NG * ntm * ntn; t += F.G) { int g = t / (ntm * ntn), tt = t % (ntm * ntn);
          if (F.G == 256) { g = (t & 7) * 4 + (t >> 6); tt = (t >> 3) & 7; }
          OpBf16Rows A{(const bf16*)(ws + WS_ACAT) + (size_t)g * NROWC * KCAT, KCAT}; OpBf16Rows Bo{(const bf16*)(ws + WS_WEND) + (size_t)g * 256 * 1024, 1024};
          EpiF32Plain E{(float*)(ws + WS_EE) + (size_t)g * NROWC * 256, 256};
          gg_tile(F.lds, A, Bo, E, (tt % ntm) * 128, (tt / ntm) * 128, 1024, F.wave); } }
}
__device__ __forceinline__ void phase_stageC(Frame& F, KArgs a) {
    unsigned char* ws = F.ws;
    { pg8::PolStageC P{(const bf16*)(ws + OFF_DFT2), (const bf16*)(ws + WS_Y), 128}; pg8::LinearOrder S; S.init(1, 1024, F.G, F.bid); pg8::EpiStageC E{(bf16*)(ws + WS_FMIX)};
      pg8::gemm_phase(F.lds, P, S, E, F.wave); }
    { const float* EE = (const float*)(ws + WS_EE); bf16* ACAT = (bf16*)(ws + WS_ACAT); const f32x2* L64 = (const f32x2*)(ws + OFF_L64);
      if (F.G == 256) {
          const int b = F.bid >> 6, g = (F.bid >> 1) & 31, d = F.bid & 1, tid = F.tid(), lane = F.lane(); f32x4 v[8];
          __syncthreads();
#pragma unroll
          for (int k = 0; k < 8; ++k) { const int p = tid + NTHR * k, c = p >> 5, j = p & 31; v[k] = *(const f32x4*)(EE + ((size_t)g * NROWC + b * NCH + c) * 256 + d * 128 + j * 4); }
          asm volatile("s_waitcnt vmcnt(0)" ::: "memory");
#pragma unroll
          for (int k = 0; k < 8; ++k) *(LAS f32x4*)(F.lds + (size_t)(tid + NTHR * k) * 16) = v[k];
          __syncthreads();
          if (F.wave == 0) { const LAS f32x2* es = (const LAS f32x2*)F.lds; const f32x2 l64 = L64[(d * NG + g) * 64 + lane]; float cr = 0.f, ci = 0.f;
              for (int s0 = 0; s0 < NCH; s0 += 16) { f32x2 e[16];
#pragma unroll
                  for (int q = 0; q < 16; ++q) { const int c = d ? (NCH - 1 - s0 - q) : (s0 + q); e[q] = es[c * 64 + lane]; }
#pragma unroll
                  for (int q = 0; q < 16; ++q) { const int c = d ? (NCH - 1 - s0 - q) : (s0 + q); const size_t row = (size_t)g * NROWC + b * NCH + c;
                      *(unsigned*)(ACAT + row * KCAT + 1024 + d * 128 + lane * 2) = cvt_pk_bf16(cr, ci);
                      const float nr = l64.x * cr - l64.y * ci + e[q].x, ni = l64.x * ci + l64.y * cr + e[q].y; cr = nr; ci = ni; } } }
          __syncthreads();
      } else {
      const int gt = F.bid * NTHR + F.tid(), NT = F.G * NTHR;
      for (int it = gt; it < NB * NG * 2 * NS; it += NT) { const int n = it & 63, d = (it >> 6) & 1, g = (it >> 7) & 31, b = it >> 12;
          const f32x2 l64 = L64[(d * NG + g) * 64 + n]; float cr = 0.f, ci = 0.f;
          for (int s0 = 0; s0 < NCH; s0 += 16) { f32x2 e[16];
#pragma unroll
              for (int q = 0; q < 16; ++q) { const int c = d ? (NCH - 1 - s0 - q) : (s0 + q); e[q] = *(const f32x2*)(EE + ((size_t)g * NROWC + b * NCH + c) * 256 + d * 128 + n * 2); }
              asm volatile("s_waitcnt vmcnt(0)" ::: "memory");
#pragma unroll
              for (int q = 0; q < 16; ++q) { const int c = d ? (NCH - 1 - s0 - q) : (s0 + q); const size_t row = (size_t)g * NROWC + b * NCH + c;
                  *(unsigned*)(ACAT + row * KCAT + 1024 + d * 128 + n * 2) = cvt_pk_bf16(cr, ci);
                  const float nr = l64.x * cr - l64.y * ci + e[q].x, ni = l64.x * ci + l64.y * cr + e[q].y; cr = nr; ci = ni; } } } } }
}
__device__ __forceinline__ void phase_passB(Frame& F, KArgs a) {
    unsigned char* ws = F.ws;
    { pg8::PolPassB2 P{(const bf16*)(ws + WS_ACAT), (const bf16*)(ws + WS_KC), (const bf16*)(ws + WS_CT), KCAT}; pg8::LinearOrder S; S.init(NG * 2, 4, F.G, F.bid); pg8::EpiPassB E{(bf16*)(ws + WS_YS)};
      pg8::gemm_phase(F.lds, P, S, E, F.wave); }
    { pg8::PolPlain P{(const bf16*)(ws + WS_FMIX), (const bf16*)(ws + OFF_WF), 512, 512, 512}; pg8::StaticOrder S; S.init(T, DM, F.G, F.bid); pg8::EpiMulGate E{(bf16*)(ws + WS_MIXF), ws + WS_GF};
      pg8::gemm_phase(F.lds, P, S, E, F.wave); }
}
__device__ __forceinline__ void phase_glu(Frame& F, KArgs a) {
    unsigned char* ws = F.ws;
    pg8::PolPlain P{(const bf16*)(ws + WS_YS), (const bf16*)(ws + OFF_WGLU), 512, 512, 512}; pg8::StaticOrder S; S.init(T, 2048, F.G, F.bid); pg8::EpiGlu E{(bf16*)(ws + WS_MIX), ws + WS_GS};
    pg8::gemm_phase(F.lds, P, S, E, F.wave);
}
__device__ __forceinline__ void phase_wout(Frame& F, KArgs a) {
    unsigned char* ws = F.ws;
    pg8::PolPlain P{(const bf16*)(ws + WS_MIX), (const bf16*)(ws + OFF_WOUT), DM, DM, DM}; pg8::StaticOrder S; S.init(T, DM, F.G, F.bid); pg8::EpiResidual E{F.xo, a->in[0]};
    pg8::gemm_phase(F.lds, P, S, E, F.wave);
}
__device__ __forceinline__ void phase_expert_weights(Frame& F, KArgs a) {
    unsigned char* ws = F.ws; LAS float* scr = (LAS float*)(F.lds + 40 * 1024 + F.wave * 8704); const int gw = F.bid * 8 + F.wave, NW = F.G * 8;
    constexpr int I_GU = NE * 2 * (DM / 64) * (DE / 32), I_D = NE * (DE / 64) * (DM / 32);
    for (int it = gw; it < I_GU + I_D; it += NW) {
        if (it < I_GU) { const int nb = it % 88, kb = (it / 88) % 16, bj = (it / (88 * 16)) & 1, e = it / (88 * 16 * 2);
            const int f0 = nb * 32, tq = f0 >> 7, xx = f0 & 127; const float* W = (bj ? a->in[18] : a->in[17]) + (size_t)e * DM * DE;
            transpose_item_fp8(W, a->in[15], DE, f0, kb * 64, ws + WS_WGU + ((size_t)e * (2 * DE) + tq * 256 + bj * 128 + xx) * DM, DM, 64.0f, scr, F.lane()); }
        else { const int r = it - I_GU, nb = r % 32, kb = (r / 32) % 44, e = r / (32 * 44);
            transpose_item_fp8(a->in[19] + (size_t)e * DE * DM, nullptr, DM, nb * 32, kb * 64, ws + WS_WD + ((size_t)e * DM + nb * 32) * DE, DE, 64.0f, scr, F.lane()); }
    }
}
__device__ __forceinline__ void phase_eproj(Frame& F, KArgs a, int G2, int c2) {
    unsigned char* ws = F.ws; (void)a;
    pg8::PolPlain P{(const bf16*)(ws + WS_PB), (const bf16*)(ws + OFF_WPP), PLE, PLE, PLE}; pg8::StaticOrder S; S.init(T, DM, G2, c2); pg8::EpiBf16 E{(bf16*)(ws + WS_EB), DM};
    pg8::gemm_phase(F.lds, P, S, E, F.wave);
}
__device__ __forceinline__ void phase_exp_up(Frame& F, KArgs a) {
    unsigned char* ws = F.ws;
    pg8::PolExpUp8 P{ws + WS_H, (const int*)(ws + OFF_IDX), ws + WS_WGU, DM / 2}; pg8::ExpertOrder S; S.init(2 * DE / 256, F.G, F.bid); pg8::EpiSwiglu E{ws + WS_HID, (const float*)(ws + OFF_RSS), 1.0f / 64.0f, 8.0f};
    pg8::gemm_phase(F.lds, P, S, E, F.wave);
}
__device__ __forceinline__ void phase_exp_down(Frame& F, KArgs a) {
    unsigned char* ws = F.ws;

    pg8::PolExpDown8 P{ws + WS_HID, ws + WS_WD, DE / 2}; pg8::ExpertOrder S; S.init(DM / 256, F.G, F.bid); pg8::EpiScaleRows E{(bf16*)(ws + WS_YB), (const float*)(ws + OFF_VAL), 1.0f / 512.0f};
    pg8::gemm_phase(F.lds, P, S, E, F.wave);
}
__device__ __forceinline__ void phase_combine(Frame& F, KArgs a) {
    unsigned char* ws = F.ws; float* RST = (float*)(ws + OFF_RST); bf16* X2B = (bf16*)(ws + WS_X2B); unsigned char* X2F = ws + WS_X2F; const bf16* YB = (const bf16*)(ws + WS_YB); const int* SLOT = (const int*)(ws + OFF_SLOT);
    const int gw = F.bid * 8 + F.wave, NW = F.G * 8, lane = F.lane();
    for (int m0 = gw * 4; m0 < T; m0 += NW * 4) {
        const int myslot = SLOT[(size_t)(lane & 15) * T + m0 + (lane >> 4)];
        f32x4 v[4][4];
#pragma unroll
        for (int r = 0; r < 4; ++r)
#pragma unroll
            for (int j = 0; j < 4; ++j) v[r][j] = __builtin_nontemporal_load((const f32x4*)(F.xo + (size_t)(m0 + r) * DM) + lane + 64 * j);
        asm volatile("s_waitcnt vmcnt(0)" ::: "memory");
        unsigned long long mk = __ballot(myslot >= 0); unsigned msk[4];
#pragma unroll
        for (int r = 0; r < 4; ++r) msk[r] = (unsigned)(mk >> (16 * r)) & 0xffffu;
        while ((msk[0] | msk[1] | msk[2] | msk[3]) != 0u) { u32x2 y[4][4]; bool act[4];
#pragma unroll
            for (int r = 0; r < 4; ++r) { act[r] = msk[r] != 0u; if (act[r]) { const int e = __builtin_ctz(msk[r]); msk[r] &= msk[r] - 1u; const int sl = __shfl(myslot, 16 * r + e);
                    const bf16* yr = YB + ((size_t)e * 4096 + sl) * DM + 4 * lane;
#pragma unroll
                    for (int j = 0; j < 4; ++j) y[r][j] = __builtin_nontemporal_load((const u32x2*)(yr + 256 * j)); } }
            asm volatile("s_waitcnt vmcnt(0)" ::: "memory");
#pragma unroll
            for (int r = 0; r < 4; ++r) if (act[r]) {
#pragma unroll
                for (int j = 0; j < 4; ++j) { const u32x2 w = y[r][j]; v[r][j] += (f32x4){__uint_as_float(w.x << 16), __uint_as_float(w.x & 0xffff0000u), __uint_as_float(w.y << 16), __uint_as_float(w.y & 0xffff0000u)}; } }
        }
#pragma unroll
        for (int r = 0; r < 4; ++r) { float sq = 0.f;
#pragma unroll
            for (int j = 0; j < 4; ++j) { store_bf16x4(X2B + (size_t)(m0 + r) * DM + 4 * lane + 256 * j, v[r][j]);
                { unsigned w8 = 0u; w8 = __builtin_amdgcn_cvt_pk_fp8_f32(clamp8(v[r][j].x), clamp8(v[r][j].y), w8, false); w8 = __builtin_amdgcn_cvt_pk_fp8_f32(clamp8(v[r][j].z), clamp8(v[r][j].w), w8, true); *(unsigned*)(X2F + (size_t)(m0 + r) * DM + 4 * lane + 256 * j) = w8; }
                sq += (v[r][j].x * v[r][j].x + v[r][j].y * v[r][j].y) + (v[r][j].z * v[r][j].z + v[r][j].w * v[r][j].w); }
            const float rstd = 1.0f / sqrtf(wave_sum(sq) * (1.0f / DM) + RMS_EPS);
            if (lane == 0) RST[m0 + r] = rstd; }
    }
}
__device__ __forceinline__ void phase_ple(Frame& F, KArgs a) {
    unsigned char* ws = F.ws;
    pg8::PolPlain8 P{ws + WS_X2F, ws + OFF_WPG, DM, DM, DM / 2}; pg8::StaticOrder S; S.init(T, DM, F.G, F.bid); pg8::EpiPle E{(const bf16*)(ws + WS_X2B), (bf16*)(ws + WS_X3B), (const bf16*)(ws + WS_EB), (const float*)(ws + OFF_RST), 1.0f / 64.0f};
    pg8::gemm_phase(F.lds, P, S, E, F.wave);
}

constexpr int LDS_BYTES = 147456;
constexpr int LDS_MISC = 140 * 1024;
__global__ void __launch_bounds__(NTHR, 2) mk_fwd(Args args) {
    extern __shared__ __attribute__((aligned(16))) unsigned char lds_raw[];
    Frame F; F.lds = (LAS unsigned char*)lds_raw; F.wave = __builtin_amdgcn_readfirstlane((int)threadIdx.x >> 6); F.G = gridDim.x; F.bid = blockIdx.x;
    const KArgs kp = (KArgs)__builtin_amdgcn_kernarg_segment_ptr();
    F.ws = args.ws; F.xo = args.out;
    volatile LAS unsigned* MISC = (volatile LAS unsigned*)(F.lds + LDS_MISC);
    { const int t0 = F.tid(); if (t0 < 64) MISC[t0] = 0u; }
    __syncthreads();
    XcdBarrier bar; bar.bar = (unsigned*)(args.ws + WS_CTL) + 4096; bar.x = 0; bar.st = nullptr; bar.wave = F.wave;
    if (MK_N_LAUNCHES == 1) bar = xcd_barrier_post((unsigned*)(args.ws + WS_CTL) + 4096, MISC + 8, F.wave);
    const int lo = args.ph_lo, hi = args.ph_hi;
#define IN(k) (lo <= (k) && (k) < hi)
    auto kpl = [&]() -> KArgs { KArgs p = kp; asm volatile("" : "+s"(p)); return p; };
#define SEAM(k) do { if (lo <= (k) && (k) + 1 < hi) xcd_barrier(bar); } while (0)
    if (IN(0))  { phase0(F, kpl());
    }         SEAM(0);
    if (IN(2))  { phase_gemm1(F, kpl()); }    SEAM(2);
    if (IN(3))  { phase_stageA(F, kpl()); }   SEAM(3);
    if (IN(4))  { phase_stageC(F, kpl()); }   SEAM(4);
    if (IN(5))  { phase_passB(F, kpl()); }    SEAM(5);
    if (IN(6))  { phase_glu(F, kpl()); }      SEAM(6);
    if (IN(7))  { phase_wout(F, kpl()); }     SEAM(7);
    if (IN(8))  { phase_router(F, kpl()); }   SEAM(8);
    if (IN(9))  { if (F.G == 256) { if (F.bid < NB * NE) phase_topk(F, kpl()); else phase_eproj(F, kpl(), 192, F.bid - NB * NE); } else { phase_topk(F, kpl()); __syncthreads(); phase_eproj(F, kpl(), F.G, F.bid); }
                  __syncthreads(); phase_expert_weights(F, kpl()); } SEAM(9);
    if (IN(10)) { phase_exp_up(F, kpl()); }   SEAM(10);
    if (IN(11)) { phase_exp_down(F, kpl()); } SEAM(11);
    if (IN(12)) { phase_combine(F, kpl()); }  SEAM(12);
    if (IN(13)) { phase_ple(F, kpl()); }      SEAM(13);
    if (IN(14)) { phase_final(F, kpl()); }
#undef IN
#undef SEAM
}

extern "C" void kernel_launch(void* const* d_in, const int* in_sizes, int n_in, void* d_out, int out_size, void* d_ws, size_t ws_size, hipStream_t stream) {
    static int grid = 0;
    if (grid == 0) {
        if (n_in != 24 || out_size != T * DM || ws_size < WS_END) { fprintf(stderr, "kernel_launch: unexpected shapes (n_in %d out %d ws %zu need %zu)\n", n_in, out_size, ws_size, (size_t)WS_END); grid = -1; return; }
        int dev = 0, cus = 0, per_cu = 0;
        if (hipGetDevice(&dev) != hipSuccess || hipDeviceGetAttribute(&cus, hipDeviceAttributeMultiprocessorCount, dev) != hipSuccess) { grid = -1; return; }
        if (hipFuncSetAttribute((const void*)mk_fwd, hipFuncAttributeMaxDynamicSharedMemorySize, LDS_BYTES) != hipSuccess) { fprintf(stderr, "kernel_launch: hipFuncSetAttribute failed\n"); grid = -1; return; }
        if (hipOccupancyMaxActiveBlocksPerMultiprocessor(&per_cu, (const void*)mk_fwd, NTHR, LDS_BYTES) != hipSuccess || per_cu < 1) { fprintf(stderr, "kernel_launch: occupancy query says %d\n", per_cu); (void)hipGetLastError(); grid = -1; return; }
        grid = cus;
    }
    if (grid < 0) return;
    (void)hipMemsetAsync((char*)d_ws + WS_CTL, 0, CTL_BYTES, stream);
    Args a{};
    for (int i = 0; i < 24; ++i) a.in[i] = (const float*)d_in[i];
    a.out = (float*)d_out; a.ws = (unsigned char*)d_ws;
    if (MK_N_LAUNCHES == 1) { a.ph_lo = 0; a.ph_hi = NPH; hipLaunchKernelGGL(mk_fwd, dim3(grid), dim3(NTHR), LDS_BYTES, stream, a); }
    else for (int p = 0; p < NPH; ++p) { a.ph_lo = p; a.ph_hi = p + 1; hipLaunchKernelGGL(mk_fwd, dim3(grid), dim3(NTHR), LDS_BYTES, stream, a); }
}
```

```cpp
#include <hip/hip_runtime.h>
#include <cstdint>
#include <cstdio>

#ifndef MK_N_LAUNCHES
#define MK_N_LAUNCHES 1
#endif

#define LAS __attribute__((address_space(3)))
#define GAS __attribute__((address_space(1)))
typedef unsigned short bf16;
typedef short bf16x8 __attribute__((ext_vector_type(8)));
typedef float f32x4 __attribute__((ext_vector_type(4)));
typedef float f32x2 __attribute__((ext_vector_type(2)));
typedef unsigned u32x2 __attribute__((ext_vector_type(2)));
typedef unsigned u32x4 __attribute__((ext_vector_type(4)));
typedef GAS unsigned gu32;

constexpr int NB = 4, SEQ = 8192, T = NB * SEQ, DM = 1024, DIN = 3072, NE = 16, DE = 2816, CAP = 1024, PLE = 256;
constexpr int NG = 32, NS = 64, LCH = 64, NCH = SEQ / LCH, NROWC = NB * NCH, KCAT = 1280;
constexpr float RMS_EPS = 1e-6f;
constexpr int NPH = 15;
constexpr int NTHR = 512;

constexpr size_t MiB = 1u << 20;
constexpr size_t WS_CTL = 0, CTL_BYTES = 1 * MiB;
constexpr size_t OFF_WFT = 1 * MiB;
constexpr size_t OFF_DFT1 = OFF_WFT + 1 * MiB;
constexpr size_t OFF_DFT2 = OFF_DFT1 + 64 * 1024;
constexpr size_t OFF_TW = OFF_DFT2 + 64 * 1024;
constexpr size_t OFF_L64 = OFF_TW + 64 * 1024;
constexpr size_t OFF_WGT = OFF_L64 + 64 * 1024;
constexpr size_t OFF_AFF = OFF_WGT + 64 * 1024;
constexpr size_t OFF_IDX = OFF_AFF + 2 * MiB;
constexpr size_t OFF_VAL = OFF_IDX + 256 * 1024;
constexpr size_t OFF_SLOT = OFF_VAL + 256 * 1024;
constexpr size_t OFF_RST = OFF_SLOT + 2 * MiB;
constexpr size_t OFF_RSD = OFF_RST + 128 * 1024;
constexpr size_t OFF_RSS = OFF_RSD + 128 * 1024;
static_assert(OFF_RSS + 256 * 1024 <= 16 * MiB, "small region");
constexpr size_t OFF_WB = 16 * MiB;
constexpr size_t OFF_WGLU = OFF_WB + 5 * MiB;
constexpr size_t OFF_WF = OFF_WGLU + 2 * MiB;
constexpr size_t OFF_WOUT = OFF_WF + 1 * MiB;
constexpr size_t OFF_WPG = OFF_WOUT + 2 * MiB;
constexpr size_t OFF_WPP = OFF_WPG + 2 * MiB;
constexpr size_t WS_H = 32 * MiB;
constexpr size_t WS_R = 96 * MiB;
constexpr size_t WS_GF = WS_R, WS_GS = WS_R + 32 * MiB;
constexpr size_t WS_MIXF = WS_R + 64 * MiB, WS_MIX = WS_MIXF;
constexpr size_t WS_XT = WS_R + 128 * MiB, WS_Y = WS_R + 160 * MiB, WS_FMIX = WS_R + 224 * MiB,
                 WS_ACAT = WS_R + 256 * MiB, WS_YS = WS_R + 296 * MiB, WS_EE = WS_R + 328 * MiB;
constexpr size_t WS_KC = WS_R + 352 * MiB;
constexpr size_t WS_CT = WS_R + 356 * MiB;
constexpr size_t WS_WEND = WS_R + 432 * MiB;
constexpr size_t WS_HID = WS_R;
constexpr size_t WS_WGU = WS_R + 352 * MiB;
constexpr size_t WS_WD = WS_R + 528 * MiB;
constexpr size_t WS_YB = WS_WGU;
constexpr size_t WS_PB = WS_R + 496 * MiB;
constexpr size_t WS_X2B = WS_R + 64 * MiB;
constexpr size_t WS_X2F = WS_R + 256 * MiB;
constexpr size_t WS_X3B = WS_R + 128 * MiB;
constexpr size_t WS_EB = WS_R + 192 * MiB;
constexpr size_t WS_END = WS_R + 616 * MiB;
static_assert(OFF_SLOT + 2 * MiB <= OFF_WB && OFF_WPP + 1 * MiB <= WS_H && WS_EE + 16 * MiB <= WS_WGU && WS_PB >= WS_YB + 128 * MiB && WS_PB + 16 * MiB <= WS_WD && WS_EB >= WS_HID + 176 * MiB && WS_EB + 64 * MiB <= WS_WGU, "ws map");

typedef __bf16 bf16v2_t __attribute__((ext_vector_type(2)));
__device__ __forceinline__ unsigned cvt_pk_bf16(float lo, float hi) { const bf16v2_t v = __builtin_convertvector((f32x2){lo, hi}, bf16v2_t); return __builtin_bit_cast(unsigned, v); }
__device__ __forceinline__ float clamp8(float v) { return fminf(fmaxf(v, -440.0f), 440.0f); }
__device__ __forceinline__ float bf2f(unsigned short h) { return __uint_as_float(((unsigned)h) << 16); }
__device__ __forceinline__ float sigmoidf_(float x) { return __builtin_amdgcn_rcpf(1.0f + __expf(-x)); }
__device__ __forceinline__ float gelu_tanh(float x) { const float u = 0.7978845608028654f * (x + 0.044715f * x * x * x); return x * __builtin_amdgcn_rcpf(1.0f + __expf(-2.0f * u)); }
__device__ __forceinline__ float wave_sum(float v) {
    v += __int_as_float(__builtin_amdgcn_update_dpp(0, __float_as_int(v), 0xB1, 0xf, 0xf, true));
    v += __int_as_float(__builtin_amdgcn_update_dpp(0, __float_as_int(v), 0x4E, 0xf, 0xf, true));
    v += __int_as_float(__builtin_amdgcn_update_dpp(0, __float_as_int(v), 0x141, 0xf, 0xf, true));
    v += __int_as_float(__builtin_amdgcn_update_dpp(0, __float_as_int(v), 0x140, 0xf, 0xf, true));
    { const auto s = __builtin_amdgcn_permlane16_swap(__float_as_uint(v), __float_as_uint(v), false, false); v = __uint_as_float(s[0]) + __uint_as_float(s[1]); }
    { const auto t = __builtin_amdgcn_permlane32_swap(__float_as_uint(v), __float_as_uint(v), false, false); v = __uint_as_float(t[0]) + __uint_as_float(t[1]); }
    return v;
}
__device__ __forceinline__ bf16x8 pack8(const f32x4 a, const f32x4 b) {
    u32x4 w; w.x = cvt_pk_bf16(a.x, a.y); w.y = cvt_pk_bf16(a.z, a.w); w.z = cvt_pk_bf16(b.x, b.y); w.w = cvt_pk_bf16(b.z, b.w);
    return __builtin_bit_cast(bf16x8, w);
}
__device__ __forceinline__ void store_bf16x4(bf16* p, const f32x4 v) { u32x2 w; w.x = cvt_pk_bf16(v.x, v.y); w.y = cvt_pk_bf16(v.z, v.w); *(u32x2*)p = w; }
__device__ __forceinline__ f32x4 load_bf16x4(const bf16* p) { const u32x2 w = *(const u32x2*)p; f32x4 r; r.x = __uint_as_float(w.x << 16); r.y = __uint_as_float(w.x & 0xffff0000u); r.z = __uint_as_float(w.y << 16); r.w = __uint_as_float(w.y & 0xffff0000u); return r; }

__device__ __forceinline__ int lane_id_here() { unsigned z = 0u; asm volatile("" : "+v"(z)); return (int)__builtin_amdgcn_mbcnt_hi(~0u, __builtin_amdgcn_mbcnt_lo(~0u, z)); }
#define XB_TMO      128
#define XB_XCNT(j)  (256  + 64 * (j))
#define XB_XSUB(j)  (1280 + 64 * (j))
#define XB_XGEN(j)  (2304 + 64 * (j))
#define XB_TOP      3328
#define XB_TOPGEN   3392
#define XCD_BAR_WORDS 3456
#define XB_SPIN_CAP (1u << 22)
__device__ __forceinline__ unsigned xb_ld(unsigned* p)              { return __hip_atomic_load(p, __ATOMIC_RELAXED, __HIP_MEMORY_SCOPE_AGENT); }
__device__ __forceinline__ unsigned xb_add(unsigned* p, unsigned v) { return __hip_atomic_fetch_add(p, v, __ATOMIC_RELAXED, __HIP_MEMORY_SCOPE_AGENT); }
__device__ __forceinline__ unsigned xb_xcc_id() { return (unsigned)__builtin_amdgcn_s_getreg((3 << 11) | 20) & 0xFu; }
#define XB_SPIN(cond, bar) do { unsigned _sp = 0; while (cond) { __builtin_amdgcn_s_sleep(1); \
    if ((++_sp & 255u) == 0u) { if (xb_ld(&(bar)[XB_TMO])) break; if (_sp > XB_SPIN_CAP) { atomicAdd(&(bar)[XB_TMO], 1u); break; } } } } while (0)
struct XcdBarrier { unsigned* bar; unsigned x; volatile LAS unsigned* st; int wave; };
__device__ __forceinline__ XcdBarrier xcd_barrier_post(unsigned* bar, volatile LAS unsigned* st, int wave) {
    XcdBarrier b; b.bar = bar; b.x = xb_xcc_id(); b.st = st; b.wave = wave;
    if (wave == 0 && lane_id_here() == 0) (void)xb_add(&bar[XB_XCNT(b.x)], 1u);
    return b;
}
__device__ __forceinline__ void xcd_barrier_complete(unsigned* bar, unsigned x, unsigned& nloc, unsigned& nx) {
    const unsigned G = gridDim.x * gridDim.y * gridDim.z;
    unsigned sum, cnt, mine, sp = 0u;
    for (;;) {
        sum = 0u; cnt = 0u; mine = 0u;
#pragma unroll
        for (unsigned j = 0; j < 16; ++j) { const unsigned c = xb_ld(&bar[XB_XCNT(j)]); sum += c; cnt += (c > 0u) ? 1u : 0u; mine = (j == x) ? c : mine; }
        if (sum == G) break;
        __builtin_amdgcn_s_sleep(1);
        if ((++sp & 255u) == 0u) { if (xb_ld(&bar[XB_TMO])) break; if (sp > XB_SPIN_CAP) { atomicAdd(&bar[XB_TMO], 1u); break; } }
    }
    nloc = mine > 0u ? mine : 1u; nx = cnt > 0u ? cnt : 1u;
}
__device__ __forceinline__ void xcd_barrier(const XcdBarrier& b) {
    asm volatile("s_waitcnt vmcnt(0)" ::: "memory");
    __syncthreads();
    if (b.wave == 0 && lane_id_here() == 0) {
        unsigned* bar = b.bar;
        __builtin_amdgcn_s_waitcnt(0);
        unsigned nloc = b.st[0], nx = b.st[1];
        if (nloc == 0u) { xcd_barrier_complete(bar, b.x, nloc, nx); b.st[0] = nloc; b.st[1] = nx; }
        const unsigned old = xb_add(&bar[XB_XSUB(b.x)], 1u);
        const unsigned gen = old / nloc;
        if (old + 1u == (gen + 1u) * nloc) {
            __builtin_amdgcn_fence(__ATOMIC_RELEASE, "agent");
            asm volatile("s_waitcnt vmcnt(0)" ::: "memory");
            const unsigned og = xb_add(&bar[XB_TOP], 1u);
            const unsigned tg = og / nx;
            if (og + 1u == (tg + 1u) * nx) xb_add(&bar[XB_TOPGEN], 1u);
            else XB_SPIN(xb_ld(&bar[XB_TOPGEN]) == tg, bar);
            __builtin_amdgcn_fence(__ATOMIC_ACQUIRE, "agent");
            xb_add(&bar[XB_XGEN(b.x)], 1u);
            asm volatile("s_waitcnt vmcnt(0)" ::: "memory");
        } else {
            XB_SPIN(xb_ld(&bar[XB_XGEN(b.x)]) == gen, bar);
            __builtin_amdgcn_fence(__ATOMIC_ACQUIRE, "agent");
            asm volatile("s_waitcnt vmcnt(0)" ::: "memory");
        }
    }
    __syncthreads();
}

constexpr int GG_LDS_ROW = 80;
constexpr int GG_LDS_B = 128 * GG_LDS_ROW;
template <class AF, class BF, class EF>
__device__ __forceinline__ void gg_tile(LAS unsigned char* lds, const AF& af, const BF& bfn, const EF& ef, int m0, int n0, int K, int wid) {
    const int lane = lane_id_here(), tid = wid * 64 + lane, wr = wid >> 2, wc = wid & 3, fr = lane & 15, fq = lane >> 4;
    const int a_row = AF::ROWFAST ? (tid & 127) : (tid >> 2), a_kc = AF::ROWFAST ? (tid >> 7) : (tid & 3);
    const int b_row = BF::ROWFAST ? (tid & 127) : (tid >> 2), b_kc = BF::ROWFAST ? (tid >> 7) : (tid & 3);
    f32x4 acc[4][2];
#pragma unroll
    for (int m = 0; m < 4; ++m)
#pragma unroll
        for (int n = 0; n < 2; ++n) acc[m][n] = (f32x4){0.f, 0.f, 0.f, 0.f};
    constexpr int GG_BUF = 2 * 128 * GG_LDS_ROW;
    bf16x8 av[4], bv[4];
#pragma unroll
    for (int d = 0; d < 4; ++d) { av[d] = af.load8(m0 + a_row, 32 * d + a_kc * 8); bv[d] = bfn.load8(n0 + b_row, 32 * d + b_kc * 8); }
    __syncthreads();
    *(LAS bf16x8*)(lds + a_row * GG_LDS_ROW + a_kc * 16) = av[0];
    *(LAS bf16x8*)(lds + GG_LDS_B + b_row * GG_LDS_ROW + b_kc * 16) = bv[0];
    for (int k0 = 0; k0 < K; k0 += 128) {
#pragma unroll
        for (int d = 0; d < 4; ++d) { LAS unsigned char* cur = lds + (d & 1) * GG_BUF; LAS unsigned char* oth = lds + ((d + 1) & 1) * GG_BUF;
            __syncthreads();
            bf16x8 Af[4], Bf[2];
#pragma unroll
            for (int m = 0; m < 4; ++m) Af[m] = *(const LAS bf16x8*)(cur + (wr * 64 + m * 16 + fr) * GG_LDS_ROW + fq * 16);
#pragma unroll
            for (int n = 0; n < 2; ++n) Bf[n] = *(const LAS bf16x8*)(cur + GG_LDS_B + (wc * 32 + n * 16 + fr) * GG_LDS_ROW + fq * 16);
            if (k0 + 128 < K) { av[d] = af.load8(m0 + a_row, k0 + 128 + 32 * d + a_kc * 8); bv[d] = bfn.load8(n0 + b_row, k0 + 128 + 32 * d + b_kc * 8); }
            if (d < 3 || k0 + 128 < K) { *(LAS bf16x8*)(oth + a_row * GG_LDS_ROW + a_kc * 16) = av[(d + 1) & 3]; *(LAS bf16x8*)(oth + GG_LDS_B + b_row * GG_LDS_ROW + b_kc * 16) = bv[(d + 1) & 3]; }
#pragma unroll
            for (int m = 0; m < 4; ++m)
#pragma unroll
                for (int n = 0; n < 2; ++n) acc[m][n] = __builtin_amdgcn_mfma_f32_16x16x32_bf16(Bf[n], Af[m], acc[m][n], 0, 0, 0);
        }
    }
    __syncthreads();
    ef.tile(m0 + wr * 64 + fr, n0 + wc * 32 + fq * 4, acc);
}

struct OpTrivA { static constexpr bool ROWFAST = false;
    __device__ __forceinline__ bf16x8 load8(int row, int k0) const { float v[8];
#pragma unroll
        for (int q = 0; q < 8; ++q) v[q] = (float)(((row * 5 + k0 + q) & 15) - 8);
        return pack8((f32x4){v[0], v[1], v[2], v[3]}, (f32x4){v[4], v[5], v[6], v[7]}); } };
struct OpBf16Rows {
    static constexpr bool ROWFAST = false; const bf16* p; int ld;
    __device__ __forceinline__ bf16x8 load8(int row, int k0) const { return *(const bf16x8*)(p + (size_t)row * ld + k0); }
};
struct OpF32Rows {
    static constexpr bool ROWFAST = false; const float* p; int ld;
    __device__ __forceinline__ bf16x8 load8(int row, int k0) const { const f32x4* q = (const f32x4*)(p + (size_t)row * ld + k0); return pack8(q[0], q[1]); }
};
struct OpF32KN {
    static constexpr bool ROWFAST = true; const float* p; int ld; int c0;
    __device__ __forceinline__ bf16x8 load8(int n, int k0) const {
        const float* q = p + (size_t)k0 * ld + c0 + n; float v[8];
#pragma unroll
        for (int j = 0; j < 8; ++j) v[j] = q[(size_t)j * ld];
        return pack8((f32x4){v[0], v[1], v[2], v[3]}, (f32x4){v[4], v[5], v[6], v[7]});
    }
};
struct OpF32KNPair {
    static constexpr bool ROWFAST = true; const float* w0; long delta; int ld;
    __device__ __forceinline__ bf16x8 load8(int n, int k0) const {
        const int f = ((n >> 5) << 4) | (n & 15); const float* q = w0 + (long)((n >> 4) & 1) * delta + (size_t)k0 * ld + f; float v[8];
#pragma unroll
        for (int j = 0; j < 8; ++j) v[j] = q[(size_t)j * ld];
        return pack8((f32x4){v[0], v[1], v[2], v[3]}, (f32x4){v[4], v[5], v[6], v[7]});
    }
};


struct Args { const float* in[24]; float* out; unsigned char* ws; int ph_lo, ph_hi; };
typedef const __attribute__((address_space(4))) Args* KArgs;
struct Frame {
    LAS unsigned char* lds; int wave, G, bid;
    unsigned char* ws; float* xo;
    __device__ __forceinline__ int lane() const { return lane_id_here(); }
    __device__ __forceinline__ int tid() const { return wave * 64 + lane_id_here(); }
};

namespace pg8 {
constexpr int BM = 256, BK = 64, HALF = 128, HTB = HALF * BK * 2, STAGE_BYTES = 8 * HTB, NXCD = 8, WGM = 8;
__device__ __forceinline__ int lds_byte(int r, int c) { const int st = (r >> 4) * 2 + (c >> 5), rr = r & 15, cc = c & 31, ob = rr * 64 + cc * 2; return st * 1024 + (ob ^ (((ob >> 9) & 1) << 5)); }
__device__ __forceinline__ void stage_rc(int b, int& R, int& C) { const int st = b / 1024, sb = b % 1024, swz = sb ^ (((sb >> 9) & 1) << 5); R = (st >> 1) * 16 + swz / 64; C = (st & 1) * 32 + (swz % 64) / 2; }
__device__ __forceinline__ int perm32(int rho) { const int n = rho >> 4, i = rho & 15; return 8 * (i >> 2) + 4 * n + (i & 3); }
struct Unit { int pm, pn; };
typedef int v8i_t __attribute__((ext_vector_type(8)));
__device__ __forceinline__ v8i_t cat8(const bf16x8 lo, const bf16x8 hi) { typedef int v4i_t __attribute__((ext_vector_type(4))); const v4i_t a = __builtin_bit_cast(v4i_t, lo), b = __builtin_bit_cast(v4i_t, hi); return (v8i_t){a.x, a.y, a.z, a.w, b.x, b.y, b.z, b.w}; }
struct StaticOrder {
    int nM, nN, nwg, G, c;
    __device__ void init(int M, int N, int G_, int c_) { nM = M / BM; nN = N / BM; nwg = nM * nN; G = G_; c = c_; }
    __device__ bool next(int i, Unit& u) const {
        const long L = (long)i * G + c; if (L >= nwg) return false;
        int wgid = (int)L; { const int q = nwg / NXCD, r = nwg % NXCD, xcd = wgid % NXCD, off = wgid / NXCD; wgid = (xcd < r ? xcd * (q + 1) : r * (q + 1) + (xcd - r) * q) + off; }
        const int nig = WGM * nN, gid = wgid / nig, fm = gid * WGM, gsz = (nM - fm) < WGM ? (nM - fm) : WGM;
        u.pm = fm + ((wgid % nig) % gsz); u.pn = (wgid % nig) / gsz; return true;
    }
};
struct ExpertOrder {
    int nN, nwg, G, c;
    __device__ void init(int nN_, int G_, int c_) { nN = nN_; nwg = NE * 16 * nN_; G = G_; c = c_; }
    __device__ bool next(int i, Unit& u) const { const long L = (long)i * G + c; if (L >= nwg) return false;
        int combo = (int)(L >> 4), pml = (int)(L & 15);
        if (G == 256) { const int x = c & 7, j = c >> 3; combo = 16 * i + 4 * (x >> 1) + (j >> 3); pml = 8 * (x & 1) + (j & 7); }
        const int e = combo / nN; u.pn = combo - e * nN; u.pm = e * 16 + pml; return true; }
};
struct PolPlain {
    static constexpr bool DYN = false, FP8 = false, BSWITCH = false; const bf16* A; const bf16* Bt; int lda, ldb, K;
    __device__ __forceinline__ const char* a_base(const Unit& u) const { return (const char*)(A + (size_t)u.pm * BM * lda); }
    __device__ __forceinline__ const char* b_base(const Unit& u) const { return (const char*)(Bt + (size_t)u.pn * BM * ldb); }
    __device__ __forceinline__ unsigned a_off(int h, int R, int C, const Unit&) const { return (unsigned)((h * HALF + R) * lda + C) * 2u; }
    __device__ __forceinline__ unsigned b_off(int h, int R, int C) const { return (unsigned)((h * HALF + R) * ldb + C) * 2u; }
};
struct PolYfGlu {
    static constexpr bool DYN = false, FP8 = false, BSWITCH = false; const unsigned char* ws; size_t a0, b0, a1, b1; int K;
    __device__ __forceinline__ const char* a_base(const Unit& u) const { const size_t o = (u.pn >> 16) ? a1 : a0; return (const char*)(ws + o) + (size_t)u.pm * BM * 512 * 2; }
    __device__ __forceinline__ const char* b_base(const Unit& u) const { const size_t o = (u.pn >> 16) ? b1 : b0; return (const char*)(ws + o) + (size_t)(u.pn & 0xffff) * BM * 512 * 2; }
    __device__ __forceinline__ unsigned a_off(int h, int R, int C, const Unit&) const { return (unsigned)((h * HALF + R) * 512 + C) * 2u; }
    __device__ __forceinline__ unsigned b_off(int h, int R, int C) const { return (unsigned)((h * HALF + R) * 512 + C) * 2u; }
};
struct TripleOrder {
    StaticOrder so;
    __device__ void init(int G_, int c_) { so.init(T, DM, G_, c_); }
    __device__ bool next(int i, Unit& u) const { const int sup = i / 3, sub = i - 3 * sup; Unit v; if (!so.next(sup, v)) return false; u.pm = v.pm; u.pn = sub == 0 ? v.pn : ((2 * v.pn + sub - 1) | (1 << 16)); return true; }
};
struct PolG1a {
    static constexpr bool DYN = false, FP8 = false, BSWITCH = false; const bf16* A; const bf16* H; int K;
    __device__ __forceinline__ const char* a_base(const Unit& u) const { return (const char*)(A + (size_t)u.pm * BM * DM); }
    __device__ __forceinline__ const char* b_base(const Unit& u) const { return (const char*)(H + ((size_t)(u.pn >> 5) * SEQ + 2 * (u.pn & 31)) * DM); }
    __device__ __forceinline__ unsigned a_off(int h, int R, int C, const Unit&) const { return (unsigned)((h * HALF + R) * DM + C) * 2u; }
    __device__ __forceinline__ unsigned b_off(int h, int R, int C) const { return (unsigned)((64 * R + h) * DM + C) * 2u; }
};
struct PolExpUp {
    static constexpr bool DYN = true, FP8 = false, BSWITCH = false; const bf16* H2; const int* idx; const bf16* W; int K;
    __device__ __forceinline__ const char* a_base(const Unit&) const { return (const char*)H2; }
    __device__ __forceinline__ const char* b_base(const Unit& u) const { return (const char*)(W + ((size_t)(u.pm >> 4) * (2 * DE) + (size_t)u.pn * BM) * DM); }
    __device__ __forceinline__ unsigned a_off(int h, int R, int C, const Unit& u) const { return (unsigned)idx[u.pm * BM + h * HALF + R] * (unsigned)(DM * 2) + (unsigned)C * 2u; }
    __device__ __forceinline__ unsigned b_off(int h, int R, int C) const { return (unsigned)((h * HALF + R) * DM + C) * 2u; }
};
struct PolExpUp8 {
    static constexpr bool DYN = true, FP8 = true, BSWITCH = false; const unsigned char* H2; const int* idx; const unsigned char* W; int K;
    __device__ __forceinline__ const char* a_base(const Unit&) const { return (const char*)H2; }
    __device__ __forceinline__ const char* b_base(const Unit& u) const { return (const char*)(W + ((size_t)(u.pm >> 4) * (2 * DE) + (size_t)u.pn * BM) * DM); }
    __device__ __forceinline__ unsigned a_off(int h, int R, int C, const Unit& u) const { return (unsigned)idx[u.pm * BM + h * HALF + R] * (unsigned)DM + (unsigned)C * 2u; }
    __device__ __forceinline__ const int* idx_ptr(const Unit& u) const { return idx + (size_t)u.pm * BM; }
    __device__ __forceinline__ unsigned a_off_idx(int iv, int C) const { return (unsigned)iv * (unsigned)DM + (unsigned)C * 2u; }
    __device__ __forceinline__ unsigned b_off(int h, int R, int C) const { return (unsigned)((h * HALF + R) * DM) + (unsigned)C * 2u; }
};
struct PolPlain8 {
    static constexpr bool DYN = false, FP8 = true, BSWITCH = false; const unsigned char* A; const unsigned char* W; int lda, ldb, K;
    __device__ __forceinline__ const char* a_base(const Unit& u) const { return (const char*)(A + (size_t)u.pm * BM * lda); }
    __device__ __forceinline__ const char* b_base(const Unit& u) const { return (const char*)(W + (size_t)u.pn * BM * ldb); }
    __device__ __forceinline__ unsigned a_off(int h, int R, int C, const Unit&) const { return (unsigned)((h * HALF + R) * lda) + (unsigned)C * 2u; }
    __device__ __forceinline__ unsigned b_off(int h, int R, int C) const { return (unsigned)((h * HALF + R) * ldb) + (unsigned)C * 2u; }
};
struct PolExpDown8 {
    static constexpr bool DYN = false, FP8 = true, BSWITCH = false; const unsigned char* A; const unsigned char* W; int K;
    __device__ __forceinline__ const char* a_base(const Unit& u) const { return (const char*)(A + (size_t)u.pm * BM * DE); }
    __device__ __forceinline__ const char* b_base(const Unit& u) const { return (const char*)(W + ((size_t)(u.pm >> 4) * DM + (size_t)u.pn * BM) * DE); }
    __device__ __forceinline__ unsigned a_off(int h, int R, int C, const Unit&) const { return (unsigned)((h * HALF + R) * DE) + (unsigned)C * 2u; }
    __device__ __forceinline__ unsigned b_off(int h, int R, int C) const { return (unsigned)((h * HALF + R) * DE) + (unsigned)C * 2u; }
};
struct PolExpDown {
    static constexpr bool DYN = false, FP8 = false, BSWITCH = false; const bf16* A; const bf16* W; int K;
    __device__ __forceinline__ const char* a_base(const Unit& u) const { return (const char*)(A + (size_t)u.pm * BM * DE); }
    __device__ __forceinline__ const char* b_base(const Unit& u) const { return (const char*)(W + ((size_t)(u.pm >> 4) * DM + (size_t)u.pn * BM) * DE); }
    __device__ __forceinline__ unsigned a_off(int h, int R, int C, const Unit&) const { return (unsigned)((h * HALF + R) * DE + C) * 2u; }
    __device__ __forceinline__ unsigned b_off(int h, int R, int C) const { return (unsigned)((h * HALF + R) * DE + C) * 2u; }
};

struct PolPassB {
    static constexpr bool DYN = false, FP8 = false, BSWITCH = false; const bf16* A; const bf16* W; int K;
    __device__ __forceinline__ const char* a_base(const Unit& u) const { return (const char*)(A + (size_t)u.pm * BM * KCAT); }
    __device__ __forceinline__ const char* b_base(const Unit& u) const { return (const char*)(W + ((size_t)(u.pm >> 1) * 1024 + (size_t)u.pn * BM) * KCAT); }
    __device__ __forceinline__ unsigned a_off(int h, int R, int C, const Unit&) const { return (unsigned)((h * HALF + R) * KCAT + C) * 2u; }
    __device__ __forceinline__ unsigned b_off(int h, int R, int C) const { return (unsigned)((h * HALF + R) * KCAT + C) * 2u; }
};
struct PolStageC {
    static constexpr bool DYN = false, FP8 = false, BSWITCH = false; const bf16* A; const bf16* Y; int K;
    __device__ __forceinline__ const char* a_base(const Unit&) const { return (const char*)A; }
    __device__ __forceinline__ const char* b_base(const Unit& u) const { return (const char*)(Y + (size_t)u.pn * 2 * 128 * 128); }
    __device__ __forceinline__ unsigned a_off(int h, int R, int C, const Unit&) const { return (unsigned)((h * HALF + R) * 128 + C) * 2u; }
    __device__ __forceinline__ unsigned b_off(int h, int R, int C) const { return (unsigned)((((R >> 6) * 128 + h * 64 + (R & 63)) * 128) + C) * 2u; }
};
struct PolPassB2 {
    static constexpr bool DYN = false, FP8 = false, BSWITCH = true; static constexpr int KSW = 16;
    const bf16* A; const bf16* KC; const bf16* CT; int K;
    __device__ __forceinline__ const char* a_base(const Unit& u) const { return (const char*)(A + (size_t)u.pm * BM * KCAT); }
    __device__ __forceinline__ unsigned a_off(int h, int R, int C, const Unit&) const { return (unsigned)((h * HALF + R) * KCAT + C) * 2u; }
    __device__ __forceinline__ const char* b_base(const Unit& u) const { return (const char*)(KC + (size_t)(u.pm >> 1) * (128 * 256)) + (size_t)u.pn * 8192; }
    __device__ __forceinline__ unsigned b_off(int h, int R, int C) const { const int row = h * HALF + R; return (unsigned)((((row >> 4) - (C >> 4) + 63) * 256 + (row & 15) * 16 + (C & 15)) * 2); }
    __device__ __forceinline__ long kstepB1() const { return -2048; }
    __device__ __forceinline__ const char* b_base2(const Unit& u) const { return (const char*)(CT + ((size_t)(u.pm >> 1) * 1024 + (size_t)u.pn * BM) * 256); }
    __device__ __forceinline__ unsigned b_off2(int h, int R, int C) const { return (unsigned)((h * HALF + R) * 256 + C) * 2u; }
    __device__ __forceinline__ long kstepB2() const { return 128; }
};
struct LinearOrder {
    int nN, nwg, G, c;
    __device__ void init(int nM_, int nN_, int G_, int c_) { nN = nN_; nwg = nM_ * nN_; G = G_; c = c_; }
    __device__ bool next(int i, Unit& u) const { const long L = (long)i * G + c; if (L >= nwg) return false; u.pm = (int)(L / nN); u.pn = (int)(L % nN); return true; }
};
template <class E, class = void> struct epi_perm2 { static constexpr bool v = false; };
template <class E> struct epi_perm2<E, decltype((void)E::PERM2)> { static constexpr bool v = E::PERM2; };
template <class E, class = void> struct epi_side { static constexpr bool v = false; };
template <class E> struct epi_side<E, decltype((void)E::SIDE)> { static constexpr bool v = E::SIDE; };
constexpr int LDS_SIDE = 132 * 1024, LDS_IDX = 134 * 1024;
template <class Pol> __device__ __forceinline__ constexpr int ksw_of() { if constexpr (Pol::BSWITCH) return Pol::KSW; else return 0; }
template <class Pol, class Epi, class Sched>
__device__ __forceinline__ void gemm_phase(LAS unsigned char* lds, const Pol& P, const Sched& S, const Epi& E, int wid) {
    const int lane = lane_id_here(), tid = wid * 64 + lane, wr = wid >> 2, wc = wid & 3, fr = lane & 15, fq = lane >> 4;
    int nt = P.K / BK; asm volatile("" : "+s"(nt));
    Unit cur, nxt; int ui = 0;
    if (!S.next(0, cur)) return;
    int sR[2], sC[2], sRb[2];
#pragma unroll
    for (int i = 0; i < 2; ++i) { stage_rc(tid * 16 + i * 8192, sR[i], sC[i]); sRb[i] = epi_perm2<Epi>::v ? ((sR[i] >> 5) * 64 + perm32(sR[i] & 31)) : (Epi::PERM ? ((sR[i] & ~31) + perm32(sR[i] & 31)) : sR[i]); }
    unsigned vA[2][2], vB[2], vB2[2];
    const size_t hsB1 = epi_perm2<Epi>::v ? (size_t)(P.b_off(0, 32, 0) - P.b_off(0, 0, 0)) : (size_t)(P.b_off(1, 0, 0) - P.b_off(0, 0, 0)); size_t hsB2 = 0;
#pragma unroll
    for (int i = 0; i < 2; ++i) { vB[i] = P.b_off(0, sRb[i], sC[i]); vB2[i] = 0u;
#pragma unroll
        for (int h = 0; h < 2; ++h) vA[h][i] = P.a_off(h, sR[i], sC[i], cur); }
    if constexpr (Pol::BSWITCH) { hsB2 = (size_t)(P.b_off2(1, 0, 0) - P.b_off2(0, 0, 0));
#pragma unroll
        for (int i = 0; i < 2; ++i) vB2[i] = P.b_off2(0, sRb[i], sC[i]); }
    if (Pol::DYN) asm volatile("s_waitcnt vmcnt(0)" ::: "memory");
    const size_t kstep = (size_t)(BK * 2);
    long ksB = (long)kstep, ksB2 = 0; if constexpr (Pol::BSWITCH) { ksB = P.kstepB1(); ksB2 = P.kstepB2(); }
    const unsigned ldsw = (unsigned)wid * 1024u;
    const int aoff = lds_byte(wr * 64 + fr, fq * 8), boff = lds_byte(wc * 32 + fr, fq * 8);
#define PG8_SA(b, h) (((b) * 2 + (h)) * HTB)
#define PG8_SB(b, h) ((4 + (b) * 2 + (h)) * HTB)
#define PG8_STG(bufoff, gbase, voff2) do { _Pragma("unroll") for (int _i = 0; _i < 2; ++_i) { unsigned _o = (voff2)[_i]; asm volatile("" : "+v"(_o));     \
        __builtin_amdgcn_global_load_lds((const unsigned*)((const char*)(gbase) + _o), (LAS unsigned*)(lds + (bufoff) + ldsw + _i * 8192), 16, 0, 0); } } while (0)
#define PG8_LDA(dst, b, h) do { if constexpr (Pol::FP8) { _Pragma("unroll") for (int m = 0; m < 4; ++m) dst##8[m] = cat8(*(const LAS bf16x8*)(lds + PG8_SA(b, h) + aoff + m * 2048), *(const LAS bf16x8*)(lds + PG8_SA(b, h) + aoff + m * 2048 + 1024)); } \
        else { _Pragma("unroll") for (int m = 0; m < 4; ++m) _Pragma("unroll") for (int k = 0; k < 2; ++k) dst[m][k] = *(const LAS bf16x8*)(lds + PG8_SA(b, h) + aoff + m * 2048 + k * 1024); } } while (0)
#define PG8_LDB(dst, b, h) do { if constexpr (Pol::FP8) { _Pragma("unroll") for (int n = 0; n < 2; ++n) dst##8[n] = cat8(*(const LAS bf16x8*)(lds + PG8_SB(b, h) + boff + n * 2048), *(const LAS bf16x8*)(lds + PG8_SB(b, h) + boff + n * 2048 + 1024)); } \
        else { _Pragma("unroll") for (int n = 0; n < 2; ++n) _Pragma("unroll") for (int k = 0; k < 2; ++k) dst[n][k] = *(const LAS bf16x8*)(lds + PG8_SB(b, h) + boff + n * 2048 + k * 1024); } } while (0)
#define PG8_MMA(ai, bj, At, Bt) do { __builtin_amdgcn_s_setprio(1); \
        if constexpr (Pol::FP8) { _Pragma("unroll") for (int m = 0; m < 4; ++m) _Pragma("unroll") for (int n = 0; n < 2; ++n) \
            acc[ai][bj][m][n] = __builtin_amdgcn_mfma_scale_f32_16x16x128_f8f6f4(Bt##8[n], At##8[m], acc[ai][bj][m][n], 0, 0, 0, 0x7f7f7f7f, 0, 0x7f7f7f7f); } \
        else { _Pragma("unroll") for (int m = 0; m < 4; ++m) _Pragma("unroll") for (int n = 0; n < 2; ++n) _Pragma("unroll") for (int k = 0; k < 2; ++k) \
            acc[ai][bj][m][n] = __builtin_amdgcn_mfma_f32_16x16x32_bf16(Bt[n][k], At[m][k], acc[ai][bj][m][n], 0, 0, 0); } \
        __builtin_amdgcn_s_setprio(0); } while (0)
#define PG8_WAIT_V(n) asm volatile("s_waitcnt vmcnt(" #n ")" ::: "memory")
#define PG8_WAIT_L(n) asm volatile("s_waitcnt lgkmcnt(" #n ")" ::: "memory")
#define PG8_BAR __builtin_amdgcn_s_barrier()
#define PG8_SCHED __builtin_amdgcn_sched_barrier(0)
    f32x4 acc[2][2][4][2];
#pragma unroll
    for (int a = 0; a < 2; ++a)
#pragma unroll
        for (int b = 0; b < 2; ++b)
#pragma unroll
            for (int m = 0; m < 4; ++m)
#pragma unroll
                for (int n = 0; n < 2; ++n) acc[a][b][m][n] = (f32x4){0.f, 0.f, 0.f, 0.f};
    bf16x8 At[4][2], B0[2][2], B1[2][2]; v8i_t At8[4], B08[2], B18[2]; (void)At; (void)B0; (void)B1; (void)At8; (void)B08; (void)B18;
    const char* cA = P.a_base(cur); const char* cB = P.b_base(cur);
    PG8_STG(PG8_SB(0, 0), cB, vB); PG8_STG(PG8_SB(0, 1), cB + hsB1, vB); PG8_STG(PG8_SA(0, 0), cA, vA[0]); PG8_STG(PG8_SA(0, 1), cA, vA[1]);
    if (wr == 1) PG8_BAR;
    PG8_WAIT_V(2); PG8_BAR;
    PG8_STG(PG8_SB(1, 0), cB + ksB, vB); PG8_STG(PG8_SA(1, 0), cA + kstep, vA[0]); PG8_STG(PG8_SB(1, 1), cB + ksB + hsB1, vB);
    PG8_WAIT_V(6); PG8_BAR;
    for (;;) {
        const bool has_next = S.next(ui + 1, nxt);
        const char* nA = has_next ? P.a_base(nxt) : cA; const char* nB = has_next ? P.b_base(nxt) : cB;
        const char* cB2 = cB; if constexpr (Pol::BSWITCH) cB2 = P.b_base2(cur);
        if constexpr (epi_side<Epi>::v) { if (wid == 0) { unsigned so = (unsigned)lane_id_here() * 16u; asm volatile("" : "+v"(so));
            __builtin_amdgcn_global_load_lds((const unsigned*)((const char*)E.side_ptr(cur) + so), (LAS unsigned*)(lds + LDS_SIDE + (ui & 1) * 1024), 16, 0, 0); } }
        if constexpr (Pol::DYN) {
            if (has_next && wid == 0) { unsigned so = (unsigned)lane_id_here() * 16u; asm volatile("" : "+v"(so));
                __builtin_amdgcn_global_load_lds((const unsigned*)((const char*)P.idx_ptr(nxt) + so), (LAS unsigned*)(lds + LDS_IDX + ((ui + 1) & 1) * 1024), 16, 0, 0); }
        }
        for (int t = 0; t < nt; t += 2) {
            const bool last = (t == nt - 2);
            const char* a1 = cA + (size_t)(t + 1) * kstep;
            const char* a2 = last ? nA : cA + (size_t)(t + 2) * kstep; const char* a3 = a2 + kstep;
            const char* b2; const char* b3; unsigned wB[2]; size_t hsB = hsB1;
            { bool r2 = false; if constexpr (Pol::BSWITCH) r2 = !last && (t + 2 >= ksw_of<Pol>());
              if (last) { b2 = nB; b3 = b2 + ksB; } else if (r2) { b2 = cB2 + (long)(t + 2 - ksw_of<Pol>()) * ksB2; b3 = b2 + ksB2; hsB = hsB2; } else { b2 = cB + (long)(t + 2) * ksB; b3 = b2 + ksB; }
#pragma unroll
              for (int i = 0; i < 2; ++i) wB[i] = r2 ? vB2[i] : vB[i]; }
            PG8_LDB(B0, 0, 0); PG8_LDB(B1, 0, 1); PG8_SCHED; PG8_LDA(At, 0, 0); PG8_STG(PG8_SA(1, 1), a1, vA[1]);
            if constexpr (Pol::DYN) { if (last && has_next) {
                const LAS int* ix = (const LAS int*)(lds + LDS_IDX + ((ui + 1) & 1) * 1024);
#pragma unroll
                for (int i = 0; i < 2; ++i) { int R_, C_; stage_rc(tid * 16 + i * 8192, R_, C_);
#pragma unroll
                    for (int h = 0; h < 2; ++h) vA[h][i] = P.a_off_idx(ix[h * HALF + R_], C_); } } }
            PG8_WAIT_V(8); PG8_WAIT_L(0); PG8_BAR; PG8_MMA(0, 0, At, B0); PG8_MMA(0, 1, At, B1); PG8_BAR; PG8_SCHED;
            PG8_LDA(At, 0, 1); PG8_STG(PG8_SB(0, 0), b2, wB); PG8_STG(PG8_SB(0, 1), b2 + hsB, wB); PG8_STG(PG8_SA(0, 0), a2, vA[0]);
            PG8_WAIT_V(8); PG8_WAIT_L(0); PG8_BAR; PG8_MMA(1, 0, At, B0); PG8_MMA(1, 1, At, B1); PG8_BAR; PG8_SCHED;
            PG8_LDB(B0, 1, 0); PG8_LDB(B1, 1, 1); PG8_SCHED; PG8_LDA(At, 1, 0); PG8_STG(PG8_SA(0, 1), a2, vA[1]);
            PG8_WAIT_V(8); PG8_WAIT_L(0); PG8_BAR; PG8_MMA(0, 0, At, B0); PG8_MMA(0, 1, At, B1); PG8_BAR; PG8_SCHED;
            PG8_LDA(At, 1, 1); PG8_STG(PG8_SB(1, 0), b3, wB); PG8_STG(PG8_SB(1, 1), b3 + hsB, wB); PG8_STG(PG8_SA(1, 0), a3, vA[0]);
            PG8_WAIT_V(8); PG8_WAIT_L(0); PG8_BAR; PG8_MMA(1, 0, At, B0); PG8_MMA(1, 1, At, B1); PG8_BAR; PG8_SCHED;
        }
        if (wr == 0) PG8_BAR;
        { Unit eu = cur; int et = lane_id_here(); asm volatile("" : "+s"(eu.pm), "+s"(eu.pn), "+v"(et)); const int efr = et & 15, efq = (et >> 4) & 3;
          if constexpr (epi_side<Epi>::v) E(acc, eu, wr, wc, efr, efq, (const LAS float*)(lds + LDS_SIDE + (ui & 1) * 1024)); else E(acc, eu, wr, wc, efr, efq); }
        if (!has_next) break;
#pragma unroll
        for (int a = 0; a < 2; ++a)
#pragma unroll
            for (int b = 0; b < 2; ++b)
#pragma unroll
                for (int m = 0; m < 4; ++m)
#pragma unroll
                    for (int n = 0; n < 2; ++n) acc[a][b][m][n] = (f32x4){0.f, 0.f, 0.f, 0.f};
        cur = nxt; cA = nA; cB = nB; ++ui;
        if (wr == 1) PG8_BAR;
    }
    PG8_WAIT_V(0);
    PG8_BAR;
#undef PG8_SA
#undef PG8_SB
#undef PG8_STG
#undef PG8_LDA
#undef PG8_LDB
#undef PG8_MMA
#undef PG8_WAIT_V
#undef PG8_WAIT_L
#undef PG8_BAR
#undef PG8_SCHED
}

__device__ __forceinline__ u32x4 pk8(const f32x4 a, const f32x4 b) { u32x4 w; w.x = cvt_pk_bf16(a.x, a.y); w.y = cvt_pk_bf16(a.z, a.w); w.z = cvt_pk_bf16(b.x, b.y); w.w = cvt_pk_bf16(b.z, b.w); return w; }
__device__ __forceinline__ void unpk8(const u32x4 w, f32x4& a, f32x4& b) {
    a.x = __uint_as_float(w.x << 16); a.y = __uint_as_float(w.x & 0xffff0000u); a.z = __uint_as_float(w.y << 16); a.w = __uint_as_float(w.y & 0xffff0000u);
    b.x = __uint_as_float(w.z << 16); b.y = __uint_as_float(w.z & 0xffff0000u); b.z = __uint_as_float(w.w << 16); b.w = __uint_as_float(w.w & 0xffff0000u); }
__device__ __forceinline__ f32x4 sig4s(const f32x4 v, float nc_log2e, float invk) { const f32x4 a = v * nc_log2e;
    const f32x4 e = (f32x4){__builtin_amdgcn_exp2f(a.x), __builtin_amdgcn_exp2f(a.y), __builtin_amdgcn_exp2f(a.z), __builtin_amdgcn_exp2f(a.w)}; const f32x4 d = e * invk + invk;
    return (f32x4){__builtin_amdgcn_rcpf(d.x), __builtin_amdgcn_rcpf(d.y), __builtin_amdgcn_rcpf(d.z), __builtin_amdgcn_rcpf(d.w)}; }
__device__ __forceinline__ f32x4 sig4(const f32x4 v) { const f32x4 a = v * -1.4426950408889634f;
    const f32x4 e = (f32x4){__builtin_amdgcn_exp2f(a.x), __builtin_amdgcn_exp2f(a.y), __builtin_amdgcn_exp2f(a.z), __builtin_amdgcn_exp2f(a.w)}; const f32x4 d = e + 1.0f;
    return (f32x4){__builtin_amdgcn_rcpf(d.x), __builtin_amdgcn_rcpf(d.y), __builtin_amdgcn_rcpf(d.z), __builtin_amdgcn_rcpf(d.w)}; }
__device__ __forceinline__ u32x2 pk8_u8(const f32x4 a, const f32x4 b) {
    unsigned lo = 0u, hi = 0u;
    lo = __builtin_amdgcn_cvt_pk_u8_f32(a.x * 255.0f, 0, lo); lo = __builtin_amdgcn_cvt_pk_u8_f32(a.y * 255.0f, 1, lo); lo = __builtin_amdgcn_cvt_pk_u8_f32(a.z * 255.0f, 2, lo); lo = __builtin_amdgcn_cvt_pk_u8_f32(a.w * 255.0f, 3, lo);
    hi = __builtin_amdgcn_cvt_pk_u8_f32(b.x * 255.0f, 0, hi); hi = __builtin_amdgcn_cvt_pk_u8_f32(b.y * 255.0f, 1, hi); hi = __builtin_amdgcn_cvt_pk_u8_f32(b.z * 255.0f, 2, hi); hi = __builtin_amdgcn_cvt_pk_u8_f32(b.w * 255.0f, 3, hi);
    return (u32x2){lo, hi};
}
__device__ __forceinline__ u32x2 pk8_u8raw(const f32x4 a, const f32x4 b) {
    unsigned lo = 0u, hi = 0u;
    lo = __builtin_amdgcn_cvt_pk_u8_f32(a.x, 0, lo); lo = __builtin_amdgcn_cvt_pk_u8_f32(a.y, 1, lo); lo = __builtin_amdgcn_cvt_pk_u8_f32(a.z, 2, lo); lo = __builtin_amdgcn_cvt_pk_u8_f32(a.w, 3, lo);
    hi = __builtin_amdgcn_cvt_pk_u8_f32(b.x, 0, hi); hi = __builtin_amdgcn_cvt_pk_u8_f32(b.y, 1, hi); hi = __builtin_amdgcn_cvt_pk_u8_f32(b.z, 2, hi); hi = __builtin_amdgcn_cvt_pk_u8_f32(b.w, 3, hi);
    return (u32x2){lo, hi};
}
__device__ __forceinline__ void unpk8_u8(const u32x2 w, f32x4& a, f32x4& b) {
    constexpr float k = 1.0f / 255.0f;
    a = (f32x4){(float)(w.x & 255u) * k, (float)((w.x >> 8) & 255u) * k, (float)((w.x >> 16) & 255u) * k, (float)(w.x >> 24) * k};
    b = (f32x4){(float)(w.y & 255u) * k, (float)((w.y >> 8) & 255u) * k, (float)((w.y >> 16) & 255u) * k, (float)(w.y >> 24) * k};
}
__device__ __forceinline__ f32x4 gelu4(const f32x4 x) { constexpr float c1 = -2.0f * 0.7978845608028654f * 1.4426950408889634f, c2 = c1 * 0.044715f;
    const f32x4 a = x * ((x * x) * c2 + c1); const f32x4 e = (f32x4){__builtin_amdgcn_exp2f(a.x), __builtin_amdgcn_exp2f(a.y), __builtin_amdgcn_exp2f(a.z), __builtin_amdgcn_exp2f(a.w)}; const f32x4 d = e + 1.0f;
    return x * (f32x4){__builtin_amdgcn_rcpf(d.x), __builtin_amdgcn_rcpf(d.y), __builtin_amdgcn_rcpf(d.z), __builtin_amdgcn_rcpf(d.w)}; }
#define PG8_EPI_LOOP for (int ai = 0; ai < 2; ++ai) _Pragma("unroll") for (int m = 0; m < 4; ++m) _Pragma("unroll") for (int bj = 0; bj < 2; ++bj)
struct EpiXt {
    static constexpr bool PERM = true; bf16* XT;
    __device__ __forceinline__ void operator()(const f32x4 (&acc)[2][2][4][2], const Unit& u, int wr, int wc, int fr, int fq) const {
        const int b = u.pn >> 5, n1 = wc * 32 + 8 * fq;
#pragma unroll
        PG8_EPI_LOOP { const int r = u.pm * BM + ai * HALF + wr * 64 + m * 16 + fr, g = r >> 7, pqc = r & 127, n2 = 2 * (u.pn & 31) + bj;
            *(u32x4*)(XT + ((((size_t)(b * 4 + g) * 128 + pqc) * 64 + n2) * 128 + n1)) = pk8(acc[ai][bj][m][0], acc[ai][bj][m][1]); }
    }
};
struct EpiG1b {
    static constexpr bool PERM = true, PERM2 = true; bf16* ACAT; unsigned char* GF; unsigned char* GS;
    __device__ __forceinline__ void operator()(const f32x4 (&acc)[2][2][4][2], const Unit& u, int wr, int wc, int fr, int fq) const {
#pragma unroll
        PG8_EPI_LOOP { const int r = u.pm * BM + ai * HALF + wr * 64 + m * 16 + fr, c = u.pn * BM + wc * 64 + bj * 32 + 8 * fq;
            if (c < 512) { const int g = c >> 4; *(u32x4*)(ACAT + ((size_t)(g * NROWC + (r >> 6)) * KCAT + (r & 63) * 16 + (c & 15))) = pk8(acc[ai][bj][m][0], acc[ai][bj][m][1]); }
            else { const int cc = c - 512; const u32x2 w = pk8_u8raw(sig4s(acc[ai][bj][m][0], -1.4426950408889634f, 1.0f / 255.0f), sig4s(acc[ai][bj][m][1], -1.4426950408889634f, 1.0f / 255.0f));
                if (cc < 1024) *(u32x2*)(GF + (size_t)r * DM + cc) = w; else *(u32x2*)(GS + (size_t)r * DM + (cc - 1024)) = w; } }
    }
};
struct EpiPassB {
    static constexpr bool PERM = true; bf16* YS;
    __device__ __forceinline__ void operator()(const f32x4 (&acc)[2][2][4][2], const Unit& u, int wr, int wc, int fr, int fq) const {
#pragma unroll
        PG8_EPI_LOOP { const int r = u.pm * BM + ai * HALF + wr * 64 + m * 16 + fr, c = u.pn * BM + bj * HALF + wc * 32 + 8 * fq, g = r >> 9, s = c >> 4, o = c & 15;
            const f32x4 v0 = acc[ai][bj][m][0], v1 = acc[ai][bj][m][1];
            *(u32x4*)(YS + ((size_t)((r & 511) * 64 + s) * 512 + g * 16 + o)) = pk8(gelu4(v0), gelu4(v1)); }
    }
};
struct EpiStageA {
    static constexpr bool PERM = true; bf16* Y; const f32x2* TW;
    __device__ __forceinline__ void operator()(const f32x4 (&acc)[2][2][4][2], const Unit& u, int wr, int wc, int fr, int fq) const {
        const int bg = u.pn >> 5, n2 = 32 * (wc & 1) + 8 * fq;
        f32x2 tq0[4], tq1[4];
#pragma unroll
        for (int m = 0; m < 4; ++m) { const int k1 = 64 * wr + 16 * m + fr; tq0[m] = TW[n2 * k1]; tq1[m] = TW[k1]; }
        asm volatile("s_waitcnt vmcnt(0)" ::: "memory");
#pragma unroll
        for (int m = 0; m < 4; ++m) { const int k1 = 64 * wr + 16 * m + fr; const f32x2 t0 = tq0[m], t1 = tq1[m];
            float twc[8], tws[8]; twc[0] = t0.x; tws[0] = t0.y;
#pragma unroll
            for (int q = 1; q < 8; ++q) { twc[q] = twc[q - 1] * t1.x - tws[q - 1] * t1.y; tws[q] = tws[q - 1] * t1.x + twc[q - 1] * t1.y; }
#pragma unroll
            for (int bj = 0; bj < 2; ++bj) { const int pqc = 4 * (u.pn & 31) + 2 * bj + (wc >> 1); f32x4 xr[2], xi[2];
#pragma unroll
                for (int n = 0; n < 2; ++n)
#pragma unroll
                    for (int j = 0; j < 4; ++j) { const float c_ = twc[4 * n + j], s_ = tws[4 * n + j], ar = acc[0][bj][m][n][j], ai_ = acc[1][bj][m][n][j];
                        const float br = ar * c_ + ai_ * s_, bi = ai_ * c_ - ar * s_; if (pqc >= 65) { xr[n][j] = -bi; xi[n][j] = br; } else { xr[n][j] = br; xi[n][j] = bi; } }
                bf16* yp = Y + (((size_t)(bg * 128 + k1) * 128 + pqc) * 128 + n2); *(u32x4*)yp = pk8(xr[0], xr[1]); *(u32x4*)(yp + 64) = pk8(xi[0], xi[1]); }
            asm volatile("" ::: "memory"); }
    }
};
struct EpiStageC {
    static constexpr bool PERM = true; bf16* FM;
    __device__ __forceinline__ void operator()(const f32x4 (&acc)[2][2][4][2], const Unit& u, int wr, int wc, int fr, int fq) const {
        if (wr != 0) return;
        const int bgk1 = 2 * u.pn + (wc >> 1), bg = bgk1 >> 7, k1 = bgk1 & 127, b = bg >> 2, g = bg & 3, c0 = 32 * (wc & 1) + 8 * fq;
#pragma unroll
        for (int m = 0; m < 4; ++m) { const int k2 = 16 * m + fr; f32x4 dr0 = acc[0][0][m][0] - acc[0][1][m][0], dr1 = acc[0][0][m][1] - acc[0][1][m][1], mr0 = acc[0][0][m][0] + acc[0][1][m][0], mr1 = acc[0][0][m][1] + acc[0][1][m][1];
            if (c0 == 0) { dr0.x = acc[0][0][m][0].x; mr0.x = acc[0][1][m][0].x; }
            bf16* o = FM + (size_t)(b * SEQ + k1 + 128 * k2) * 512 + g * 128 + c0; *(u32x4*)o = pk8(dr0, dr1); *(u32x4*)(o + 64) = pk8(mr0, mr1); }
    }
};
struct EpiBf16 {
    static constexpr bool PERM = true, PERM2 = true; bf16* O; int ld;
    __device__ __forceinline__ void operator()(const f32x4 (&acc)[2][2][4][2], const Unit& u, int wr, int wc, int fr, int fq) const {
#pragma unroll
        PG8_EPI_LOOP { const int r = u.pm * BM + ai * HALF + wr * 64 + m * 16 + fr, c = u.pn * BM + wc * 64 + bj * 32 + 8 * fq;
            *(u32x4*)(O + (size_t)r * ld + c) = pk8(acc[ai][bj][m][0], acc[ai][bj][m][1]); }
    }
};
struct EpiMulGate {
    static constexpr bool PERM = true; bf16* O; const unsigned char* G;
    __device__ __forceinline__ void operator()(const f32x4 (&acc)[2][2][4][2], const Unit& u, int wr, int wc, int fr, int fq) const {
#pragma unroll
        for (int ai = 0; ai < 2; ++ai) { u32x2 t[4][2];
#pragma unroll
            for (int m = 0; m < 4; ++m)
#pragma unroll
                for (int bj = 0; bj < 2; ++bj) t[m][bj] = *(const u32x2*)(G + (size_t)(u.pm * BM + ai * HALF + wr * 64 + m * 16 + fr) * DM + u.pn * BM + bj * HALF + wc * 32 + 8 * fq);
            asm volatile("s_waitcnt vmcnt(0)" ::: "memory");
#pragma unroll
            for (int m = 0; m < 4; ++m)
#pragma unroll
                for (int bj = 0; bj < 2; ++bj) { bf16* p = O + (size_t)(u.pm * BM + ai * HALF + wr * 64 + m * 16 + fr) * DM + u.pn * BM + bj * HALF + wc * 32 + 8 * fq;
                    f32x4 g0, g1; unpk8_u8(t[m][bj], g0, g1); *(u32x4*)p = pk8(acc[ai][bj][m][0] * g0, acc[ai][bj][m][1] * g1); } }
    }
};
struct EpiGlu {
    static constexpr bool PERM = true; bf16* MIX; const unsigned char* GS;
    __device__ __forceinline__ void operator()(const f32x4 (&acc)[2][2][4][2], const Unit& u, int wr, int wc, int fr, int fq) const {
#pragma unroll
        for (int ai = 0; ai < 2; ++ai) { u32x2 ts[4]; u32x4 tx[4];
#pragma unroll
            for (int m = 0; m < 4; ++m) { const size_t off = (size_t)(u.pm * BM + ai * HALF + wr * 64 + m * 16 + fr) * DM + u.pn * HALF + wc * 32 + 8 * fq; ts[m] = *(const u32x2*)(GS + off); tx[m] = *(const u32x4*)(MIX + off); }
            asm volatile("s_waitcnt vmcnt(0)" ::: "memory");
#pragma unroll
            for (int m = 0; m < 4; ++m) { const size_t off = (size_t)(u.pm * BM + ai * HALF + wr * 64 + m * 16 + fr) * DM + u.pn * HALF + wc * 32 + 8 * fq;
                f32x4 s0, s1, x0, x1; unpk8_u8(ts[m], s0, s1); unpk8(tx[m], x0, x1);
                *(u32x4*)(MIX + off) = pk8(acc[ai][0][m][0] * sig4(acc[ai][1][m][0]) * s0 + x0, acc[ai][0][m][1] * sig4(acc[ai][1][m][1]) * s1 + x1); } }
    }
};
struct EpiYfGlu {
    static constexpr bool PERM = true; EpiMulGate e0; EpiGlu e1;
    __device__ __forceinline__ void operator()(const f32x4 (&acc)[2][2][4][2], const Unit& u, int wr, int wc, int fr, int fq) const {
        Unit v; v.pm = u.pm; v.pn = u.pn & 0xffff;
        if ((u.pn >> 16) == 0) e0(acc, v, wr, wc, fr, fq); else e1(acc, v, wr, wc, fr, fq);
    }
};
struct EpiResidual {
    static constexpr bool PERM = true, PERM2 = true; bf16* OH; unsigned char* OL; const float* X;
    __device__ __forceinline__ void operator()(const f32x4 (&acc)[2][2][4][2], const Unit& u, int wr, int wc, int fr, int fq) const {
#pragma unroll
        for (int ai = 0; ai < 2; ++ai)
#pragma unroll
            for (int mp = 0; mp < 2; ++mp) { f32x4 t[2][2][2];
#pragma unroll
                for (int mm = 0; mm < 2; ++mm)
#pragma unroll
                    for (int bj = 0; bj < 2; ++bj)
#pragma unroll
                        for (int n = 0; n < 2; ++n) t[mm][bj][n] = *(const f32x4*)(X + (size_t)(u.pm * BM + ai * HALF + wr * 64 + (2 * mp + mm) * 16 + fr) * DM + u.pn * BM + wc * 64 + bj * 32 + 8 * fq + 4 * n);
                u32x2 lo[2][2];
#pragma unroll
                for (int mm = 0; mm < 2; ++mm)
#pragma unroll
                    for (int bj = 0; bj < 2; ++bj) { const int m = 2 * mp + mm; const size_t off = (size_t)(u.pm * BM + ai * HALF + wr * 64 + m * 16 + fr) * DM + u.pn * BM + wc * 64 + bj * 32 + 8 * fq;
                        const f32x4 v0 = t[mm][bj][0] + acc[ai][bj][m][0], v1 = t[mm][bj][1] + acc[ai][bj][m][1]; const u32x4 hi = pk8(v0, v1); f32x4 h0, h1; unpk8(hi, h0, h1);
                        *(u32x4*)(OH + off) = hi; const f32x4 r0 = (v0 - h0) * 4096.0f, r1 = (v1 - h1) * 4096.0f; unsigned tt = 0u;
                        tt = __builtin_amdgcn_cvt_pk_fp8_f32(clamp8(r0.x), clamp8(r0.y), tt, false); tt = __builtin_amdgcn_cvt_pk_fp8_f32(clamp8(r0.z), clamp8(r0.w), tt, true); lo[mm][bj].x = tt; tt = 0u;
                        tt = __builtin_amdgcn_cvt_pk_fp8_f32(clamp8(r1.x), clamp8(r1.y), tt, false); tt = __builtin_amdgcn_cvt_pk_fp8_f32(clamp8(r1.z), clamp8(r1.w), tt, true); lo[mm][bj].y = tt; }
#pragma unroll
                for (int bj = 0; bj < 2; ++bj) { const auto sx = __builtin_amdgcn_permlane16_swap(lo[0][bj].x, lo[1][bj].x, false, false); const auto sy = __builtin_amdgcn_permlane16_swap(lo[0][bj].y, lo[1][bj].y, false, false);
                    const size_t off = (size_t)(u.pm * BM + ai * HALF + wr * 64 + (2 * mp + (fq & 1)) * 16 + fr) * DM + u.pn * BM + wc * 64 + bj * 32 + 16 * (fq >> 1);
                    *(u32x4*)(OL + off) = (u32x4){sx[0], sy[0], sx[1], sy[1]}; } }
    }
};
struct EpiPle {
    static constexpr bool PERM = true, PERM2 = true, SIDE = true; const bf16* XI; bf16* XO; const bf16* EB; const float* RST; float sc;
    __device__ __forceinline__ const float* side_ptr(const Unit& u) const { return RST + (size_t)u.pm * BM; }
    __device__ __forceinline__ void operator()(const f32x4 (&acc)[2][2][4][2], const Unit& u, int wr, int wc, int fr, int fq, const LAS float* sd) const {
        float rs[2][4];
#pragma unroll
        for (int ai = 0; ai < 2; ++ai)
#pragma unroll
            for (int m = 0; m < 4; ++m) rs[ai][m] = sd[ai * HALF + wr * 64 + m * 16 + fr] * sc;
#pragma unroll
        for (int ai = 0; ai < 2; ++ai)
#pragma unroll
            for (int mp = 0; mp < 2; ++mp) { u32x4 tx[2][2], te[2][2];
#pragma unroll
                for (int mm = 0; mm < 2; ++mm)
#pragma unroll
                    for (int bj = 0; bj < 2; ++bj) { const size_t off = (size_t)(u.pm * BM + ai * HALF + wr * 64 + (2 * mp + mm) * 16 + fr) * DM + u.pn * BM + wc * 64 + bj * 32 + 8 * fq; tx[mm][bj] = *(const u32x4*)(XI + off); te[mm][bj] = *(const u32x4*)(EB + off); }
#pragma unroll
                for (int mm = 0; mm < 2; ++mm)
#pragma unroll
                    for (int bj = 0; bj < 2; ++bj) { const int m = 2 * mp + mm; const size_t off = (size_t)(u.pm * BM + ai * HALF + wr * 64 + m * 16 + fr) * DM + u.pn * BM + wc * 64 + bj * 32 + 8 * fq;
                        f32x4 x0, x1, e0, e1; unpk8(tx[mm][bj], x0, x1); unpk8(te[mm][bj], e0, e1);
                        const float nc = rs[ai][m] * -1.4426950408889634f; *(u32x4*)(XO + off) = pk8(x0 + sig4s(acc[ai][bj][m][0], nc, 1.0f) * e0, x1 + sig4s(acc[ai][bj][m][1], nc, 1.0f) * e1); } }
    }
};
struct EpiSwiglu {
    static constexpr bool PERM = true, SIDE = true; unsigned char* HID; const float* rs; float sc, hs;
    __device__ __forceinline__ const float* side_ptr(const Unit& u) const { return rs + (size_t)u.pm * BM; }
    __device__ __forceinline__ void operator()(const f32x4 (&acc)[2][2][4][2], const Unit& u, int wr, int wc, int fr, int fq, const LAS float* sd) const {
#pragma unroll
        for (int ai = 0; ai < 2; ++ai)
#pragma unroll
            for (int m = 0; m < 4; ++m) { const int rl = ai * HALF + wr * 64 + m * 16 + fr, r = u.pm * BM + rl, f = u.pn * HALF + wc * 32 + 8 * fq;
                const float s1 = sd[rl] * sc, s2 = s1 * hs;
                const float nc = s1 * -1.4426950408889634f, s12 = s1 * s2;
                    const f32x4 h0 = (acc[ai][0][m][0] * acc[ai][1][m][0]) * s12 * sig4s(acc[ai][0][m][0], nc, 1.0f), h1 = (acc[ai][0][m][1] * acc[ai][1][m][1]) * s12 * sig4s(acc[ai][0][m][1], nc, 1.0f);
                u32x2 w; unsigned t = 0u; t = __builtin_amdgcn_cvt_pk_fp8_f32(clamp8(h0.x), clamp8(h0.y), t, false); t = __builtin_amdgcn_cvt_pk_fp8_f32(clamp8(h0.z), clamp8(h0.w), t, true); w.x = t;
                t = 0u; t = __builtin_amdgcn_cvt_pk_fp8_f32(clamp8(h1.x), clamp8(h1.y), t, false); t = __builtin_amdgcn_cvt_pk_fp8_f32(clamp8(h1.z), clamp8(h1.w), t, true); w.y = t;
                *(u32x2*)(HID + (size_t)r * DE + f) = w; }
    }
};
struct EpiScaleRows {
    static constexpr bool PERM = true, PERM2 = true, SIDE = true; bf16* O; const float* val; float sc;
    __device__ __forceinline__ const float* side_ptr(const Unit& u) const { return val + (size_t)u.pm * BM; }
    __device__ __forceinline__ void operator()(const f32x4 (&acc)[2][2][4][2], const Unit& u, int wr, int wc, int fr, int fq, const LAS float* sd) const {
#pragma unroll
        for (int ai = 0; ai < 2; ++ai)
#pragma unroll
            for (int m = 0; m < 4; ++m) { const int rl = ai * HALF + wr * 64 + m * 16 + fr, r = u.pm * BM + rl; const float s = sd[rl] * sc;
#pragma unroll
                for (int bj = 0; bj < 2; ++bj) { const int c = u.pn * BM + wc * 64 + bj * 32 + 8 * fq; *(u32x4*)(O + (size_t)r * DM + c) = pk8(acc[ai][bj][m][0] * s, acc[ai][bj][m][1] * s); } }
    }
};
}

__device__ __forceinline__ void rms_row_to_bf16(const float* xrow, const float* g, bf16* orow, int lane) {
    const f32x4* xr = (const f32x4*)xrow + lane; const f32x4* gr = (const f32x4*)g + lane;
    f32x4 v[4]; float s = 0.f;
#pragma unroll
    for (int j = 0; j < 4; ++j) { v[j] = xr[64 * j]; s += (v[j].x * v[j].x + v[j].y * v[j].y) + (v[j].z * v[j].z + v[j].w * v[j].w); }
    const float rstd = 1.0f / sqrtf(wave_sum(s) * (1.0f / DM) + RMS_EPS);
#pragma unroll
    for (int j = 0; j < 4; ++j) { const f32x4 gg = gr[64 * j]; store_bf16x4(orow + 4 * lane + 256 * j, (f32x4){v[j].x * rstd * gg.x, v[j].y * rstd * gg.y, v[j].z * rstd * gg.z, v[j].w * rstd * gg.w}); }
}

struct EpiStageA {
    bf16* Y; const f32x2* TW;
    __device__ __forceinline__ void tile(int row, int col, const f32x4 (&acc)[4][2]) const {
#pragma unroll
        for (int mp = 0; mp < 2; ++mp) { const int r = row + 32 * mp, k1 = ((r >> 5) << 4) | (r & 15);
#pragma unroll
            for (int n = 0; n < 2; ++n) { const int c = col + 16 * n, bg = c >> 13, pqc = (c >> 6) & 127, n2 = c & 63; f32x4 xr, xi;
#pragma unroll
                for (int j = 0; j < 4; ++j) { const f32x2 tw = TW[(n2 + j) * k1]; const float ar = acc[2 * mp][n][j], ai = acc[2 * mp + 1][n][j];
                    const float br = ar * tw.x + ai * tw.y, bi = ai * tw.x - ar * tw.y; if (pqc >= 65) { xr[j] = -bi; xi[j] = br; } else { xr[j] = br; xi[j] = bi; } }
                bf16* yp = Y + (((size_t)(bg * 128 + k1) * 128 + pqc) * 128 + n2); store_bf16x4(yp, xr); store_bf16x4(yp + 64, xi); } }
    }
};
struct EpiF32Plain { float* O; int ld;
    __device__ __forceinline__ void tile(int row, int col, const f32x4 (&acc)[4][2]) const {
#pragma unroll
        for (int m = 0; m < 4; ++m)
#pragma unroll
            for (int n = 0; n < 2; ++n) *(f32x4*)(O + (size_t)(row + 16 * m) * ld + col + 16 * n) = acc[m][n];
    }
};

struct OpDft2 {
    static constexpr bool ROWFAST = false; const bf16* D2;
    __device__ __forceinline__ bf16x8 load8(int row, int k0) const { if (row < 64) return *(const bf16x8*)(D2 + row * 128 + k0); return (bf16x8){0, 0, 0, 0, 0, 0, 0, 0}; }
};
struct OpYcols {
    static constexpr bool ROWFAST = false; const bf16* Y;
    __device__ __forceinline__ bf16x8 load8(int n, int k0) const { const int w = n & 127, c = ((w >> 5) << 4) | (w & 15), pq = (w >> 4) & 1; return *(const bf16x8*)(Y + ((size_t)(n >> 7) * 128 + pq * 64 + c) * 128 + k0); }
};
struct EpiStageC {
    bf16* FM;
    __device__ __forceinline__ void tile(int row, int col, const f32x4 (&acc)[4][2]) const {
        const int bgk1 = col >> 7, bg = bgk1 >> 7, k1 = bgk1 & 127, b = bg >> 2, g = bg & 3, c0 = (((col & 127) >> 5) << 4) | (col & 15);
#pragma unroll
        for (int m = 0; m < 4; ++m) { const int k2 = row + 16 * m; if (k2 < 64) { const f32x4 P = acc[m][0], Q = acc[m][1]; f32x4 dr = P - Q, mr = P + Q; if (c0 == 0) { dr.x = P.x; mr.x = Q.x; }
            bf16* o = FM + (size_t)(b * SEQ + k1 + 128 * k2) * 512 + g * 128 + c0; store_bf16x4(o, dr); store_bf16x4(o + 64, mr); } }
    }
};


__device__ __forceinline__ void phase_router(Frame& F, KArgs a) {
    unsigned char* ws = F.ws; unsigned char* H2 = ws + WS_H; float* AFF = (float*)(ws + OFF_AFF); float* RSD = (float*)(ws + OFF_RSD); (void)a;
    const int gw = F.bid * 8 + F.wave, NW = F.G * 8, lane = F.lane(), ri = lane & 15, q = lane >> 4;
    LAS f32x4* wl = (LAS f32x4*)F.lds;
    { const float* src = (const float*)(ws + OFF_WGT); for (int idx = F.tid(); idx < 8192; idx += NTHR) { const int h = idx & 1, e = (idx >> 1) & 15, qq = (idx >> 5) & 3, Tt = idx >> 7; wl[idx] = *(const f32x4*)(src + e * DM + 64 * (Tt >> 1) + 16 * qq + 8 * (Tt & 1) + 4 * h); } }
    asm volatile("s_waitcnt vmcnt(0)" ::: "memory"); __syncthreads();
    for (int tile = gw; tile < T / 16; tile += NW) { const int m0 = tile * 16;
        const u32x4* xh = (const u32x4*)((const bf16*)F.xo + (size_t)(m0 + ri) * DM) + 2 * q;
        const u32x2* xl = (const u32x2*)((const unsigned char*)((const bf16*)F.xo + (size_t)T * DM) + (size_t)(m0 + ri) * DM) + 2 * q;
        LAS unsigned char* hb = F.lds + 65536 + F.wave * 8448; const LAS f32x4* wrow = wl + 2 * lane;
        f32x4 ac0 = (f32x4){0.f, 0.f, 0.f, 0.f}, ac1 = ac0, ac2 = ac0, ac3 = ac0; float ss = 0.f;
#pragma unroll 1
        for (int half = 0; half < 2; ++half) { u32x4 vh[16]; u32x2 vl[16];
#pragma unroll
            for (int t = 0; t < 16; ++t) { const int ix = 8 * (8 * half + (t >> 1)) + (t & 1); vh[t] = xh[ix]; vl[t] = xl[ix]; }
            asm volatile("s_waitcnt vmcnt(0)" ::: "memory");
#pragma unroll
            for (int tp = 0; tp < 8; ++tp) { u32x4 w16;
#pragma unroll
                for (int sx = 0; sx < 2; ++sx) { const int t = 2 * tp + sx, Tt = 16 * half + t; f32x4 a0, a1; pg8::unpk8(vh[t], a0, a1); constexpr float ki = 1.0f / 4096.0f;
                    const f32x4 x0 = (f32x4){__builtin_amdgcn_cvt_f32_fp8(vl[t].x, 0), __builtin_amdgcn_cvt_f32_fp8(vl[t].x, 1), __builtin_amdgcn_cvt_f32_fp8(vl[t].x, 2), __builtin_amdgcn_cvt_f32_fp8(vl[t].x, 3)} * ki + a0;
                    const f32x4 x1 = (f32x4){__builtin_amdgcn_cvt_f32_fp8(vl[t].y, 0), __builtin_amdgcn_cvt_f32_fp8(vl[t].y, 1), __builtin_amdgcn_cvt_f32_fp8(vl[t].y, 2), __builtin_amdgcn_cvt_f32_fp8(vl[t].y, 3)} * ki + a1;
                    const f32x4 w0 = wrow[128 * Tt], w1 = wrow[128 * Tt + 1];
                    ss += ((x0.x * x0.x + x0.y * x0.y) + (x0.z * x0.z + x0.w * x0.w)) + ((x1.x * x1.x + x1.y * x1.y) + (x1.z * x1.z + x1.w * x1.w));
                    unsigned tt = 0u; tt = __builtin_amdgcn_cvt_pk_fp8_f32(clamp8(x0.x), clamp8(x0.y), tt, false); tt = __builtin_amdgcn_cvt_pk_fp8_f32(clamp8(x0.z), clamp8(x0.w), tt, true); w16[2 * sx] = tt;
                    tt = 0u; tt = __builtin_amdgcn_cvt_pk_fp8_f32(clamp8(x1.x), clamp8(x1.y), tt, false); tt = __builtin_amdgcn_cvt_pk_fp8_f32(clamp8(x1.z), clamp8(x1.w), tt, true); w16[2 * sx + 1] = tt;
                    ac0 = __builtin_amdgcn_mfma_f32_16x16x4f32(x0.x, w0.x, ac0, 0, 0, 0); ac1 = __builtin_amdgcn_mfma_f32_16x16x4f32(x0.y, w0.y, ac1, 0, 0, 0);
                    ac2 = __builtin_amdgcn_mfma_f32_16x16x4f32(x0.z, w0.z, ac2, 0, 0, 0); ac3 = __builtin_amdgcn_mfma_f32_16x16x4f32(x0.w, w0.w, ac3, 0, 0, 0);
                    ac0 = __builtin_amdgcn_mfma_f32_16x16x4f32(x1.x, w1.x, ac0, 0, 0, 0); ac1 = __builtin_amdgcn_mfma_f32_16x16x4f32(x1.y, w1.y, ac1, 0, 0, 0);
                    ac2 = __builtin_amdgcn_mfma_f32_16x16x4f32(x1.z, w1.z, ac2, 0, 0, 0); ac3 = __builtin_amdgcn_mfma_f32_16x16x4f32(x1.w, w1.w, ac3, 0, 0, 0); }
                *(LAS u32x4*)(hb + ri * 528 + 64 * tp + 16 * q) = w16; }
            asm volatile("s_waitcnt lgkmcnt(0)" ::: "memory");
#pragma unroll
            for (int i = 0; i < 8; ++i) { const int row = 2 * i + (lane >> 5), pc = lane & 31;
                *(u32x4*)(H2 + (size_t)(m0 + row) * DM + 512 * half + 16 * pc) = *(const LAS u32x4*)(hb + row * 528 + 16 * pc); }
            asm volatile("s_waitcnt lgkmcnt(0)" ::: "memory");
        }
        ss += __shfl_xor(ss, 16); ss += __shfl_xor(ss, 32);
        const float rstd = 1.0f / sqrtf(ss * (1.0f / DM) + RMS_EPS);
        if (q == 0) RSD[m0 + ri] = rstd;
        const f32x4 lgv = (ac0 + ac1) + (ac2 + ac3);
#pragma unroll
        for (int r = 0; r < 4; ++r) { const float rs = __shfl(rstd, 4 * q + r); const float lg = lgv[r] * rs; float mx = lg;
#pragma unroll
            for (int o = 1; o < 16; o <<= 1) mx = fmaxf(mx, __shfl_xor(mx, o));
            const float ex = expf(lg - mx); float den = ex;
#pragma unroll
            for (int o = 1; o < 16; o <<= 1) den += __shfl_xor(den, o);
            AFF[(size_t)(m0 + 4 * q + r) * NE + ri] = ex / den; }
    }
}
__device__ __forceinline__ void phase_topk(Frame& F, KArgs a) {
    unsigned char* ws = F.ws; const float* AFF = (const float*)(ws + OFF_AFF); int* IDX = (int*)(ws + OFF_IDX); float* VAL = (float*)(ws + OFF_VAL); int* SLOT = (int*)(ws + OFF_SLOT); const float* RSD = (const float*)(ws + OFF_RSD); float* RSS = (float*)(ws + OFF_RSS);
    LAS unsigned* keys = (LAS unsigned*)F.lds; LAS unsigned* hist = keys + SEQ; LAS unsigned* ctl = hist + 256; LAS unsigned* wtot = ctl + 8;
    const int tid = F.tid(), lane = F.lane(), wave = F.wave;
    for (int be = F.bid; be < NB * NE; be += F.G) { const int b = be >> 4, e = be & 15; const float* src = AFF + (size_t)b * SEQ * NE + e;
        __syncthreads();
        for (int i = tid; i < SEQ; i += NTHR) keys[i] = __float_as_uint(src[(size_t)i * NE]);
        if (tid == 0) { ctl[0] = 0u; ctl[1] = CAP; }
        unsigned mask = 0u;
        for (int p = 3; p >= 0; --p) {
            if (tid < 256) hist[tid] = 0u;
            __syncthreads();
            const unsigned prefix = ctl[0];
            for (int i = tid; i < SEQ; i += NTHR) { const unsigned k = keys[i]; if ((k & mask) == prefix) atomicAdd((unsigned*)&hist[(k >> (8 * p)) & 255u], 1u); }
            __syncthreads();
            if (wave == 0) {
                const unsigned need = ctl[1]; const unsigned h0 = hist[4 * lane], h1 = hist[4 * lane + 1], h2 = hist[4 * lane + 2], h3 = hist[4 * lane + 3]; const unsigned loc = (h0 + h1) + (h2 + h3);
                unsigned suf = loc;
#pragma unroll
                for (int o = 1; o < 64; o <<= 1) { const unsigned t = __shfl_down(suf, o); if (lane + o < 64) suf += t; }
                const unsigned above = suf - loc;
                if (above < need && need <= suf) { unsigned cum = above; int bsel;
                    if (cum + h3 >= need) bsel = 4 * lane + 3; else { cum += h3; if (cum + h2 >= need) bsel = 4 * lane + 2; else { cum += h2; if (cum + h1 >= need) bsel = 4 * lane + 1; else { cum += h1; bsel = 4 * lane; } } }
                    ctl[0] = prefix | ((unsigned)bsel << (8 * p)); ctl[1] = need - cum; } }
            mask |= 0xFFu << (8 * p);
            __syncthreads();
        }
        const unsigned Tk = ctl[0], need_eq = ctl[1];
        unsigned cg = 0u, ce = 0u; unsigned kk[16];
#pragma unroll
        for (int q = 0; q < 16; ++q) { kk[q] = keys[tid * 16 + q]; cg += kk[q] > Tk ? 1u : 0u; ce += kk[q] == Tk ? 1u : 0u; }
        unsigned ig = cg, ie = ce;
#pragma unroll
        for (int o = 1; o < 64; o <<= 1) { const unsigned tg = __shfl_up(ig, o), te = __shfl_up(ie, o); if (lane >= o) { ig += tg; ie += te; } }
        if (lane == 63) { wtot[wave] = ig; wtot[8 + wave] = ie; }
        __syncthreads();
        unsigned bg = ig - cg, beq = ie - ce;
        for (int w = 0; w < wave; ++w) { bg += wtot[w]; beq += wtot[8 + w]; }
#pragma unroll
        for (int q = 0; q < 16; ++q) { const unsigned k = kk[q]; const bool gtv = k > Tk, eqv = k == Tk; const bool sel = gtv || (eqv && beq < need_eq);
            if (sel) { const unsigned pos = bg + (beq < need_eq ? beq : need_eq); const int i = tid * 16 + q; const int slot = b * CAP + (int)pos;
                IDX[e * 4096 + slot] = b * SEQ + i; VAL[e * 4096 + slot] = __uint_as_float(k); RSS[e * 4096 + slot] = RSD[b * SEQ + i]; SLOT[(size_t)e * T + b * SEQ + i] = slot; }
            bg += gtv ? 1u : 0u; beq += eqv ? 1u : 0u; }
    }
}

__device__ __forceinline__ void phase_final(Frame& F, KArgs a) {
    const float* g = a->in[23]; const bf16* X3B = (const bf16*)(F.ws + WS_X3B); const int gw = F.bid * 8 + F.wave, NW = F.G * 8, lane = F.lane();
    f32x4 gg[4];
#pragma unroll
    for (int j = 0; j < 4; ++j) gg[j] = ((const f32x4*)g + lane)[64 * j];
    asm volatile("s_waitcnt vmcnt(0)" ::: "memory");
    for (int m0 = gw * 4; m0 < T; m0 += NW * 4) { f32x4 v[4][4];
#pragma unroll
        for (int r = 0; r < 4; ++r)
#pragma unroll
            for (int j = 0; j < 4; ++j) { const u32x2 w = __builtin_nontemporal_load((const u32x2*)(X3B + (size_t)(m0 + r) * DM + 4 * lane + 256 * j)); v[r][j] = (f32x4){__uint_as_float(w.x << 16), __uint_as_float(w.x & 0xffff0000u), __uint_as_float(w.y << 16), __uint_as_float(w.y & 0xffff0000u)}; }
#pragma unroll
        for (int r = 0; r < 4; ++r) { float sq = 0.f; f32x4* xr = (f32x4*)(F.xo + (size_t)(m0 + r) * DM) + lane;
#pragma unroll
            for (int j = 0; j < 4; ++j) sq += (v[r][j].x * v[r][j].x + v[r][j].y * v[r][j].y) + (v[r][j].z * v[r][j].z + v[r][j].w * v[r][j].w);
            const float rstd = 1.0f / sqrtf(wave_sum(sq) * (1.0f / DM) + RMS_EPS);
#pragma unroll
            for (int j = 0; j < 4; ++j) __builtin_nontemporal_store((f32x4){v[r][j].x * rstd * gg[j].x, v[r][j].y * rstd * gg[j].y, v[r][j].z * rstd * gg[j].z, v[r][j].w * rstd * gg[j].w}, xr + 64 * j); }
    }
}


__device__ __forceinline__ void transpose_item(const float* W, int ld, int c0, int k0, bf16* dst, int ldd, LAS float* scr, int lane) {
#pragma unroll 8
    for (int i = 0; i < 32; ++i) { const int kk = 2 * i + (lane >> 5); scr[kk * 33 + (lane & 31)] = W[(size_t)(k0 + kk) * ld + c0 + (lane & 31)]; }
    asm volatile("s_waitcnt vmcnt(0) lgkmcnt(0)" ::: "memory");
    const int c = lane & 7;
#pragma unroll
    for (int j = 0; j < 4; ++j) { const int n = (lane >> 3) + 8 * j; const LAS float* s = scr + (8 * c) * 33 + n;
        u32x4 o; o.x = cvt_pk_bf16(s[0 * 33], s[1 * 33]); o.y = cvt_pk_bf16(s[2 * 33], s[3 * 33]); o.z = cvt_pk_bf16(s[4 * 33], s[5 * 33]); o.w = cvt_pk_bf16(s[6 * 33], s[7 * 33]);
        *(u32x4*)(dst + (size_t)n * ldd + k0 + 8 * c) = o; }
    asm volatile("s_waitcnt lgkmcnt(0)" ::: "memory");
}
__device__ __forceinline__ int kperm_fourier(int p) { const int g = p >> 7, q = p & 127; return g * 128 + (q <= 64 ? q : 192 - q); }
template <bool KMAP>
__device__ __forceinline__ void transpose_item_t(const float* W, int ld, int c0, int k0, bf16* dst, int ldd, LAS float* scr, int lane) {
#pragma unroll 8
    for (int i = 0; i < 32; ++i) { const int kk = 2 * i + (lane >> 5); const int ks = KMAP ? kperm_fourier(k0 + kk) : (k0 + kk); scr[kk * 33 + (lane & 31)] = W[(size_t)ks * ld + c0 + (lane & 31)]; }
    asm volatile("s_waitcnt vmcnt(0) lgkmcnt(0)" ::: "memory");
    const int c = lane & 7;
#pragma unroll
    for (int j = 0; j < 4; ++j) { const int n = (lane >> 3) + 8 * j; const LAS float* s = scr + (8 * c) * 33 + n;
        u32x4 o; o.x = cvt_pk_bf16(s[0 * 33], s[1 * 33]); o.y = cvt_pk_bf16(s[2 * 33], s[3 * 33]); o.z = cvt_pk_bf16(s[4 * 33], s[5 * 33]); o.w = cvt_pk_bf16(s[6 * 33], s[7 * 33]);
        *(u32x4*)(dst + (size_t)n * ldd + k0 + 8 * c) = o; }
    asm volatile("s_waitcnt lgkmcnt(0)" ::: "memory");
}

struct OpTcTab {
    static constexpr bool ROWFAST = false; const LAS float* ct; const LAS float* st;
    __device__ __forceinline__ bf16x8 load8(int pqc, int k0) const { float v[8];
#pragma unroll
        for (int q = 0; q < 8; ++q) { const int c = k0 + q; v[q] = pqc < 64 ? ct[(c * pqc) & 127] : (pqc == 64 ? ((c & 1) ? -1.f : 1.f) : st[(c * (pqc - 64)) & 127]); }
        return pack8((f32x4){v[0], v[1], v[2], v[3]}, (f32x4){v[4], v[5], v[6], v[7]}); }
};
struct EpiBf16Plain { bf16* O; int ld;
    __device__ __forceinline__ void tile(int row, int col, const f32x4 (&acc)[4][2]) const {
#pragma unroll
        for (int m = 0; m < 4; ++m)
#pragma unroll
            for (int n = 0; n < 2; ++n) store_bf16x4(O + (size_t)(row + 16 * m) * ld + col + 16 * n, acc[m][n]);
    }
};
__device__ __forceinline__ void ssm_tables_group(Frame& F, KArgs a, int g, int part) {
    unsigned char* ws = F.ws; const int tid = F.tid();
    LAS f32x2* LB = (LAS f32x2*)(F.lds); LAS f32x2* BBl = (LAS f32x2*)(F.lds + 33280); LAS f32x2* Cl = (LAS f32x2*)(F.lds + 41472);
    LAS bf16* KTb = (LAS bf16*)(F.lds + 49664); LAS float* K0 = (LAS float*)(F.lds + 115200);
    const float* a_re = a->in[5]; const float* a_im = a->in[6]; const float* log_dt = a->in[7]; const float* b_re = a->in[8]; const float* b_im = a->in[9];
    const float* c_re = a->in[10]; const float* c_im = a->in[11]; const float* dvec = a->in[12];
    bf16* WE = (bf16*)(ws + WS_WEND) + (size_t)g * 256 * 1024; bf16* KC = (bf16*)(ws + WS_KC) + (size_t)g * 128 * 256; bf16* CT = (bf16*)(ws + WS_CT) + (size_t)g * 1024 * 256; f32x2* L64 = (f32x2*)(ws + OFF_L64);
    for (int d = 0; d < 2; ++d) {
        const int dg = d * NG + g; const float dt = expf(log_dt[dg]);
        __syncthreads();
        for (int it = tid; it < 64 * 65; it += NTHR) { const int n = it / 65, p = it - n * 65; const float are = a_re[dg * 64 + n], aim = a_im[dg * 64 + n];
            const float mag = expf(are * dt * (float)p); const double tr = (double)aim * (double)dt * (double)p * 0.15915494309189535; const float fr_ = (float)(tr - __builtin_rint(tr));
            float s_, c_; sincospif(2.0f * fr_, &s_, &c_); const f32x2 v = (f32x2){mag * c_, mag * s_}; LB[it] = v; if (p == 64 && part == 0) L64[dg * 64 + n] = v; }
        for (int it = tid; it < 64 * 16; it += NTHR) { const int n = it >> 4; const float are = a_re[dg * 64 + n], aim = a_im[dg * 64 + n];
            const float em1 = expm1f(are * dt), th = aim * dt; float sh, ch, s_, c_; sincosf(0.5f * th, &sh, &ch); sincosf(th, &s_, &c_); (void)ch;
            const float lr = em1 * c_ - 2.0f * sh * sh, li = (1.0f + em1) * s_, den = are * are + aim * aim, qr = (lr * are + li * aim) / den, qi = (li * are - lr * aim) / den;
            const float br = b_re[(size_t)dg * 1024 + it], bi = b_im[(size_t)dg * 1024 + it]; BBl[it] = (f32x2){qr * br - qi * bi, qr * bi + qi * br};
            Cl[it] = (f32x2){c_re[(size_t)dg * 1024 + it], c_im[(size_t)dg * 1024 + it]}; }
        asm volatile("s_waitcnt vmcnt(0)" ::: "memory"); __syncthreads();
        { const int lane = F.lane(), o_a = lane & 15, nq = 4 * (lane >> 4); f32x2 creg[4][4]; bf16x8 bfr[4];
#pragma unroll
          for (int q = 0; q < 4; ++q) { float bv[8];
#pragma unroll
              for (int jj = 0; jj < 4; ++jj) { const int n = 16 * q + nq + jj; creg[q][jj] = Cl[o_a * 64 + n]; const f32x2 b = BBl[n * 16 + (lane & 15)]; bv[2 * jj] = b.x; bv[2 * jj + 1] = b.y; }
              bfr[q] = pack8((f32x4){bv[0], bv[1], bv[2], bv[3]}, (f32x4){bv[4], bv[5], bv[6], bv[7]}); }
          for (int k = F.wave; k < 64; k += 8) { f32x4 acc = (f32x4){0.f, 0.f, 0.f, 0.f};
#pragma unroll
              for (int q = 0; q < 4; ++q) { float av[8];
#pragma unroll
                  for (int jj = 0; jj < 4; ++jj) { const int n = 16 * q + nq + jj; const f32x2 l = LB[n * 65 + k], c = creg[q][jj]; av[2 * jj] = c.x * l.x - c.y * l.y; av[2 * jj + 1] = -(c.x * l.y + c.y * l.x); }
                  acc = __builtin_amdgcn_mfma_f32_16x16x32_bf16(pack8((f32x4){av[0], av[1], av[2], av[3]}, (f32x4){av[4], av[5], av[6], av[7]}), bfr[q], acc, 0, 0, 0); }
#pragma unroll
              for (int r = 0; r < 4; ++r) { const int o = (lane >> 4) * 4 + r, i = lane & 15, oi = o * 16 + i; KTb[(d * 64 + k) * 256 + oi] = (bf16)(cvt_pk_bf16(acc[r], 0.f) & 0xffffu);
                  if (k == 0) { if (d == 0) K0[oi] = acc[r] + (o == i ? dvec[g * 16 + o] : 0.f); else K0[oi] += acc[r]; } } } }
        for (int it = part * 4096 + tid; it < (part + 1) * 4096; it += NTHR) { const int kc = it & 127, rr = it >> 7, n = rr >> 1, ri = rr & 1, j = kc >> 1, i0 = (kc & 1) * 8; const f32x2 l = LB[n * 65 + (d ? j : 63 - j)]; float v[8];
#pragma unroll
            for (int q = 0; q < 8; ++q) { const f32x2 b = BBl[n * 16 + i0 + q]; v[q] = ri ? (l.x * b.y + l.y * b.x) : (l.x * b.x - l.y * b.y); }
            *(bf16x8*)(WE + ((size_t)(d * 128 + rr) * 1024 + kc * 8)) = pack8((f32x4){v[0], v[1], v[2], v[3]}, (f32x4){v[4], v[5], v[6], v[7]}); }
        for (int it = part * 4096 + tid; it < (part + 1) * 4096; it += NTHR) { const int nb = (it & 15) * 4, row = it >> 4, sI = row >> 4, o = row & 15, p = d ? 64 - sI : sI + 1; float v[8];
#pragma unroll
            for (int q = 0; q < 4; ++q) { const f32x2 c = Cl[o * 64 + nb + q], l = LB[(nb + q) * 65 + p]; v[2 * q] = c.x * l.x - c.y * l.y; v[2 * q + 1] = -(c.x * l.y + c.y * l.x); }
            *(bf16x8*)(CT + ((size_t)row * 256 + d * 128 + nb * 2)) = pack8((f32x4){v[0], v[1], v[2], v[3]}, (f32x4){v[4], v[5], v[6], v[7]}); }
    }
    __syncthreads();
    for (int it = part * 1024 + tid; it < (part + 1) * 1024; it += NTHR) { const int L = it >> 5, pc = (it & 31) * 8; bf16x8 w;
        if (L == 127) continue;
        if (L != 63) { const int d = L > 63 ? 0 : 1, lag = L > 63 ? L - 63 : 63 - L; w = *(const LAS bf16x8*)(KTb + (d * 64 + lag) * 256 + pc); }
        else { const LAS float* k0 = K0 + pc; w = pack8((f32x4){k0[0], k0[1], k0[2], k0[3]}, (f32x4){k0[4], k0[5], k0[6], k0[7]}); }
        *(bf16x8*)(KC + (size_t)L * 256 + pc) = w; }
    __syncthreads();
}

__device__ __forceinline__ void transpose_item_fp8(const float* W, const float* gs, int ld, int c0, int k0, unsigned char* dst, int ldd, float scale, LAS float* scr, int lane) {
    { const int r8 = lane >> 3, c4 = (lane & 7) * 4; f32x4 v[8];
#pragma unroll
      for (int i = 0; i < 8; ++i) v[i] = __builtin_nontemporal_load((const f32x4*)(W + (size_t)(k0 + 8 * i + r8) * ld + c0 + c4));
#pragma unroll
      for (int i = 0; i < 8; ++i) { const float gk = gs ? gs[k0 + 8 * i + r8] : 1.0f; LAS float* p = scr + (8 * i + r8) * 33 + c4; p[0] = v[i].x * gk; p[1] = v[i].y * gk; p[2] = v[i].z * gk; p[3] = v[i].w * gk; } }
    asm volatile("s_waitcnt vmcnt(0) lgkmcnt(0)" ::: "memory");
    const int c = lane & 3;
#pragma unroll
    for (int j = 0; j < 2; ++j) { const int n = (lane >> 2) + 16 * j; const LAS float* s = scr + (16 * c) * 33 + n; u32x4 o;
#pragma unroll
        for (int q = 0; q < 4; ++q) { unsigned w8 = 0u; w8 = __builtin_amdgcn_cvt_pk_fp8_f32(clamp8(s[(4 * q) * 33] * scale), clamp8(s[(4 * q + 1) * 33] * scale), w8, false); w8 = __builtin_amdgcn_cvt_pk_fp8_f32(clamp8(s[(4 * q + 2) * 33] * scale), clamp8(s[(4 * q + 3) * 33] * scale), w8, true); o[q] = w8; }
        *(u32x4*)(dst + (size_t)n * ldd + k0 + 16 * c) = o; }
    asm volatile("s_waitcnt lgkmcnt(0)" ::: "memory");
}
__device__ __forceinline__ void transpose_item64_fp8(const float* W, const float* gs, int ld, int c0, int k0, unsigned char* dst, int ldd, float scale, LAS float* scr, int lane) {
    { const int r4 = lane >> 4, c4 = (lane & 15) * 4; f32x4 v[16];
#pragma unroll
      for (int i = 0; i < 16; ++i) v[i] = __builtin_nontemporal_load((const f32x4*)(W + (size_t)(k0 + 4 * i + r4) * ld + c0 + c4));
#pragma unroll
      for (int i = 0; i < 16; ++i) { const float gk = gs ? gs[k0 + 4 * i + r4] : 1.0f; LAS float* p = scr + (4 * i + r4) * 65 + c4; p[0] = v[i].x * gk; p[1] = v[i].y * gk; p[2] = v[i].z * gk; p[3] = v[i].w * gk; } }
    asm volatile("s_waitcnt vmcnt(0) lgkmcnt(0)" ::: "memory");
    const int c = lane & 3;
#pragma unroll
    for (int j = 0; j < 4; ++j) { const int n = (lane >> 2) + 16 * j; const LAS float* s = scr + (16 * c) * 65 + n; u32x4 o;
#pragma unroll
        for (int q = 0; q < 4; ++q) { unsigned w8 = 0u; w8 = __builtin_amdgcn_cvt_pk_fp8_f32(clamp8(s[(4 * q) * 65] * scale), clamp8(s[(4 * q + 1) * 65] * scale), w8, false); w8 = __builtin_amdgcn_cvt_pk_fp8_f32(clamp8(s[(4 * q + 2) * 65] * scale), clamp8(s[(4 * q + 3) * 65] * scale), w8, true); o[q] = w8; }
        *(u32x4*)(dst + (size_t)n * ldd + k0 + 16 * c) = o; }
    asm volatile("s_waitcnt lgkmcnt(0)" ::: "memory");
}
__device__ __forceinline__ void transpose_pair64_fp8(const float* W, const float* gs, int ld, int c0, int k0, unsigned char* dst, int ldd, float scale, LAS float* scr, int lane) {
    u32x4 o[2][4]; const int c = lane & 3;
#pragma unroll
    for (int tl = 0; tl < 2; ++tl) { const int kt = k0 + 64 * tl;
        { const int r4 = lane >> 4, c4 = (lane & 15) * 4; f32x4 v[16];
#pragma unroll
          for (int i = 0; i < 16; ++i) v[i] = __builtin_nontemporal_load((const f32x4*)(W + (size_t)(kt + 4 * i + r4) * ld + c0 + c4));
#pragma unroll
          for (int i = 0; i < 16; ++i) { const float gk = gs ? gs[kt + 4 * i + r4] : 1.0f; LAS float* p = scr + (4 * i + r4) * 65 + c4; p[0] = v[i].x * gk; p[1] = v[i].y * gk; p[2] = v[i].z * gk; p[3] = v[i].w * gk; } }
        asm volatile("s_waitcnt vmcnt(0) lgkmcnt(0)" ::: "memory");
#pragma unroll
        for (int j = 0; j < 4; ++j) { const int n = (lane >> 2) + 16 * j; const LAS float* sp = scr + (16 * c) * 65 + n;
#pragma unroll
            for (int q = 0; q < 4; ++q) { unsigned w8 = 0u; w8 = __builtin_amdgcn_cvt_pk_fp8_f32(clamp8(sp[(4 * q) * 65] * scale), clamp8(sp[(4 * q + 1) * 65] * scale), w8, false); w8 = __builtin_amdgcn_cvt_pk_fp8_f32(clamp8(sp[(4 * q + 2) * 65] * scale), clamp8(sp[(4 * q + 3) * 65] * scale), w8, true); o[tl][j][q] = w8; } }
        asm volatile("s_waitcnt lgkmcnt(0)" ::: "memory"); }
    LAS unsigned char* B = (LAS unsigned char*)scr;
#pragma unroll
    for (int tl = 0; tl < 2; ++tl)
#pragma unroll
        for (int j = 0; j < 4; ++j) *(LAS u32x4*)(B + ((lane >> 2) + 16 * j) * 144 + 64 * tl + 16 * c) = o[tl][j];
    asm volatile("s_waitcnt lgkmcnt(0)" ::: "memory");
#pragma unroll
    for (int i = 0; i < 8; ++i) { const int row = (lane >> 3) + 8 * i, pc = lane & 7; *(u32x4*)(dst + (size_t)row * ldd + k0 + 16 * pc) = *(const LAS u32x4*)(B + row * 144 + 16 * pc); }
    asm volatile("s_waitcnt lgkmcnt(0)" ::: "memory");
}
__device__ __forceinline__ void transpose_item_rowscale(const float* W, const float* gs, int ld, int c0, int k0, bf16* dst, int ldd, LAS float* scr, int lane) {
#pragma unroll 8
    for (int i = 0; i < 32; ++i) { const int kk = 2 * i + (lane >> 5); scr[kk * 33 + (lane & 31)] = W[(size_t)(k0 + kk) * ld + c0 + (lane & 31)] * gs[k0 + kk]; }
    asm volatile("s_waitcnt vmcnt(0) lgkmcnt(0)" ::: "memory");
    const int c = lane & 7;
#pragma unroll
    for (int j = 0; j < 4; ++j) { const int n = (lane >> 3) + 8 * j; const LAS float* s = scr + (8 * c) * 33 + n;
        u32x4 o; o.x = cvt_pk_bf16(s[0 * 33], s[1 * 33]); o.y = cvt_pk_bf16(s[2 * 33], s[3 * 33]); o.z = cvt_pk_bf16(s[4 * 33], s[5 * 33]); o.w = cvt_pk_bf16(s[6 * 33], s[7 * 33]);
        *(u32x4*)(dst + (size_t)n * ldd + k0 + 8 * c) = o; }
    asm volatile("s_waitcnt lgkmcnt(0)" ::: "memory");
}
__device__ __forceinline__ void phase0(Frame& F, KArgs a, int qword = 2048) {
    const int NBUILD = F.G >= 192 ? 4 * NG : 0; const bool builder = F.bid < NBUILD; const int rb = builder ? 0 : F.bid - NBUILD, RG = F.G - NBUILD;
    const int gt = builder ? (1 << 30) : rb * NTHR + F.tid(), NT = RG * NTHR, gw = builder ? (1 << 30) : rb * 8 + F.wave, NW = RG * 8;
    const float* x = a->in[0]; const float* g_mix = a->in[2]; const float* w_in = a->in[3];
    unsigned char* ws = F.ws;
    LAS float* ct = (LAS float*)(F.lds + 96 * 1024); LAS float* st = ct + 128;
    if (F.tid() < 128) { float s, c; sincospif((float)F.tid() / 64.0f, &s, &c); ct[F.tid()] = c; st[F.tid()] = s; }
    __syncthreads();
    if (NBUILD == 0) { for (int u = F.bid; u < 4 * NG; u += F.G) ssm_tables_group(F, a, u >> 2, u & 3); }
    if (builder) { ssm_tables_group(F, a, F.bid >> 2, F.bid & 3);
        if (F.tid() < 128) { float s, c; sincospif((float)F.tid() / 64.0f, &s, &c); ct[F.tid()] = c; st[F.tid()] = s; }
        __syncthreads(); }
    { const int nb0 = NBUILD, nbw = RG < 32 ? RG : 32;
      if (F.bid >= nb0 && F.bid < nb0 + nbw) for (int t = F.bid - nb0; t < 32; t += nbw) { const int g = t >> 3, n0 = (t & 7) * 128;
          OpTcTab A{ct, st}; OpF32Rows Bo{w_in + g * 128, DIN}; EpiBf16Plain E{(bf16*)(ws + OFF_WFT) + (size_t)g * 128 * 1024, 1024};
          gg_tile(F.lds, A, Bo, E, 0, n0, 128, F.wave); }
      __syncthreads(); }
    { bf16* D1 = (bf16*)(ws + OFF_DFT1);
      for (int it = gt; it < 256 * 128; it += NT) { const int r = it >> 7, n1 = it & 127, ri = r >> 7, k1 = r & 127; const int m = (n1 * k1) & 127;
          const float v = ri ? -st[m] : ct[m]; D1[it] = (bf16)(cvt_pk_bf16(v, 0.f) & 0xffffu); } }
    { bf16* D2 = (bf16*)(ws + OFF_DFT2);
      for (int it = gt; it < 256 * 128; it += NT) { const int k2 = it >> 7, kk = it & 127, ri = kk >> 6, n2 = kk & 63; const int m = ((n2 * k2) & 63) * 2;
          const float v = k2 < 64 ? (ri ? st[m] : ct[m]) * (1.0f / 1024.0f) : 0.f; D2[it] = (bf16)(cvt_pk_bf16(v, 0.f) & 0xffffu); } }
    { f32x2* TW = (f32x2*)(ws + OFF_TW);
      for (int it = gt; it < 8192; it += NT) { float s, c; sincospif((float)it / 4096.0f, &s, &c); TW[it] = (f32x2){c, s}; } }
    { int* SL = (int*)(ws + OFF_SLOT); for (int it = gt; it < T * NE; it += NT) SL[it] = -1; }
    { float* WG = (float*)(ws + OFF_WGT); const float* gf = a->in[15]; const float* wrt = a->in[16]; for (int it = gt; it < NE * DM; it += NT) { const int e = it >> 10, d = it & 1023; WG[it] = gf[d] * wrt[d * NE + e]; } }
    { LAS float* scr = (LAS float*)(F.lds + F.wave * 8704);
      constexpr int I_WB = (DM / 64) * (2560 / 32), I_GLU = (512 / 64) * (2048 / 32), I_WF = (512 / 64) * (DM / 32), I_SQ = (DM / 64) * (DM / 32), I_PP = (PLE / 64) * (DM / 32);
      constexpr int NITEMS = I_WB + I_GLU + I_WF + 2 * I_SQ + I_PP;
      for (int it = gw; it < NITEMS; it += NW) { int r = it;
          if (r < I_WB) { const int nb = r % 80, kb = r / 80; transpose_item(w_in, DIN, 512 + nb * 32, kb * 64, (bf16*)(ws + OFF_WB) + (size_t)nb * 32 * DM, DM, scr, F.lane()); continue; } r -= I_WB;
          if (r < I_GLU) { const int nb = r % 64, kb = r / 64;
              const int n0 = nb * 32, pn = n0 >> 8, bj = (n0 >> 7) & 1, xx = n0 & 127; transpose_item(a->in[13], 2048, bj * 1024 + pn * 128 + xx, kb * 64, (bf16*)(ws + OFF_WGLU) + (size_t)n0 * 512, 512, scr, F.lane()); continue; } r -= I_GLU;
          if (r < I_WF) { const int nb = r % 32, kb = r / 32; transpose_item_t<true>(a->in[4], DM, nb * 32, kb * 64, (bf16*)(ws + OFF_WF) + (size_t)nb * 32 * 512, 512, scr, F.lane()); continue; } r -= I_WF;
          if (r < I_SQ) { const int nb = r % 32, kb = r / 32; transpose_item(a->in[14], DM, nb * 32, kb * 64, (bf16*)(ws + OFF_WOUT) + (size_t)nb * 32 * DM, DM, scr, F.lane()); continue; } r -= I_SQ;
          if (r < I_SQ) { const int nb = r % 32, kb = r / 32; transpose_item_fp8(a->in[21], a->in[20], DM, nb * 32, kb * 64, ws + OFF_WPG + (size_t)nb * 32 * DM, DM, 64.0f, scr, F.lane()); continue; } r -= I_SQ;
          { const int nb = r % 32, kb = r / 32; transpose_item(a->in[22], DM, nb * 32, kb * 64, (bf16*)(ws + OFF_WPP) + (size_t)nb * 32 * PLE, PLE, scr, F.lane()); }
      } }
    { bf16* H = (bf16*)(ws + WS_H); unsigned* q = (unsigned*)(ws + WS_CTL) + qword; const int lane = F.lane(); const float* pin = a->in[1];
      f32x4 gg[4];
#pragma unroll
      for (int j = 0; j < 4; ++j) gg[j] = ((const f32x4*)g_mix + lane)[64 * j];
      for (;;) { unsigned r0 = 0; if (lane == 0) r0 = __hip_atomic_fetch_add(q, 16u, __ATOMIC_RELAXED, __HIP_MEMORY_SCOPE_AGENT); r0 = __builtin_amdgcn_readfirstlane(r0); if (r0 >= (unsigned)T) break;
          for (int m0 = (int)r0; m0 < (int)r0 + 16; m0 += 4) { f32x4 v[4][4], pv[4];
#pragma unroll
              for (int r = 0; r < 4; ++r) {
#pragma unroll
                  for (int j = 0; j < 4; ++j) v[r][j] = __builtin_nontemporal_load((const f32x4*)(x + (size_t)(m0 + r) * DM) + lane + 64 * j);
                  pv[r] = __builtin_nontemporal_load((const f32x4*)(pin + (size_t)(m0 + r) * PLE) + lane); }
#pragma unroll
              for (int r = 0; r < 4; ++r) { float sq = 0.f;
#pragma unroll
                  for (int j = 0; j < 4; ++j) sq += (v[r][j].x * v[r][j].x + v[r][j].y * v[r][j].y) + (v[r][j].z * v[r][j].z + v[r][j].w * v[r][j].w);
                  const float rstd = 1.0f / sqrtf(wave_sum(sq) * (1.0f / DM) + RMS_EPS);
#pragma unroll
                  for (int j = 0; j < 4; ++j) store_bf16x4(H + (size_t)(m0 + r) * DM + 4 * lane + 256 * j, (f32x4){v[r][j].x * rstd * gg[j].x, v[r][j].y * rstd * gg[j].y, v[r][j].z * rstd * gg[j].z, v[r][j].w * rstd * gg[j].w});
                  store_bf16x4((bf16*)(ws + WS_PB) + (size_t)(m0 + r) * PLE + 4 * lane, pv[r]); } } } }
}

__device__ __forceinline__ void phase_gemm1(Frame& F, KArgs a) {
    unsigned char* ws = F.ws; const bf16* H = (const bf16*)(ws + WS_H);
    { pg8::PolG1a P{(const bf16*)(ws + OFF_WFT), H, DM}; pg8::StaticOrder S; S.init(512, T, F.G, F.bid); pg8::EpiXt E{(bf16*)(ws + WS_XT)};
      pg8::gemm_phase(F.lds, P, S, E, F.wave); }
    { pg8::PolPlain P{H, (const bf16*)(ws + OFF_WB), DM, DM, DM}; pg8::StaticOrder S; S.init(T, 2560, F.G, F.bid); pg8::EpiG1b E{(bf16*)(ws + WS_ACAT), ws + WS_GF, ws + WS_GS};
      pg8::gemm_phase(F.lds, P, S, E, F.wave); }
}
__device__ __forceinline__ void phase_stageA(Frame& F, KArgs a) {
    unsigned char* ws = F.ws;
    { pg8::PolPlain P{(const bf16*)(ws + OFF_DFT1), (const bf16*)(ws + WS_XT), 128, 128, 128}; pg8::LinearOrder S; S.init(1, 131072 / 256, F.G, F.bid); pg8::EpiStageA E{(bf16*)(ws + WS_Y), (const f32x2*)(ws + OFF_TW)};
      pg8::gemm_phase(F.lds, P, S, E, F.wave); }
    { const int ntm = 4, ntn = 2;
      for (int t = F.bid; t < NG * ntm * ntn; t += F.G) { int g = t / (ntm * ntn), tt = t % (ntm * ntn);
          if (F.G == 256) { g = (t & 7) * 4 + (t >> 6); tt = (t >> 3) & 7; }
          OpBf16Rows A{(const bf16*)(ws + WS_ACAT) + (size_t)g * NROWC * KCAT, KCAT}; OpBf16Rows Bo{(const bf16*)(ws + WS_WEND) + (size_t)g * 256 * 1024, 1024};
          EpiF32Plain E{(float*)(ws + WS_EE) + (size_t)g * NROWC * 256, 256};
          gg_tile(F.lds, A, Bo, E, (tt % ntm) * 128, (tt / ntm) * 128, 1024, F.wave); } }
}
__device__ __forceinline__ void phase_stageC(Frame& F, KArgs a) {
    unsigned char* ws = F.ws;
    { pg8::PolStageC P{(const bf16*)(ws + OFF_DFT2), (const bf16*)(ws + WS_Y), 128}; pg8::LinearOrder S; S.init(1, 1024, F.G, F.bid); pg8::EpiStageC E{(bf16*)(ws + WS_FMIX)};
      pg8::gemm_phase(F.lds, P, S, E, F.wave); }
    { const float* EE = (const float*)(ws + WS_EE); bf16* ACAT = (bf16*)(ws + WS_ACAT); const f32x2* L64 = (const f32x2*)(ws + OFF_L64);
      if (F.G == 256) {
          const int b = F.bid >> 6, g = (F.bid >> 1) & 31, d = F.bid & 1, tid = F.tid(), lane = F.lane(); f32x4 v[8];
          __syncthreads();
#pragma unroll
          for (int k = 0; k < 8; ++k) { const int p = tid + NTHR * k, c = p >> 5, j = p & 31; v[k] = *(const f32x4*)(EE + ((size_t)g * NROWC + b * NCH + c) * 256 + d * 128 + j * 4); }
          asm volatile("s_waitcnt vmcnt(0)" ::: "memory");
#pragma unroll
          for (int k = 0; k < 8; ++k) *(LAS f32x4*)(F.lds + (size_t)(tid + NTHR * k) * 16) = v[k];
          __syncthreads();
          if (F.wave == 0) { const LAS f32x2* es = (const LAS f32x2*)F.lds; const f32x2 l64 = L64[(d * NG + g) * 64 + lane]; float cr = 0.f, ci = 0.f;
              for (int s0 = 0; s0 < NCH; s0 += 16) { f32x2 e[16];
#pragma unroll
                  for (int q = 0; q < 16; ++q) { const int c = d ? (NCH - 1 - s0 - q) : (s0 + q); e[q] = es[c * 64 + lane]; }
#pragma unroll
                  for (int q = 0; q < 16; ++q) { const int c = d ? (NCH - 1 - s0 - q) : (s0 + q); const size_t row = (size_t)g * NROWC + b * NCH + c;
                      *(unsigned*)(ACAT + row * KCAT + 1024 + d * 128 + lane * 2) = cvt_pk_bf16(cr, ci);
                      const float nr = l64.x * cr - l64.y * ci + e[q].x, ni = l64.x * ci + l64.y * cr + e[q].y; cr = nr; ci = ni; } } }
          __syncthreads();
      } else {
      const int gt = F.bid * NTHR + F.tid(), NT = F.G * NTHR;
      for (int it = gt; it < NB * NG * 2 * NS; it += NT) { const int n = it & 63, d = (it >> 6) & 1, g = (it >> 7) & 31, b = it >> 12;
          const f32x2 l64 = L64[(d * NG + g) * 64 + n]; float cr = 0.f, ci = 0.f;
          for (int s0 = 0; s0 < NCH; s0 += 16) { f32x2 e[16];
#pragma unroll
              for (int q = 0; q < 16; ++q) { const int c = d ? (NCH - 1 - s0 - q) : (s0 + q); e[q] = *(const f32x2*)(EE + ((size_t)g * NROWC + b * NCH + c) * 256 + d * 128 + n * 2); }
              asm volatile("s_waitcnt vmcnt(0)" ::: "memory");
#pragma unroll
              for (int q = 0; q < 16; ++q) { const int c = d ? (NCH - 1 - s0 - q) : (s0 + q); const size_t row = (size_t)g * NROWC + b * NCH + c;
                  *(unsigned*)(ACAT + row * KCAT + 1024 + d * 128 + n * 2) = cvt_pk_bf16(cr, ci);
                  const float nr = l64.x * cr - l64.y * ci + e[q].x, ni = l64.x * ci + l64.y * cr + e[q].y; cr = nr; ci = ni; } } } } }
}
__device__ __forceinline__ void phase_passB(Frame& F, KArgs a) {
    unsigned char* ws = F.ws;
    { pg8::PolPassB2 P{(const bf16*)(ws + WS_ACAT), (const bf16*)(ws + WS_KC), (const bf16*)(ws + WS_CT), KCAT}; pg8::LinearOrder S; S.init(NG * 2, 4, F.G, F.bid); pg8::EpiPassB E{(bf16*)(ws + WS_YS)};
      pg8::gemm_phase(F.lds, P, S, E, F.wave); }
}
__device__ __forceinline__ void phase_glu(Frame& F, KArgs a) {
    unsigned char* ws = F.ws;
    pg8::PolYfGlu P{ws, WS_FMIX, OFF_WF, WS_YS, OFF_WGLU, 512}; pg8::TripleOrder S; S.init(F.G, F.bid);
    pg8::EpiYfGlu E{pg8::EpiMulGate{(bf16*)(ws + WS_MIXF), ws + WS_GF}, pg8::EpiGlu{(bf16*)(ws + WS_MIX), ws + WS_GS}};
    pg8::gemm_phase(F.lds, P, S, E, F.wave);
}
__device__ __forceinline__ void phase_wout(Frame& F, KArgs a) {
    unsigned char* ws = F.ws;
    pg8::PolPlain P{(const bf16*)(ws + WS_MIX), (const bf16*)(ws + OFF_WOUT), DM, DM, DM}; pg8::StaticOrder S; S.init(T, DM, F.G, F.bid); pg8::EpiResidual E{(bf16*)F.xo, (unsigned char*)((bf16*)F.xo + (size_t)T * DM), a->in[0]};
    pg8::gemm_phase(F.lds, P, S, E, F.wave);
}
__device__ __forceinline__ void phase_expert_weights(Frame& F, KArgs a) {
    unsigned char* ws = F.ws; LAS float* scr = (LAS float*)(F.lds + F.wave * 16640); const int gw = F.bid * 8 + F.wave, NW = F.G * 8;
    constexpr int I_GU = NE * 2 * (DM / 64) * (DE / 64), I_D = NE * (DE / 64) * (DM / 64);
    for (int it2 = gw; it2 < (I_GU + I_D) / 2; it2 += NW) {
        if (it2 < I_GU / 2) { const int nb = it2 % 44, kp = (it2 / 44) % 8, bj = (it2 / (44 * 8)) & 1, e = it2 / (44 * 8 * 2);
            const float* W = (bj ? a->in[18] : a->in[17]) + (size_t)e * DM * DE; const int f0 = nb * 64, tq = f0 >> 7, xx = f0 & 127;
            transpose_pair64_fp8(W, a->in[15], DE, f0, 2 * kp * 64, ws + WS_WGU + ((size_t)e * (2 * DE) + tq * 256 + bj * 128 + xx) * DM, DM, 64.0f, scr, F.lane()); }
        else { const int rr = it2 - I_GU / 2, nb = rr % 16, kp = (rr / 16) % 22, e = rr / (16 * 22);
            transpose_pair64_fp8(a->in[19] + (size_t)e * DE * DM, nullptr, DM, nb * 64, 2 * kp * 64, ws + WS_WD + ((size_t)e * DM + nb * 64) * DE, DE, 64.0f, scr, F.lane()); }
    }
}
__device__ __forceinline__ void phase_eproj(Frame& F, KArgs a, int G2, int c2) {
    unsigned char* ws = F.ws; (void)a;
    pg8::PolPlain P{(const bf16*)(ws + WS_PB), (const bf16*)(ws + OFF_WPP), PLE, PLE, PLE}; pg8::StaticOrder S; S.init(T, DM, G2, c2); pg8::EpiBf16 E{(bf16*)(ws + WS_EB), DM};
    pg8::gemm_phase(F.lds, P, S, E, F.wave);
}
__device__ __forceinline__ void phase_exp_up(Frame& F, KArgs a) {
    unsigned char* ws = F.ws;
    pg8::PolExpUp8 P{ws + WS_H, (const int*)(ws + OFF_IDX), ws + WS_WGU, DM / 2}; pg8::ExpertOrder S; S.init(2 * DE / 256, F.G, F.bid); pg8::EpiSwiglu E{ws + WS_HID, (const float*)(ws + OFF_RSS), 1.0f / 64.0f, 8.0f};
    pg8::gemm_phase(F.lds, P, S, E, F.wave);
}
__device__ __forceinline__ void phase_exp_down(Frame& F, KArgs a) {
    unsigned char* ws = F.ws;

    pg8::PolExpDown8 P{ws + WS_HID, ws + WS_WD, DE / 2}; pg8::ExpertOrder S; S.init(DM / 256, F.G, F.bid); pg8::EpiScaleRows E{(bf16*)(ws + WS_YB), (const float*)(ws + OFF_VAL), 1.0f / 512.0f};
    pg8::gemm_phase(F.lds, P, S, E, F.wave);
}
__device__ __forceinline__ void phase_combine(Frame& F, KArgs a) {
    unsigned char* ws = F.ws; float* RST = (float*)(ws + OFF_RST); bf16* X2B = (bf16*)(ws + WS_X2B); unsigned char* X2F = ws + WS_X2F; const bf16* YB = (const bf16*)(ws + WS_YB); const int* SLOT = (const int*)(ws + OFF_SLOT);
    const int gw = F.bid * 8 + F.wave, NW = F.G * 8, lane = F.lane();
    for (int m0 = gw * 4; m0 < T; m0 += NW * 4) {
        const int myslot = SLOT[(size_t)(lane & 15) * T + m0 + (lane >> 4)];
        f32x4 v[4][4];
#pragma unroll
        for (int r = 0; r < 4; ++r)
#pragma unroll
            for (int j = 0; j < 4; ++j) { const u32x2 w = __builtin_nontemporal_load((const u32x2*)((const bf16*)F.xo + (size_t)(m0 + r) * DM + 4 * lane + 256 * j)); v[r][j] = (f32x4){__uint_as_float(w.x << 16), __uint_as_float(w.x & 0xffff0000u), __uint_as_float(w.y << 16), __uint_as_float(w.y & 0xffff0000u)}; }
        asm volatile("s_waitcnt vmcnt(0)" ::: "memory");
        unsigned long long mk = __ballot(myslot >= 0); unsigned msk[4];
#pragma unroll
        for (int r = 0; r < 4; ++r) msk[r] = (unsigned)(mk >> (16 * r)) & 0xffffu;
        while ((msk[0] | msk[1] | msk[2] | msk[3]) != 0u) { u32x2 y[4][4]; bool act[4];
#pragma unroll
            for (int r = 0; r < 4; ++r) { act[r] = msk[r] != 0u; if (act[r]) { const int e = __builtin_ctz(msk[r]); msk[r] &= msk[r] - 1u; const int sl = __shfl(myslot, 16 * r + e);
                    const bf16* yr = YB + ((size_t)e * 4096 + sl) * DM + 4 * lane;
#pragma unroll
                    for (int j = 0; j < 4; ++j) y[r][j] = __builtin_nontemporal_load((const u32x2*)(yr + 256 * j)); } }
            asm volatile("s_waitcnt vmcnt(0)" ::: "memory");
#pragma unroll
            for (int r = 0; r < 4; ++r) if (act[r]) {
#pragma unroll
                for (int j = 0; j < 4; ++j) { const u32x2 w = y[r][j]; v[r][j] += (f32x4){__uint_as_float(w.x << 16), __uint_as_float(w.x & 0xffff0000u), __uint_as_float(w.y << 16), __uint_as_float(w.y & 0xffff0000u)}; } }
        }
#pragma unroll
        for (int r = 0; r < 4; ++r) { float sq = 0.f;
#pragma unroll
            for (int j = 0; j < 4; ++j) { store_bf16x4(X2B + (size_t)(m0 + r) * DM + 4 * lane + 256 * j, v[r][j]);
                { unsigned w8 = 0u; w8 = __builtin_amdgcn_cvt_pk_fp8_f32(clamp8(v[r][j].x), clamp8(v[r][j].y), w8, false); w8 = __builtin_amdgcn_cvt_pk_fp8_f32(clamp8(v[r][j].z), clamp8(v[r][j].w), w8, true); *(unsigned*)(X2F + (size_t)(m0 + r) * DM + 4 * lane + 256 * j) = w8; }
                sq += (v[r][j].x * v[r][j].x + v[r][j].y * v[r][j].y) + (v[r][j].z * v[r][j].z + v[r][j].w * v[r][j].w); }
            const float rstd = 1.0f / sqrtf(wave_sum(sq) * (1.0f / DM) + RMS_EPS);
            if (lane == 0) RST[m0 + r] = rstd; }
    }
}
__device__ __forceinline__ void phase_ple(Frame& F, KArgs a) {
    unsigned char* ws = F.ws;
    pg8::PolPlain8 P{ws + WS_X2F, ws + OFF_WPG, DM, DM, DM / 2}; pg8::StaticOrder S; S.init(T, DM, F.G, F.bid); pg8::EpiPle E{(const bf16*)(ws + WS_X2B), (bf16*)(ws + WS_X3B), (const bf16*)(ws + WS_EB), (const float*)(ws + OFF_RST), 1.0f / 64.0f};
    pg8::gemm_phase(F.lds, P, S, E, F.wave);
}

constexpr int LDS_BYTES = 147456;
constexpr int LDS_MISC = 140 * 1024;
__global__ void __launch_bounds__(NTHR, 2) mk_fwd(Args args) {
    extern __shared__ __attribute__((aligned(16))) unsigned char lds_raw[];
    Frame F; F.lds = (LAS unsigned char*)lds_raw; F.wave = __builtin_amdgcn_readfirstlane((int)threadIdx.x >> 6); F.G = gridDim.x; F.bid = blockIdx.x;
    const KArgs kp = (KArgs)__builtin_amdgcn_kernarg_segment_ptr();
    F.ws = args.ws; F.xo = args.out;
    volatile LAS unsigned* MISC = (volatile LAS unsigned*)(F.lds + LDS_MISC);
    { const int t0 = F.tid(); if (t0 < 64) MISC[t0] = 0u; }
    __syncthreads();
    XcdBarrier bar; bar.bar = (unsigned*)(args.ws + WS_CTL) + 4096; bar.x = 0; bar.st = nullptr; bar.wave = F.wave;
    if (MK_N_LAUNCHES == 1) bar = xcd_barrier_post((unsigned*)(args.ws + WS_CTL) + 4096, MISC + 8, F.wave);
    const int lo = args.ph_lo, hi = args.ph_hi;
#define IN(k) (lo <= (k) && (k) < hi)
    auto kpl = [&]() -> KArgs { KArgs p = kp; asm volatile("" : "+s"(p)); return p; };
#define SEAM(k) do { if (lo <= (k) && (k) + 1 < hi) xcd_barrier(bar); } while (0)
    if (IN(0))  { phase0(F, kpl());
    }         SEAM(0);
    if (IN(2))  { phase_gemm1(F, kpl()); }    SEAM(2);
    if (IN(3))  { phase_stageA(F, kpl()); }   SEAM(3);
    if (IN(4))  { phase_stageC(F, kpl()); }   SEAM(4);
    if (IN(5))  { phase_passB(F, kpl()); }    SEAM(5);
    if (IN(6))  { phase_glu(F, kpl()); }      SEAM(6);
    if (IN(7))  { phase_wout(F, kpl()); }     SEAM(7);
    if (IN(8))  { phase_router(F, kpl()); }   SEAM(8);
    if (IN(9))  { if (F.G == 256) { if (F.bid < NB * NE) phase_topk(F, kpl()); else phase_eproj(F, kpl(), 192, F.bid - NB * NE); } else { phase_topk(F, kpl()); __syncthreads(); phase_eproj(F, kpl(), F.G, F.bid); }
                  __syncthreads(); phase_expert_weights(F, kpl()); } SEAM(9);
    if (IN(10)) { phase_exp_up(F, kpl()); }   SEAM(10);
    if (IN(11)) { phase_exp_down(F, kpl()); } SEAM(11);
    if (IN(12)) { phase_combine(F, kpl()); }  SEAM(12);
    if (IN(13)) { phase_ple(F, kpl()); }      SEAM(13);
    if (IN(14)) { phase_final(F, kpl()); }
#undef IN
#undef SEAM
}

extern "C" void kernel_launch(void* const* d_in, const int* in_sizes, int n_in, void* d_out, int out_size, void* d_ws, size_t ws_size, hipStream_t stream) {
    static int grid = 0;
    if (grid == 0) {
        if (n_in != 24 || out_size != T * DM || ws_size < WS_END) { fprintf(stderr, "kernel_launch: unexpected shapes (n_in %d out %d ws %zu need %zu)\n", n_in, out_size, ws_size, (size_t)WS_END); grid = -1; return; }
        int dev = 0, cus = 0, per_cu = 0;
        if (hipGetDevice(&dev) != hipSuccess || hipDeviceGetAttribute(&cus, hipDeviceAttributeMultiprocessorCount, dev) != hipSuccess) { grid = -1; return; }
        if (hipFuncSetAttribute((const void*)mk_fwd, hipFuncAttributeMaxDynamicSharedMemorySize, LDS_BYTES) != hipSuccess) { fprintf(stderr, "kernel_launch: hipFuncSetAttribute failed\n"); grid = -1; return; }
        if (hipOccupancyMaxActiveBlocksPerMultiprocessor(&per_cu, (const void*)mk_fwd, NTHR, LDS_BYTES) != hipSuccess || per_cu < 1) { fprintf(stderr, "kernel_launch: occupancy query says %d\n", per_cu); (void)hipGetLastError(); grid = -1; return; }
        grid = cus;
    }
    if (grid < 0) return;
    (void)hipMemsetAsync((char*)d_ws + WS_CTL, 0, CTL_BYTES, stream);
    Args a{};
    for (int i = 0; i < 24; ++i) a.in[i] = (const float*)d_in[i];
    a.out = (float*)d_out; a.ws = (unsigned char*)d_ws;
    if (MK_N_LAUNCHES == 1) { a.ph_lo = 0; a.ph_hi = NPH; hipLaunchKernelGGL(mk_fwd, dim3(grid), dim3(NTHR), LDS_BYTES, stream, a); }
    else for (int p = 0; p < NPH; ++p) { a.ph_lo = p; a.ph_hi = p + 1; hipLaunchKernelGGL(mk_fwd, dim3(grid), dim3(NTHR), LDS_BYTES, stream, a); }
}
```
